# Optimizing an MI355X kernel written in HIP

```python
import math
import jax, jax.numpy as jnp
from jax import lax
import numpy as np

D_MODEL = 1024
BATCH = 16
SEQ = 2048
DEPTH = 1
DEC_BATCH = 32
DEC_SEQ = 32
PAST_LEN = 2048

CHUNK = 64
CONV_WIDTH = 31
CONV_DIM = 512
ATT_HEADS = 4
ATT_HEAD_DIM = 64
ATT_V_DIM = 2 * ATT_HEAD_DIM
ATT_DIM = ATT_HEADS * ATT_V_DIM
QK_DIM = ATT_HEADS * 2 * ATT_HEAD_DIM
MIX_DIM = CONV_DIM + ATT_DIM
IN_DIM = 2 * CONV_DIM + 2 * QK_DIM + ATT_DIM
ROPE_THETA = 10000.0
Q_BLOCK = 128
PEER_HEADS = 8
PEER_KEYS = 128
PEER_N = PEER_KEYS * PEER_KEYS
PEER_QDIM = 256
PEER_HALF = PEER_QDIM // 2
PEER_TOPK = 16
PEER_TOK_BLOCK = 256
LN_EPS = 1e-5
DEEPNORM_ALPHA = (2 * DEPTH) ** 0.25
DEEPNORM_BETA = (8 * DEPTH) ** -0.25

kernel_name = 'hymba_conformer_diffattn_peer_stream_step'


def layer_norm(x, g, b):
    x32 = x.astype(jnp.float32)
    mu = jnp.mean(x32, -1, keepdims=True)
    var = jnp.mean(jnp.square(x32 - mu), -1, keepdims=True)
    return ((x32 - mu) * lax.rsqrt(var + LN_EPS) * g.astype(jnp.float32) + b.astype(jnp.float32)).astype(x.dtype)


def rope(x, pos):
    half = ATT_HEAD_DIM // 2
    inv = 1.0 / (ROPE_THETA ** (jnp.arange(half, dtype=jnp.float32) / half))
    ang = pos.astype(jnp.float32)[:, None] * inv[None, :]
    cos = jnp.cos(ang)[:, None, None, :]
    sin = jnp.sin(ang)[:, None, None, :]
    x32 = x.astype(jnp.float32)
    x1, x2 = x32[..., :half], x32[..., half:]
    return jnp.concatenate([x1 * cos - x2 * sin, x2 * cos + x1 * sin], -1).astype(x.dtype)


def diff_attend(q, k, v, q_pos, k_pos, lam, subln_g, lam_init):
    s = jnp.einsum('bqhpd,bkhpd->bhpqk', q, k).astype(jnp.float32) * (ATT_HEAD_DIM ** -0.5)
    allowed = (k_pos[None, :] // CHUNK) <= (q_pos[:, None] // CHUNK)
    s = jnp.where(allowed, s, -jnp.inf)
    p = jax.nn.softmax(s, axis=-1)
    a = p[:, :, 0] - lam * p[:, :, 1]
    o = jnp.einsum('bhqk,bkhe->bqhe', a.astype(v.dtype), v).astype(jnp.float32)
    o = o * lax.rsqrt(jnp.mean(jnp.square(o), -1, keepdims=True) + LN_EPS) * subln_g.astype(jnp.float32)
    return (o * (1.0 - lam_init)).astype(v.dtype)


def prompt_attention(q, k, v, lam, subln_g, lam_init):
    B, S = q.shape[0], q.shape[1]
    nb = S // Q_BLOCK
    qb = q.reshape(B, nb, Q_BLOCK, ATT_HEADS, 2, ATT_HEAD_DIM).swapaxes(0, 1)
    k_pos = jnp.arange(S)

    def one(args):
        qblk, i = args
        q_pos = i * Q_BLOCK + jnp.arange(Q_BLOCK)
        return diff_attend(qblk, k, v, q_pos, k_pos, lam, subln_g, lam_init)

    ob = lax.map(one, (qb, jnp.arange(nb)))
    return ob.swapaxes(0, 1).reshape(B, S, ATT_HEADS, ATT_V_DIM)


def causal_dwconv(u, hist, w, b):
    xp = jnp.concatenate([hist, u], axis=1)
    y = lax.conv_general_dilated(xp, w[:, None, :], window_strides=(1,), padding='VALID',
                                 dimension_numbers=('NWC', 'WIO', 'NWC'), feature_group_count=CONV_DIM)
    return y + b, xp[:, -(CONV_WIDTH - 1):]


def peer(h, w_query, sub_keys, u_tab, v_tab):
    B, L, D = h.shape
    T = B * L
    nb = -(-T // PEER_TOK_BLOCK)
    t = jnp.pad(h.reshape(T, D), ((0, nb * PEER_TOK_BLOCK - T), (0, 0))).reshape(nb, PEER_TOK_BLOCK, D)

    def one(tb):
        q = (tb @ w_query).reshape(PEER_TOK_BLOCK, PEER_HEADS, 2, PEER_HALF)
        s = jnp.einsum('thpd,hpkd->thpk', q, sub_keys).astype(jnp.float32)
        sv, si = lax.top_k(s, PEER_TOPK)
        cand = (sv[:, :, 0, :, None] + sv[:, :, 1, None, :]).reshape(PEER_TOK_BLOCK, PEER_HEADS, PEER_TOPK * PEER_TOPK)
        cidx = (si[:, :, 0, :, None] * PEER_KEYS + si[:, :, 1, None, :]).reshape(PEER_TOK_BLOCK, PEER_HEADS, PEER_TOPK * PEER_TOPK)
        fv, fp = lax.top_k(cand, PEER_TOPK)
        e = jnp.take_along_axis(cidx, fp, axis=-1)
        g = jax.nn.softmax(fv, axis=-1)
        a = jnp.einsum('td,thkd->thk', tb, u_tab[e]).astype(jnp.float32)
        a = jax.nn.gelu(a, approximate=False) * g
        return jnp.einsum('thk,thkd->td', a.astype(tb.dtype), v_tab[e])

    out = lax.map(one, t).reshape(nb * PEER_TOK_BLOCK, D)[:T]
    return out.reshape(B, L, D)


def layer_forward(x, c, conv_hist, k_past, v_past, lw, lam_init):
    B, L, _ = x.shape
    mod = jax.nn.silu(c) @ lw['w_ada'] + lw['b_ada']
    sh1, sc1, g1, sh2, sc2, g2 = jnp.split(mod[:, None, :], 6, axis=-1)
    h = x * (1 + sc1) + sh1
    z = h @ lw['w_in'] + lw['b_in']
    conv_a, conv_b, q, k, v = jnp.split(z, [CONV_DIM, 2 * CONV_DIM, 2 * CONV_DIM + QK_DIM, 2 * CONV_DIM + 2 * QK_DIM], axis=-1)
    u = conv_a * jax.nn.sigmoid(conv_b)
    dw, conv_state = causal_dwconv(u, conv_hist, lw['w_dw'], lw['b_dw'])
    conv_out = jax.nn.silu(layer_norm(dw, lw['conv_ln_g'], lw['conv_ln_b']))
    past = 0 if k_past is None else k_past.shape[1]
    q_pos = past + jnp.arange(L)
    q = rope(q.reshape(B, L, ATT_HEADS, 2, ATT_HEAD_DIM), q_pos)
    k = rope(k.reshape(B, L, ATT_HEADS, 2, ATT_HEAD_DIM), q_pos)
    v = v.reshape(B, L, ATT_HEADS, ATT_V_DIM)
    f32 = jnp.float32
    lam = (jnp.exp(jnp.sum(lw['lam_q1'].astype(f32) * lw['lam_k1'].astype(f32)))
           - jnp.exp(jnp.sum(lw['lam_q2'].astype(f32) * lw['lam_k2'].astype(f32))) + lam_init)
    if k_past is None:
        att = prompt_attention(q, k, v, lam, lw['subln_g'], lam_init)
    else:
        k_all = jnp.concatenate([k_past, k], axis=1)
        v_all = jnp.concatenate([v_past, v], axis=1)
        att = diff_attend(q, k_all, v_all, q_pos, jnp.arange(past + L), lam, lw['subln_g'], lam_init)
    mix = jnp.concatenate([conv_out, att.reshape(B, L, ATT_DIM)], axis=-1)
    x = layer_norm(DEEPNORM_ALPHA * x + g1 * (mix @ lw['w_out'] + lw['b_out']), lw['ln1_g'], lw['ln1_b'])
    h2 = x * (1 + sc2) + sh2
    ff = peer(h2, lw['w_query'], lw['sub_keys'], lw['u_tab'], lw['v_tab'])
    x = layer_norm(DEEPNORM_ALPHA * x + g2 * ff, lw['ln2_g'], lw['ln2_b'])
    return x, conv_state, k, v


def setup_inputs(seed: int = 0) -> dict:
    key = jax.random.key(seed)
    ks = jax.random.split(key, 40)
    n = lambda i, shape, s: jax.random.normal(ks[i], shape, jnp.float32) * s
    D = D_MODEL
    return {
        'x_prompt': n(0, (BATCH, SEQ, D), 1.0),
        'x_sample': n(1, (DEC_BATCH, DEC_SEQ, D), 1.0),
        'cache_k': n(2, (DEPTH, DEC_BATCH, PAST_LEN, ATT_HEADS, 2, ATT_HEAD_DIM), 1.0),
        'cache_v': n(3, (DEPTH, DEC_BATCH, PAST_LEN, ATT_HEADS, ATT_V_DIM), 1.0),
        'cache_conv': n(4, (DEPTH, DEC_BATCH, CONV_WIDTH - 1, CONV_DIM), 0.5),
        'c_prompt': n(5, (BATCH, D), 1.0),
        'c_sample': n(6, (DEC_BATCH, D), 1.0),
        'w_ada': n(7, (DEPTH, D, 6 * D), 0.5 * D ** -0.5),
        'b_ada': n(8, (DEPTH, 6 * D), 0.01),
        'w_in': n(9, (DEPTH, D, IN_DIM), D ** -0.5),
        'b_in': n(10, (DEPTH, IN_DIM), 0.01),
        'w_dw': n(11, (DEPTH, CONV_WIDTH, CONV_DIM), CONV_WIDTH ** -0.5),
        'b_dw': n(12, (DEPTH, CONV_DIM), 0.01),
        'conv_ln_g': 1.0 + n(13, (DEPTH, CONV_DIM), 0.05),
        'conv_ln_b': n(14, (DEPTH, CONV_DIM), 0.01),
        'lam_q1': n(15, (DEPTH, ATT_HEAD_DIM), 0.1),
        'lam_k1': n(16, (DEPTH, ATT_HEAD_DIM), 0.1),
        'lam_q2': n(17, (DEPTH, ATT_HEAD_DIM), 0.1),
        'lam_k2': n(18, (DEPTH, ATT_HEAD_DIM), 0.1),
        'subln_g': 1.0 + n(19, (DEPTH, ATT_V_DIM), 0.05),
        'w_out': n(20, (DEPTH, MIX_DIM, D), DEEPNORM_BETA * MIX_DIM ** -0.5),
        'b_out': n(21, (DEPTH, D), 0.01),
        'ln1_g': 1.0 + n(22, (DEPTH, D), 0.05),
        'ln1_b': n(23, (DEPTH, D), 0.01),
        'w_query': n(24, (DEPTH, D, PEER_HEADS * PEER_QDIM), D ** -0.5),
        'sub_keys': n(25, (DEPTH, PEER_HEADS, 2, PEER_KEYS, PEER_HALF), PEER_HALF ** -0.5),
        'u_tab': n(26, (DEPTH, PEER_N, D), D ** -0.5),
        'v_tab': n(27, (DEPTH, PEER_N, D), DEEPNORM_BETA * D ** -0.5),
        'ln2_g': 1.0 + n(28, (DEPTH, D), 0.05),
        'ln2_b': n(29, (DEPTH, D), 0.01),
    }


def reference(x_prompt, x_sample, cache_k, cache_v, cache_conv, c_prompt, c_sample,
              w_ada, b_ada, w_in, b_in, w_dw, b_dw, conv_ln_g, conv_ln_b,
              lam_q1, lam_k1, lam_q2, lam_k2, subln_g, w_out, b_out, ln1_g, ln1_b,
              w_query, sub_keys, u_tab, v_tab, ln2_g, ln2_b):
    xp, xs = x_prompt, x_sample
    kp_l, vp_l, cp_l, ks_l, vs_l, cs_l = [], [], [], [], [], []
    for l in range(DEPTH):
        lam_init = 0.8 - 0.6 * math.exp(-0.3 * l)
        lw = {'w_ada': w_ada[l], 'b_ada': b_ada[l], 'w_in': w_in[l], 'b_in': b_in[l],
              'w_dw': w_dw[l], 'b_dw': b_dw[l], 'conv_ln_g': conv_ln_g[l], 'conv_ln_b': conv_ln_b[l],
              'lam_q1': lam_q1[l], 'lam_k1': lam_k1[l], 'lam_q2': lam_q2[l], 'lam_k2': lam_k2[l],
              'subln_g': subln_g[l], 'w_out': w_out[l], 'b_out': b_out[l],
              'ln1_g': ln1_g[l], 'ln1_b': ln1_b[l], 'w_query': w_query[l], 'sub_keys': sub_keys[l],
              'u_tab': u_tab[l], 'v_tab': v_tab[l], 'ln2_g': ln2_g[l], 'ln2_b': ln2_b[l]}
        hist0 = jnp.zeros((xp.shape[0], CONV_WIDTH - 1, CONV_DIM), xp.dtype)
        xp, cp, kp, vp = layer_forward(xp, c_prompt, hist0, None, None, lw, lam_init)
        xs, cs, kn, vn = layer_forward(xs, c_sample, cache_conv[l], cache_k[l], cache_v[l], lw, lam_init)
        kp_l.append(kp); vp_l.append(vp); cp_l.append(cp)
        ks_l.append(kn); vs_l.append(vn); cs_l.append(cs)
    k_prompt = jnp.stack(kp_l)
    v_prompt = jnp.stack(vp_l)
    conv_prompt = jnp.stack(cp_l)
    k_sample = jnp.stack(ks_l)
    v_sample = jnp.stack(vs_l)
    conv_sample = jnp.stack(cs_l)
    return (xp, xs, k_prompt, v_prompt, conv_prompt, k_sample, v_sample, conv_sample)
```

```cpp
#include <hip/hip_runtime.h>
#include <hip/hip_cooperative_groups.h>
#include <cstdio>
#include <cstdint>
namespace cg = cooperative_groups;

typedef unsigned short u16;
typedef unsigned int u32;
using bf16x8 = __attribute__((ext_vector_type(8))) short;
using s16x4 = __attribute__((ext_vector_type(4))) short;
using f32x16 = __attribute__((ext_vector_type(16))) float;
using u32x4 = __attribute__((ext_vector_type(4))) unsigned;
using f32x4 = __attribute__((ext_vector_type(4))) float;
using f32x2 = __attribute__((ext_vector_type(2))) float;
using h16x2 = __attribute__((ext_vector_type(2))) _Float16;
using h16x4 = __attribute__((ext_vector_type(4))) _Float16;
using h16x32 = __attribute__((ext_vector_type(32))) _Float16;
using u32x2 = __attribute__((ext_vector_type(2))) unsigned;
using u32x6 = __attribute__((ext_vector_type(6))) unsigned;
using f32x32 = __attribute__((ext_vector_type(32))) float;
typedef __bf16 bf16x2_t __attribute__((ext_vector_type(2)));
#define DI __device__ __forceinline__
#define LAS __attribute__((address_space(3)))
#define GAS __attribute__((address_space(1)))
#define MFMA32(a, b, c) __builtin_amdgcn_mfma_f32_32x32x16_bf16((a), (b), (c), 0, 0, 0)

constexpr int TP = 32768, TS = 1024, T = TP + TS;
constexpr float LN_EPS = 1e-5f;
constexpr float ALPHA = 1.189207115002721f;
constexpr float LAM_INIT = 0.2f;

constexpr size_t OFF_MOD = 0;
constexpr size_t OFF_ROPE = OFF_MOD + 1179648;
constexpr size_t OFF_MISC = OFF_ROPE + 532480;
constexpr size_t OFF_BAR = OFF_MISC + 4096;
constexpr size_t OFF_WIN = OFF_BAR + 16384;
constexpr size_t OFF_WOUT = OFF_WIN + 5242880;
constexpr size_t OFF_WQ = OFF_WOUT + 2097152;
constexpr size_t OFF_SK = OFF_WQ + 4194304;
constexpr size_t OFF_UTAB = OFF_SK + 524288;
constexpr size_t OFF_VTAB = OFF_UTAB + 16777216;
constexpr size_t OFF_USC = OFF_VTAB + 16777216;
constexpr size_t OFF_VSC = OFF_USC + 65536;
constexpr size_t OFF_X = OFF_VSC + 65536;
constexpr size_t OFF_Y = OFF_X + 69206016;
constexpr size_t OFF_Z = OFF_Y + 138412032;
constexpr size_t OFF_H2 = OFF_Z + 138412032;
constexpr size_t WS_NEED = OFF_H2 + 69206016;

constexpr int HB_LDS = 73728;
constexpr int SMEM_BYTES = 2 * HB_LDS + 64;
constexpr int SMEM_CTRL = 2 * HB_LDS;

struct Params {
  const float *x_prompt, *x_sample, *cache_k, *cache_v, *cache_conv, *c_prompt, *c_sample;
  const float *w_ada, *b_ada, *w_in, *b_in, *w_dw, *b_dw, *conv_ln_g, *conv_ln_b;
  const float *lam_q1, *lam_k1, *lam_q2, *lam_k2, *subln_g, *w_out, *b_out, *ln1_g, *ln1_b;
  const float *w_query, *sub_keys, *u_tab, *v_tab, *ln2_g, *ln2_b;
  float* out;
  char* ws;
};
#define P_y_prompt (p.out)
#define P_y_sample (p.out + 33554432)
#define P_k_prompt (p.out + 34603008)
#define P_v_prompt (p.out + 51380224)
#define P_conv_prompt (p.out + 68157440)
#define P_k_sample (p.out + 68403200)
#define P_v_sample (p.out + 68927488)
#define P_conv_sample (p.out + 69451776)
#define P_mod ((float*)(p.ws + OFF_MOD))
#define P_rope ((float2*)(p.ws + OFF_ROPE))
#define P_misc ((float*)(p.ws + OFF_MISC))
#define P_counters ((u32*)(p.ws + OFF_MISC + 256))
#define P_win_t ((u16*)(p.ws + OFF_WIN))
#define P_wout_t ((u16*)(p.ws + OFF_WOUT))
#define P_wq_t ((u16*)(p.ws + OFF_WQ))
#define P_sk ((u16*)(p.ws + OFF_SK))
#define P_utab ((unsigned char*)(p.ws + OFF_UTAB))
#define P_vtab ((unsigned char*)(p.ws + OFF_VTAB))
#define P_usc ((float*)(p.ws + OFF_USC))
#define P_vsc ((float*)(p.ws + OFF_VSC))
#define P_hb ((u16*)(p.ws + OFF_X))
#define P_mix ((u16*)(p.ws + OFF_X))
#define P_ub ((u16*)(p.ws + OFF_Y))
#define P_qb ((u16*)(p.ws + OFF_Y + 34603008))
#define P_kb ((u16*)(p.ws + OFF_Y + 2 * 34603008))
#define P_vb ((u16*)(p.ws + OFF_Y + 3 * 34603008))
#define P_y1 ((_Float16*)(p.ws + OFF_Y))
#define P_r ((u16*)(p.ws + OFF_Z))
#define P_topk ((u32*)(p.ws + OFF_Z))
#define P_elist ((u32*)(p.ws + OFF_Z + 41943040))
#define P_h2 ((u16*)(p.ws + OFF_H2))

DI u32 f2bf(float x) { u32 u = __float_as_uint(x); u += 0x7fffu + ((u >> 16) & 1u); return u >> 16; }
DI u32 pack2(float lo, float hi) { return f2bf(lo) | (f2bf(hi) << 16); }
DI float bf_lo(u32 w) { return __uint_as_float(w << 16); }
DI float bf_hi(u32 w) { return __uint_as_float(w & 0xffff0000u); }
DI int get_tid() { int t = threadIdx.x; asm volatile("" : "+v"(t)); return t; }
DI int crow(int reg, int h) { return (reg & 3) + 8 * (reg >> 2) + 4 * h; }
DI float dpp_xor1(float v) { return __uint_as_float((u32)__builtin_amdgcn_mov_dpp((int)__float_as_uint(v), 0xB1, 0xF, 0xF, true)); }
DI float dpp_xor2(float v) { return __uint_as_float((u32)__builtin_amdgcn_mov_dpp((int)__float_as_uint(v), 0x4E, 0xF, 0xF, true)); }
DI float wave_sum(float v) {
#pragma unroll
  for (int o = 32; o > 2; o >>= 1) v += __shfl_xor(v, o);
  v += dpp_xor2(v);
  v += dpp_xor1(v);
  return v;
}
DI float wave_max(float v) {
#pragma unroll
  for (int o = 32; o > 0; o >>= 1) v = fmaxf(v, __shfl_xor(v, o));
  return v;
}
DI void wave_lds_sync() { asm volatile("s_waitcnt lgkmcnt(0)" ::: "memory"); }
DI uint4 pack8(const float4& a, const float4& b) {
  uint4 r; r.x = pack2(a.x, a.y); r.y = pack2(a.z, a.w); r.z = pack2(b.x, b.y); r.w = pack2(b.z, b.w); return r;
}
DI u32x4 pack8v(const f32x4& a, const f32x4& b) {
  u32x4 r; r[0] = pack2(a[0], a[1]); r[1] = pack2(a[2], a[3]); r[2] = pack2(b[0], b[1]); r[3] = pack2(b[2], b[3]); return r;
}
DI int mod_row(int tok) { return tok < TP ? (tok >> 11) : 16 + ((tok - TP) >> 5); }
DI float dot2bf(u32 a, u32 b, float acc) {
  return __builtin_amdgcn_fdot2_f32_bf16(__builtin_bit_cast(bf16x2_t, a), __builtin_bit_cast(bf16x2_t, b), acc, false);
}


#define XB_TMO      128
#define XB_XCNT(j)  (256  + 64 * (j))
#define XB_XSUB(j)  (1280 + 64 * (j))
#define XB_XGEN(j)  (2304 + 64 * (j))
#define XB_TOP      3328
#define XB_TOPGEN   3392
#define XCD_BAR_WORDS 3456
#define XB_SPIN_CAP (1u << 18)
DI unsigned xb_ld(unsigned* p)              { return __hip_atomic_load(p, __ATOMIC_RELAXED, __HIP_MEMORY_SCOPE_AGENT); }
DI unsigned xb_add(unsigned* p, unsigned v) { return __hip_atomic_fetch_add(p, v, __ATOMIC_RELAXED, __HIP_MEMORY_SCOPE_AGENT); }
DI unsigned xb_xcc_id() { return (unsigned)__builtin_amdgcn_s_getreg((3 << 11) | 20) & 0xFu; }
#define XB_SPIN(cond, bar) do { unsigned _sp = 0; while (cond) { __builtin_amdgcn_s_sleep(1); \
    if ((++_sp & 255u) == 0u) { if (xb_ld(&(bar)[XB_TMO])) break; if (_sp > XB_SPIN_CAP) { atomicAdd(&(bar)[XB_TMO], 1u); break; } } } } while (0)
struct XcdBarrier { unsigned* bar; unsigned x; volatile LAS unsigned* st; };
DI XcdBarrier xcd_barrier_post(unsigned* bar, volatile LAS unsigned* st) {
  XcdBarrier b; b.bar = bar; b.x = xb_xcc_id(); b.st = st;
  if (threadIdx.x == 0) (void)xb_add(&bar[XB_XCNT(b.x)], 1u);
  return b;
}
DI void xcd_barrier_complete(unsigned* bar, unsigned x, unsigned& nloc, unsigned& nx) {
  const unsigned G = gridDim.x * gridDim.y * gridDim.z;
  unsigned sum, cnt, mine, sp = 0u;
  for (;;) {
    sum = 0u; cnt = 0u; mine = 0u;
#pragma unroll
    for (unsigned j = 0; j < 16; ++j) { const unsigned c = xb_ld(&bar[XB_XCNT(j)]); sum += c; cnt += (c > 0u) ? 1u : 0u; mine = (j == x) ? c : mine; }
    if (sum == G) break;
    __builtin_amdgcn_s_sleep(1);
    if ((++sp & 255u) == 0u) { if (xb_ld(&bar[XB_TMO])) break; if (sp > XB_SPIN_CAP) { atomicAdd(&bar[XB_TMO], 1u); break; } }
  }
  nloc = mine > 0u ? mine : 1u; nx = cnt > 0u ? cnt : 1u;
}
DI void xcd_barrier(const XcdBarrier& b) {
  asm volatile("s_waitcnt vmcnt(0)" ::: "memory");
  __syncthreads();
  if (threadIdx.x == 0) {
    unsigned* bar = b.bar;
    __builtin_amdgcn_s_waitcnt(0);
    unsigned nloc = b.st[0], nx = b.st[1];
    if (nloc == 0u) { xcd_barrier_complete(bar, b.x, nloc, nx); b.st[0] = nloc; b.st[1] = nx; }
    const unsigned old = xb_add(&bar[XB_XSUB(b.x)], 1u);
    const unsigned gen = old / nloc;
    if (old + 1u == (gen + 1u) * nloc) {
      __builtin_amdgcn_fence(__ATOMIC_RELEASE, "agent");
      asm volatile("s_waitcnt vmcnt(0)" ::: "memory");
      const unsigned og = xb_add(&bar[XB_TOP], 1u);
      const unsigned tg = og / nx;
      if (og + 1u == (tg + 1u) * nx) xb_add(&bar[XB_TOPGEN], 1u);
      else XB_SPIN(xb_ld(&bar[XB_TOPGEN]) == tg, bar);
      __builtin_amdgcn_fence(__ATOMIC_ACQUIRE, "agent");
      xb_add(&bar[XB_XGEN(b.x)], 1u);
      asm volatile("s_waitcnt vmcnt(0)" ::: "memory");
    } else {
      XB_SPIN(xb_ld(&bar[XB_XGEN(b.x)]) == gen, bar);
      __builtin_amdgcn_fence(__ATOMIC_ACQUIRE, "agent");
      asm volatile("s_waitcnt vmcnt(0)" ::: "memory");
    }
  }
  __syncthreads();
}

DI void prep_mod(const Params& p, int item, char* smem) {
  float* sc = (float*)smem;
  float* red = (float*)(smem + 24576);
  const int tid = (get_tid() & 255), col = tid & 31, kg = tid >> 5;
  const int n0 = item * 32;
  float acc[48];
#pragma unroll
  for (int b = 0; b < 48; ++b) acc[b] = 0.f;
  for (int kc = 0; kc < 1024; kc += 128) {
    f32x4 cv[6];
#pragma unroll
    for (int j2 = 0; j2 < 6; ++j2) {
      const int b = (tid >> 5) + 8 * j2;
      const float* cp = (b < 16) ? p.c_prompt + b * 1024 : p.c_sample + (b - 16) * 1024;
      cv[j2] = *(const f32x4*)(cp + kc + (tid & 31) * 4);
    }
    float wv[16];
#pragma unroll
    for (int i = 0; i < 16; ++i) wv[i] = p.w_ada[(size_t)(kc + kg * 16 + i) * 6144 + n0 + col];
    __syncthreads();
#pragma unroll
    for (int j2 = 0; j2 < 6; ++j2) {
      const int b = (tid >> 5) + 8 * j2;
#pragma unroll
      for (int e = 0; e < 4; ++e) {
        const float c = cv[j2][e];
        sc[((tid & 31) * 4 + e) * 48 + b] = c / (1.f + __expf(-c));
      }
    }
    __syncthreads();
#pragma unroll
    for (int i = 0; i < 16; ++i) {
      const int kk = kg * 16 + i;
      const float w = wv[i];
      const float4* s4 = (const float4*)(sc + kk * 48);
#pragma unroll
      for (int q = 0; q < 12; ++q) {
        const float4 sv = s4[q];
        acc[4 * q + 0] += sv.x * w; acc[4 * q + 1] += sv.y * w; acc[4 * q + 2] += sv.z * w; acc[4 * q + 3] += sv.w * w;
      }
    }
  }
  __syncthreads();
#pragma unroll
  for (int b = 0; b < 48; ++b) red[(kg * 48 + b) * 32 + col] = acc[b];
  __syncthreads();
  for (int i = tid; i < 1536; i += 256) {
    const int b = i >> 5, c = i & 31;
    float sum = 0.f;
#pragma unroll
    for (int g = 0; g < 8; ++g) sum += red[(g * 48 + b) * 32 + c];
    P_mod[b * 6144 + n0 + c] = sum + p.b_ada[n0 + c];
  }
}

DI void prep_transpose(const float* __restrict__ W, int N, u16* __restrict__ Wt, int tile, bool conv_perm, char* smem) {
  float* ts = (float*)smem;
  const int tid = (get_tid() & 255);
  const int nT = N >> 6;
  const int kt = tile / nT, nt = tile - kt * nT;
  __syncthreads();
#pragma unroll
  for (int j = 0; j < 4; ++j) {
    const int kr = (tid >> 4) + 16 * j, c4 = (tid & 15) * 4;
    const float4 v = *(const float4*)(W + (size_t)(kt * 64 + kr) * N + nt * 64 + c4);
    ts[kr * 65 + c4 + 0] = v.x; ts[kr * 65 + c4 + 1] = v.y; ts[kr * 65 + c4 + 2] = v.z; ts[kr * 65 + c4 + 3] = v.w;
  }
  __syncthreads();
  const int n = tid >> 2, k0 = (tid & 3) * 16;
  u32 w[8];
#pragma unroll
  for (int i = 0; i < 8; ++i) w[i] = pack2(ts[(k0 + 2 * i) * 65 + n], ts[(k0 + 2 * i + 1) * 65 + n]);
  int nn = nt * 64 + n;
  if (conv_perm && nn < 1024) { const int c = nn & 511, isb = nn >> 9; nn = (c >> 5) * 64 + isb * 32 + (c & 31); }
  uint4* dst = (uint4*)(Wt + (size_t)nn * 1024 + kt * 64 + k0);
  dst[0] = make_uint4(w[0], w[1], w[2], w[3]);
  dst[1] = make_uint4(w[4], w[5], w[6], w[7]);
}

DI void prep_convert(const float* __restrict__ src, u16* __restrict__ dst, size_t base) {
  const int tid = (get_tid() & 255);
#pragma unroll
  for (int j = 0; j < 4; ++j) {
    const size_t e = base + (size_t)(j * 256 + tid) * 8;
    const float4 a = *(const float4*)(src + e), b = *(const float4*)(src + e + 4);
    *(uint4*)(dst + e) = pack8(a, b);
  }
}


DI void prep_row_fp6(const float* __restrict__ src, unsigned char* __restrict__ dst, float* __restrict__ scl, int row, int lane) {
  const int l5 = lane & 31;
  const float* rp = src + (size_t)row * 1024;
  f32x4 v[8];
#pragma unroll
  for (int j = 0; j < 8; ++j) v[j] = *(const f32x4*)(rp + 128 * j + 4 * l5);
  float am = 0.f;
#pragma unroll
  for (int j = 0; j < 8; ++j) am = fmaxf(am, fmaxf(fmaxf(fabsf(v[j][0]), fabsf(v[j][1])), fmaxf(fabsf(v[j][2]), fabsf(v[j][3]))));
#pragma unroll
  for (int m = 16; m > 0; m >>= 1) am = fmaxf(am, __shfl_xor(am, m));
  const float sc = am > 0.f ? am * (1.f / 7.f) : 1.f;
  const float inv = 1.f / sc;
  f32x16 lo, hi;
#pragma unroll
  for (int m = 0; m < 16; ++m) { lo[m] = v[m >> 1][2 * (m & 1)] * inv; hi[m] = v[m >> 1][2 * (m & 1) + 1] * inv; }
  const u32x6 q = __builtin_amdgcn_cvt_scalef32_2xpk16_fp6_f32(lo, hi, 1.0f);
  unsigned char* rd = dst + (size_t)row * 768;
  *(u32x4*)(rd + 16 * l5) = u32x4{q[0], q[1], q[2], q[3]};
  *(u32x2*)(rd + 512 + 8 * l5) = u32x2{q[4], q[5]};
  if (l5 == 0) scl[row] = sc;
}

DI void prep_rope(const Params& p, int item) {
  const int idx = item * 256 + (get_tid() & 255);
  if (idx >= 2080 * 32) return;
  const int pos = idx >> 5, d = idx & 31;
  double inv = 1.0;
  for (int i = 0; i < d; ++i) inv *= 0.74989420933245582730;
  const double a = (double)pos * inv;
  const double n = rint(a * 0.63661977236758134308);
  const double r = (a - n * 1.57079632673412561417e+00) - n * 6.07710050650619224932e-11;
  const int q = ((int)n) & 3;
  const double r2 = r * r;
  const double sp = r * (1.0 + r2 * (-1.0 / 6 + r2 * (1.0 / 120 + r2 * (-1.0 / 5040 + r2 * (1.0 / 362880 + r2 * (-1.0 / 39916800 + r2 * (1.0 / 6227020800.0)))))));
  const double cp = 1.0 + r2 * (-0.5 + r2 * (1.0 / 24 + r2 * (-1.0 / 720 + r2 * (1.0 / 40320 + r2 * (-1.0 / 3628800 + r2 * (1.0 / 479001600.0 + r2 * (-1.0 / 87178291200.0)))))));
  double s, c;
  if (q == 0) { s = sp; c = cp; } else if (q == 1) { s = cp; c = -sp; } else if (q == 2) { s = -sp; c = -cp; } else { s = -cp; c = sp; }
  P_rope[idx] = make_float2((float)c, (float)s);
}

DI void phaseA(const Params& p, char* smem) {
  const int hbk = get_tid() >> 8;
  char* sm = smem + hbk * HB_LDS;
  const int total = 1894 + 4096;
  int nxt = 0;
  if (get_tid() == 0) nxt = (int)atomicAdd(P_counters + 32, 1u);
  for (;;) {
    __syncthreads();
    if (get_tid() == 0) *(volatile int*)(smem + SMEM_CTRL) = nxt;
    __syncthreads();
    const int pair = *(volatile int*)(smem + SMEM_CTRL);
    if (pair * 2 >= total) break;
    if (get_tid() == 0) nxt = (int)atomicAdd(P_counters + 32, 1u);
    const int item = pair * 2 + hbk;
    if (item < 192) prep_mod(p, item, sm);
    else if (item < 832) prep_transpose(p.w_in, 2560, P_win_t, item - 192, true, sm);
    else if (item < 1088) prep_transpose(p.w_out, 1024, P_wout_t, item - 832, false, sm);
    else if (item < 1600) prep_transpose(p.w_query, 2048, P_wq_t, item - 1088, false, sm);
    else if (item < 1632) prep_convert(p.sub_keys, P_sk, (size_t)(item - 1600) * 8192);
    else if (item < 1892) prep_rope(p, item - 1632);
    else if (item < 1894) {
      const int l = get_tid() & 255;
      if (item == 1892 && l < 64) {
        const float s1 = wave_sum(p.lam_q1[l] * p.lam_k1[l]);
        const float s2 = wave_sum(p.lam_q2[l] * p.lam_k2[l]);
        if (l == 0) P_misc[0] = expf(s1) - expf(s2) + LAM_INIT;
      }
      if (item == 1892 && l >= 64 && l < 128) {
        const float rep[16] = {0.125f, 0.25f, 0.375f, 0.5f, 0.75f, 1.0f, 1.25f, 1.5f, 1.75f, 2.0f, 2.5f, 3.0f, 3.5f, 4.0f, 5.0f, 7.0f};
        f32x16 lo, hi;
#pragma unroll
        for (int q = 0; q < 16; ++q) { lo[q] = (q & 1) ? -rep[q >> 1] : rep[q >> 1]; hi[q] = (q & 1) ? -rep[8 + (q >> 1)] : rep[8 + (q >> 1)]; }
        const u32x6 qq = __builtin_amdgcn_cvt_scalef32_2xpk16_fp6_f32(lo, hi, 1.0f);
        const f32x32 f = __builtin_amdgcn_cvt_scalef32_pk32_f32_fp6(qq, 1.0f);
        bool ok = true;
#pragma unroll
        for (int q = 0; q < 16; ++q) ok = ok && (f[2 * q] == lo[q]) && (f[2 * q + 1] == hi[q]);
        if (l == 64) P_misc[1] = ok ? 0.f : 1.f;
      }
    } else {
      const int it = item - 1894;
      const int tid = get_tid() & 255, lane = tid & 63, wave = tid >> 6;
      if (it < 2048) prep_row_fp6(p.u_tab, P_utab, P_usc, it * 8 + wave * 2 + (lane >> 5), lane);
      else prep_row_fp6(p.v_tab, P_vtab, P_vsc, (it - 2048) * 8 + wave * 2 + (lane >> 5), lane);
    }
  }
}

DI void phaseA2(const Params& p) {
  const int tid = get_tid(), lane = tid & 63;
  const int gw = (tid >> 6) * gridDim.x + blockIdx.x, nw = gridDim.x * 8;
  for (int tok0 = gw; tok0 < T; tok0 += 2 * nw) {
    f32x4 x[2][4];
    int tk[2];
#pragma unroll
    for (int u = 0; u < 2; ++u) {
      const int tok = tok0 + u * nw < T ? tok0 + u * nw : tok0;
      tk[u] = tok;
      const float* xr = tok < TP ? p.x_prompt + (size_t)tok * 1024 : p.x_sample + (size_t)(tok - TP) * 1024;
#pragma unroll
      for (int hf = 0; hf < 2; ++hf) {
        x[u][2 * hf] = *(const f32x4*)(xr + hf * 512 + lane * 8);
        x[u][2 * hf + 1] = *(const f32x4*)(xr + hf * 512 + lane * 8 + 4);
      }
    }
#pragma unroll
    for (int u = 0; u < 2; ++u) {
      const float* mr = P_mod + mod_row(tk[u]) * 6144;
#pragma unroll
      for (int hf = 0; hf < 2; ++hf) {
        const int c = hf * 512 + lane * 8;
        const f32x4 h0 = *(const f32x4*)(mr + c), h1 = *(const f32x4*)(mr + c + 4);
        const f32x4 s0 = *(const f32x4*)(mr + 1024 + c), s1 = *(const f32x4*)(mr + 1024 + c + 4);
        f32x4 a = x[u][2 * hf], b = x[u][2 * hf + 1];
#pragma unroll
        for (int e = 0; e < 4; ++e) { a[e] = a[e] * (1.f + s0[e]) + h0[e]; b[e] = b[e] * (1.f + s1[e]) + h1[e]; }
        *(u32x4*)(P_hb + (size_t)tk[u] * 1024 + c) = pack8v(a, b);
      }
    }
  }
}

namespace g8 {
constexpr int BK = 64, HALF = 128, HTB = HALF * BK * 2, KD = 1024;
DI int lds_byte(int r, int c) { const int st = (r >> 4) * 2 + (c >> 5), rr = r & 15, cc = c & 31, ob = rr * 64 + cc * 2; return st * 1024 + (ob ^ (((ob >> 9) & 1) << 5)); }
DI void stage_rc(int b, int& R, int& C) { const int st = b / 1024, sb = b % 1024, swz = sb ^ (((sb >> 9) & 1) << 5); R = (st >> 1) * 16 + swz / 64; C = (st & 1) * 32 + (swz % 64) / 2; }
DI void gemm256(const u16* __restrict__ A, const u16* __restrict__ Bt, int brow, int bcol, char* shm, f32x4 (&acc)[2][2][4][2]) {
  const int tid = get_tid();
  const int wid = __builtin_amdgcn_readfirstlane(tid >> 6), lane = tid & 63, wr = wid >> 2, wc = wid & 3, fr = lane & 15, fq = lane >> 4;
#define SA(b, h) (shm + ((b) * 2 + (h)) * HTB)
#define SB(b, h) (shm + (4 + (b) * 2 + (h)) * HTB)
#define STAGE(P, BASE, br, kt) do { const u16* _gb = (BASE) + ((size_t)(br) * KD + (size_t)(kt) * BK); \
    __builtin_amdgcn_global_load_lds((const GAS unsigned*)(_gb + toff0), (LAS unsigned*)((P) + tid * 16), 16, 0, 0); \
    __builtin_amdgcn_global_load_lds((const GAS unsigned*)(_gb + 64 * KD + toff0), (LAS unsigned*)((P) + tid * 16 + 8192), 16, 0, 0); } while (0)
#define LDA(dst, b, h) _Pragma("unroll") for (int m = 0; m < 4; ++m) _Pragma("unroll") for (int k = 0; k < 2; ++k) \
    dst[m][k] = *(const bf16x8*)(SA(b, h) + lds_byte(wr * 64 + m * 16 + fr, k * 32 + fq * 8))
#define LDB(dst, b, h) _Pragma("unroll") for (int n = 0; n < 2; ++n) _Pragma("unroll") for (int k = 0; k < 2; ++k) \
    dst[n][k] = *(const bf16x8*)(SB(b, h) + lds_byte(wc * 32 + n * 16 + fr, k * 32 + fq * 8))
#define MMA(ai, bj, At_, Bt_) do { __builtin_amdgcn_s_setprio(1); \
    _Pragma("unroll") for (int m = 0; m < 4; ++m) _Pragma("unroll") for (int n = 0; n < 2; ++n) _Pragma("unroll") for (int k = 0; k < 2; ++k) \
      acc[ai][bj][m][n] = __builtin_amdgcn_mfma_f32_16x16x32_bf16(At_[m][k], Bt_[n][k], acc[ai][bj][m][n], 0, 0, 0); \
    __builtin_amdgcn_s_setprio(0); } while (0)
#define WAIT_V(n) asm volatile("s_waitcnt vmcnt(" #n ")" ::: "memory")
#define WAIT_L(n) asm volatile("s_waitcnt lgkmcnt(" #n ")" ::: "memory")
#define BAR __builtin_amdgcn_s_barrier()
#define SCHED __builtin_amdgcn_sched_barrier(0)
#pragma unroll
  for (int a = 0; a < 2; ++a)
#pragma unroll
    for (int b = 0; b < 2; ++b)
#pragma unroll
      for (int m = 0; m < 4; ++m)
#pragma unroll
        for (int n = 0; n < 2; ++n) acc[a][b][m][n] = f32x4{0.f, 0.f, 0.f, 0.f};
  bf16x8 At[4][2], B0[2][2], B1[2][2];
  constexpr int nt = KD / BK;
  unsigned toff0;
  { int r_, c_; stage_rc(tid * 16, r_, c_); toff0 = (unsigned)(r_ * KD + c_); }
  STAGE(SB(0, 0), Bt, bcol, 0); STAGE(SA(0, 0), A, brow, 0);
  STAGE(SB(0, 1), Bt, bcol + HALF, 0); STAGE(SA(0, 1), A, brow + HALF, 0);
  if (wr == 1) BAR;
  WAIT_V(4); BAR;
  STAGE(SB(1, 0), Bt, bcol, 1); STAGE(SA(1, 0), A, brow, 1); STAGE(SB(1, 1), Bt, bcol + HALF, 1);
  WAIT_V(6); BAR;
#pragma unroll 1
  for (int t = 0; t < nt - 2; t += 2) {
    LDB(B0, 0, 0); SCHED; LDA(At, 0, 0); STAGE(SA(1, 1), A, brow + HALF, t + 1);
    WAIT_L(8); BAR; WAIT_L(0); MMA(0, 0, At, B0); BAR; SCHED;
    LDB(B1, 0, 1); STAGE(SB(0, 0), Bt, bcol, t + 2);
    BAR; WAIT_L(0); MMA(0, 1, At, B1); BAR;
    LDA(At, 0, 1); STAGE(SA(0, 0), A, brow, t + 2);
    BAR; WAIT_L(0); MMA(1, 0, At, B0); BAR; SCHED;
    STAGE(SB(0, 1), Bt, bcol + HALF, t + 2);
    WAIT_V(6); BAR; MMA(1, 1, At, B1); BAR;
    LDB(B0, 1, 0); SCHED; LDA(At, 1, 0); STAGE(SA(0, 1), A, brow + HALF, t + 2);
    WAIT_L(8); BAR; WAIT_L(0); MMA(0, 0, At, B0); BAR; SCHED;
    LDB(B1, 1, 1); STAGE(SB(1, 0), Bt, bcol, t + 3);
    BAR; WAIT_L(0); MMA(0, 1, At, B1); BAR;
    LDA(At, 1, 1); STAGE(SA(1, 0), A, brow, t + 3);
    BAR; WAIT_L(0); MMA(1, 0, At, B0); BAR; SCHED;
    STAGE(SB(1, 1), Bt, bcol + HALF, t + 3);
    WAIT_V(6); BAR; MMA(1, 1, At, B1); BAR;
  }
  { LDB(B0, 0, 0); LDA(At, 0, 0); STAGE(SA(1, 1), A, brow + HALF, nt - 1);
    BAR; WAIT_L(0); MMA(0, 0, At, B0); BAR;
    LDB(B1, 0, 1); BAR; WAIT_L(0); MMA(0, 1, At, B1); BAR;
    LDA(At, 0, 1); WAIT_V(4); BAR; WAIT_L(0); MMA(1, 0, At, B0); MMA(1, 1, At, B1); BAR; }
  { LDB(B0, 1, 0); LDA(At, 1, 0); WAIT_V(2); BAR; WAIT_L(0); MMA(0, 0, At, B0); BAR;
    LDB(B1, 1, 1); WAIT_V(0); BAR; WAIT_L(0); MMA(0, 1, At, B1); BAR;
    LDA(At, 1, 1); BAR; WAIT_L(0); MMA(1, 0, At, B0); MMA(1, 1, At, B1); BAR; }
  if (wr == 0) BAR;
#undef SA
#undef SB
#undef STAGE
#undef LDA
#undef LDB
#undef MMA
#undef WAIT_V
#undef WAIT_L
#undef BAR
#undef SCHED
}
}

DI bool unit_of(int L, int nM, int nN, int& pm, int& pn) {
  const int nwg = nM * nN;
  if (L >= nwg) return false;
  int wgid = L;
  { const int q = nwg / 8, r = nwg % 8, xcd = wgid % 8, off = wgid / 8; wgid = (xcd < r ? xcd * (q + 1) : r * (q + 1) + (xcd - r) * q) + off; }
  const int nig = 8 * nN, gid = wgid / nig, fm = gid * 8, gsz = (nM - fm) < 8 ? (nM - fm) : 8;
  pm = fm + ((wgid % nig) % gsz); pn = (wgid % nig) / gsz;
  return true;
}
DI void quad_to_lds_f32(const f32x4 (&acc)[2][2][4][2], int bj, char* smem) {
  const int tid = get_tid(), wid = tid >> 6, lane = tid & 63, wr = wid >> 2, wc = wid & 3, fr = lane & 15, fq = lane >> 4;
#pragma unroll
  for (int ai = 0; ai < 2; ++ai) {
    float* Ct = (float*)(smem + ai * HB_LDS);
#pragma unroll
    for (int m = 0; m < 4; ++m)
#pragma unroll
      for (int n = 0; n < 2; ++n)
        *(f32x4*)(Ct + (wc * 32 + n * 16 + fr) * 132 + wr * 64 + m * 16 + fq * 4) = acc[ai][bj][m][n];
  }
}

DI void gemm_tile(const u16* __restrict__ A, const u16* __restrict__ Bt, int m0, int n0, char* smem, f32x16 (&acc)[2][2], int khalf) {
  constexpr int KD = 1024, NK = KD / 128;
  const int tid = get_tid() & 255, lane = tid & 63, wave = tid >> 6, wm = wave >> 1, wn = wave & 1;
  const int r = lane & 31, h = lane >> 5;
  char* As = smem;
  char* Bs = smem + 18432;
  const int lrow = tid >> 3, kc = tid & 7;
  const u16* ag = A + (size_t)(m0 + lrow) * KD + kc * 8 + khalf * 512;
  const u16* bg = Bt + (size_t)(n0 + lrow) * KD + kc * 8 + khalf * 512;
  u32x4 ra0[4], rb0[4], ra1[4], rb1[4];
  {
#pragma unroll
    for (int j = 0; j < 4; ++j) {
      ra0[j] = *(const u32x4*)(ag + (size_t)j * 32 * KD);
      rb0[j] = *(const u32x4*)(bg + (size_t)j * 32 * KD);
    }
#pragma unroll
    for (int j = 0; j < 4; ++j) {
      ra1[j] = *(const u32x4*)(ag + (size_t)j * 32 * KD + 64);
      rb1[j] = *(const u32x4*)(bg + (size_t)j * 32 * KD + 64);
    }
  }
#pragma unroll
  for (int mi = 0; mi < 2; ++mi)
#pragma unroll
    for (int ni = 0; ni < 2; ++ni)
#pragma unroll
      for (int i = 0; i < 16; ++i) acc[mi][ni][i] = 0.f;
  const char* ap = As + (wm * 64 + r) * 144 + h * 16;
  const char* bp = Bs + (wn * 64 + r) * 144 + h * 16;
  char* aw = As + lrow * 144 + kc * 16;
  char* bw = Bs + lrow * 144 + kc * 16;
#define GEMM_STEP(RA, RB, KT)                                                                   \
  {                                                                                             \
    __syncthreads();                                                                            \
    _Pragma("unroll") for (int j = 0; j < 4; ++j) {  \
      *(u32x4*)(aw + j * 32 * 144) = RA[j];                                                     \
      *(u32x4*)(bw + j * 32 * 144) = RB[j];                                                     \
    }                                                                                           \
    __syncthreads();                                                                            \
    if ((KT) + 2 < NK) {                                                                        \
      _Pragma("unroll") for (int j = 0; j < 4; ++j) {                                           \
        RA[j] = *(const u32x4*)(ag + (size_t)j * 32 * KD + ((KT) + 2) * 64);                    \
        RB[j] = *(const u32x4*)(bg + (size_t)j * 32 * KD + ((KT) + 2) * 64);                    \
      }                                                                                         \
    }                                                                                           \
    __builtin_amdgcn_sched_barrier(0);                                                          \
    _Pragma("unroll") for (int ks = 0; ks < 4; ++ks) {                                          \
      const bf16x8 a0 = *(const bf16x8*)(ap + ks * 32), a1 = *(const bf16x8*)(ap + 32 * 144 + ks * 32); \
      const bf16x8 b0 = *(const bf16x8*)(bp + ks * 32), b1 = *(const bf16x8*)(bp + 32 * 144 + ks * 32); \
      acc[0][0] = MFMA32(a0, b0, acc[0][0]);                                                    \
      acc[0][1] = MFMA32(a0, b1, acc[0][1]);                                                    \
      acc[1][0] = MFMA32(a1, b0, acc[1][0]);                                                    \
      acc[1][1] = MFMA32(a1, b1, acc[1][1]);                                                    \
    }                                                                                           \
  }
#pragma unroll 1
  for (int kt = 0; kt < NK; kt += 2) {
    GEMM_STEP(ra0, rb0, kt)
    GEMM_STEP(ra1, rb1, kt + 1)
  }
#undef GEMM_STEP
}


DI void kadd(f32x16 (&acc)[2][2], char* smem, int hbk, int lt) {
  float* Pf = (float*)(smem + HB_LDS);
  const int lane = lt & 63, wave = lt >> 6;
  __syncthreads();
  if (hbk == 1) {
#pragma unroll
    for (int mi = 0; mi < 2; ++mi)
#pragma unroll
      for (int ni = 0; ni < 2; ++ni)
#pragma unroll
        for (int i = 0; i < 16; ++i) Pf[(wave * 64 + (mi * 2 + ni) * 16 + i) * 64 + lane] = acc[mi][ni][i];
  }
  __syncthreads();
  if (hbk == 0) {
#pragma unroll
    for (int mi = 0; mi < 2; ++mi)
#pragma unroll
      for (int ni = 0; ni < 2; ++ni)
#pragma unroll
        for (int i = 0; i < 16; ++i) acc[mi][ni][i] += Pf[(wave * 64 + (mi * 2 + ni) * 16 + i) * 64 + lane];
  }
}

DI bool leftover_quad(int q, int nM, int nN, int& pm, int& pn, int& ai, int& bj) {
  const int G = (int)gridDim.x, nwg = nM * nN, nfull = nwg / G, nl = nwg - nfull * G;
  if (q >= 4 * nl) return false;
  ai = (q >> 1) & 1; bj = q & 1;
  return unit_of(nfull * G + (q >> 2), nM, nN, pm, pn);
}

DI void b_rowpass(const Params& p, const float* Ct, int m0, int n0, int lt) {
#pragma unroll 2
    for (int it = 0; it < 4; ++it) {
      const int idx = it * 256 + lt;
      const int j = idx & 3, g = (idx >> 2) & 1, row = idx >> 3;
      const int grow = m0 + row;
      const float* cp = Ct + row * 132 + g * 64 + 8 * j;
      f32x4 x1a = *(const f32x4*)cp, x1b = *(const f32x4*)(cp + 4), x2a = *(const f32x4*)(cp + 32), x2b = *(const f32x4*)(cp + 36);
      const int vc = n0 + g * 64 + 8 * j;
      if (n0 < 1024) {
        const int ca = (vc >> 6) * 32 + 8 * j;
        const f32x4 ba0 = *(const f32x4*)(p.b_in + ca), ba1 = *(const f32x4*)(p.b_in + ca + 4);
        const f32x4 bb0 = *(const f32x4*)(p.b_in + 512 + ca), bb1 = *(const f32x4*)(p.b_in + 512 + ca + 4);
        f32x4 u0, u1;
#pragma unroll
        for (int e = 0; e < 4; ++e) {
          u0[e] = (x1a[e] + ba0[e]) / (1.f + __expf(-(x2a[e] + bb0[e])));
          u1[e] = (x1b[e] + ba1[e]) / (1.f + __expf(-(x2b[e] + bb1[e])));
        }
        *(u32x4*)(P_ub + (size_t)grow * 512 + ca) = pack8v(u0, u1);
        float* cs = nullptr;
        if (grow < TP) { const int s = grow & 2047; if (s >= 2018) cs = P_conv_prompt + ((size_t)(grow >> 11) * 30 + (s - 2018)) * 512 + ca; }
        else { const int rs = grow - TP, s = rs & 31; if (s >= 2) cs = P_conv_sample + ((size_t)(rs >> 5) * 30 + (s - 2)) * 512 + ca; }
        if (cs) { *(f32x4*)cs = u0; *(f32x4*)(cs + 4) = u1; }
      } else {
        const f32x4 b1a = *(const f32x4*)(p.b_in + vc), b1b = *(const f32x4*)(p.b_in + vc + 4);
        const f32x4 b2a = *(const f32x4*)(p.b_in + vc + 32), b2b = *(const f32x4*)(p.b_in + vc + 36);
#pragma unroll
        for (int e = 0; e < 4; ++e) { x1a[e] += b1a[e]; x1b[e] += b1b[e]; x2a[e] += b2a[e]; x2b[e] += b2b[e]; }
        if (n0 < 2048) {
          const int pos = grow < TP ? (grow & 2047) : 2048 + ((grow - TP) & 31);
          const f32x4* rp = (const f32x4*)(P_rope + pos * 32 + 8 * j);
          const f32x4 r0 = rp[0], r1 = rp[1], r2 = rp[2], r3 = rp[3];
          f32x4 o1a, o1b, o2a, o2b;
          o1a[0] = x1a[0] * r0[0] - x2a[0] * r0[1]; o2a[0] = x2a[0] * r0[0] + x1a[0] * r0[1];
          o1a[1] = x1a[1] * r0[2] - x2a[1] * r0[3]; o2a[1] = x2a[1] * r0[2] + x1a[1] * r0[3];
          o1a[2] = x1a[2] * r1[0] - x2a[2] * r1[1]; o2a[2] = x2a[2] * r1[0] + x1a[2] * r1[1];
          o1a[3] = x1a[3] * r1[2] - x2a[3] * r1[3]; o2a[3] = x2a[3] * r1[2] + x1a[3] * r1[3];
          o1b[0] = x1b[0] * r2[0] - x2b[0] * r2[1]; o2b[0] = x2b[0] * r2[0] + x1b[0] * r2[1];
          o1b[1] = x1b[1] * r2[2] - x2b[1] * r2[3]; o2b[1] = x2b[1] * r2[2] + x1b[1] * r2[3];
          o1b[2] = x1b[2] * r3[0] - x2b[2] * r3[1]; o2b[2] = x2b[2] * r3[0] + x1b[2] * r3[1];
          o1b[3] = x1b[3] * r3[2] - x2b[3] * r3[3]; o2b[3] = x2b[3] * r3[2] + x1b[3] * r3[3];
          x1a = o1a; x1b = o1b; x2a = o2a; x2b = o2b;
        }
        const bool isq = n0 < 1536, isk = !isq && n0 < 2048;
        const int col = vc - (isq ? 1024 : (isk ? 1536 : 2048));
        u16* db = (isq ? P_qb : (isk ? P_kb : P_vb)) + (size_t)grow * 512 + col;
        *(u32x4*)db = pack8v(x1a, x1b);
        *(u32x4*)(db + 32) = pack8v(x2a, x2b);
        if (!isq) {
          float* fo = (isk ? (grow < TP ? P_k_prompt + (size_t)grow * 512 : P_k_sample + (size_t)(grow - TP) * 512)
                           : (grow < TP ? P_v_prompt + (size_t)grow * 512 : P_v_sample + (size_t)(grow - TP) * 512)) + col;
          *(f32x4*)fo = x1a; *(f32x4*)(fo + 4) = x1b; *(f32x4*)(fo + 32) = x2a; *(f32x4*)(fo + 36) = x2b;
        }
      }
    }
}

DI void phaseB(const Params& p, char* smem) {
  const int nfull = (132 * 10) / (int)gridDim.x;
  for (int i = 0; i < nfull; ++i) {
    int pm, pn;
    if (!unit_of(i * (int)gridDim.x + (int)blockIdx.x, 132, 10, pm, pn)) break;
    f32x4 acc[2][2][4][2];
    __syncthreads();
    g8::gemm256(P_win_t, P_hb, pn * 256, pm * 256, smem, acc);
#pragma unroll
    for (int bj = 0; bj < 2; ++bj) {
      __syncthreads();
      quad_to_lds_f32(acc, bj, smem);
      __syncthreads();
      const int t2 = get_tid(), hbk = t2 >> 8;
      b_rowpass(p, (const float*)(smem + hbk * HB_LDS), pm * 256 + bj * 128, pn * 256 + hbk * 128, t2 & 255);
    }
  }
  for (int q = (int)blockIdx.x;; q += (int)gridDim.x) {
    int pm, pn, ai, bj;
    if (!leftover_quad(q, 132, 10, pm, pn, ai, bj)) break;
    {
      const int t2 = get_tid(), hbk = t2 >> 8, lt = t2 & 255, lane = lt & 63, wave = lt >> 6, wm = wave >> 1, wn = wave & 1, r = lane & 31, h = lane >> 5;
      char* sm = smem + hbk * HB_LDS;
      const int m0 = pm * 256 + ai * 128, n0 = pn * 256 + bj * 128;
      const bool act = hbk == 0;
      f32x16 acc[2][2];
      gemm_tile(P_hb, P_win_t, m0, n0, sm, acc, hbk);
      kadd(acc, smem, hbk, lt);
      __syncthreads();
      float* Ct = (float*)sm;
#pragma unroll
      for (int mi = 0; mi < 2; ++mi)
#pragma unroll
        for (int ni = 0; ni < 2; ++ni)
#pragma unroll
          for (int i = 0; i < 16; ++i) Ct[(wm * 64 + mi * 32 + crow(i, h)) * 132 + wn * 64 + ni * 32 + r] = acc[mi][ni][i];
      __syncthreads();
      if (act) b_rowpass(p, Ct, m0, n0, lt);
    }
  }
}

DI bf16x8 pack_frag(const f32x16& x, int s) {
  u32x4 o;
  if (s == 0)
    asm volatile("v_cvt_pk_bf16_f32 %0, %4, %5\n\tv_cvt_pk_bf16_f32 %1, %6, %7\n\tv_cvt_pk_bf16_f32 %2, %8, %9\n\tv_cvt_pk_bf16_f32 %3, %10, %11\n\ts_nop 1"
                 : "=&v"(o[0]), "=&v"(o[1]), "=&v"(o[2]), "=&v"(o[3])
                 : "v"(x[0]), "v"(x[1]), "v"(x[2]), "v"(x[3]), "v"(x[4]), "v"(x[5]), "v"(x[6]), "v"(x[7]));
  else
    asm volatile("v_cvt_pk_bf16_f32 %0, %4, %5\n\tv_cvt_pk_bf16_f32 %1, %6, %7\n\tv_cvt_pk_bf16_f32 %2, %8, %9\n\tv_cvt_pk_bf16_f32 %3, %10, %11\n\ts_nop 1"
                 : "=&v"(o[0]), "=&v"(o[1]), "=&v"(o[2]), "=&v"(o[3])
                 : "v"(x[8]), "v"(x[9]), "v"(x[10]), "v"(x[11]), "v"(x[12]), "v"(x[13]), "v"(x[14]), "v"(x[15]));
  return __builtin_bit_cast(bf16x8, o);
}

DI void attn_tile_compute(char* smem, int pm, const bf16x8 (&qf)[4], f32x16 (&O)[4], float& m_run, float& l_run, bool mask_hi, int lane) {
  const int r = lane & 31, h = lane >> 5;
  const char* Kp = smem + pm * 9216 + r * 144 + h * 16;
  f32x16 s0, s1;
#pragma unroll
  for (int i = 0; i < 16; ++i) { s0[i] = 0.f; s1[i] = 0.f; }
#pragma unroll
  for (int ks = 0; ks < 4; ++ks) {
    const bf16x8 k0 = *(const bf16x8*)(Kp + ks * 32), k1 = *(const bf16x8*)(Kp + 32 * 144 + ks * 32);
    s0 = MFMA32(k0, qf[ks], s0);
    s1 = MFMA32(k1, qf[ks], s1);
  }
  if (mask_hi) {
#pragma unroll
    for (int i = 0; i < 16; ++i) s1[i] = -INFINITY;
  }
  float mx = s0[0];
#pragma unroll
  for (int i = 1; i < 16; ++i) mx = fmaxf(mx, s0[i]);
#pragma unroll
  for (int i = 0; i < 16; ++i) mx = fmaxf(mx, s1[i]);
  mx = fmaxf(mx, __shfl_xor(mx, 32));
  const float m_new = fmaxf(m_run, mx);
  const float c = 0.125f * 1.4426950408889634f;
  const float alpha = __builtin_amdgcn_exp2f((m_run - m_new) * c);
  const float mc = m_new * c;
  float rs = 0.f;
#pragma unroll
  for (int i = 0; i < 16; ++i) { s0[i] = __builtin_amdgcn_exp2f(s0[i] * c - mc); rs += s0[i]; }
#pragma unroll
  for (int i = 0; i < 16; ++i) { s1[i] = __builtin_amdgcn_exp2f(s1[i] * c - mc); rs += s1[i]; }
  rs += __shfl_xor(rs, 32);
  l_run = l_run * alpha + rs;
  if (__builtin_amdgcn_ballot_w64(m_new != m_run) != 0ull) {
#pragma unroll
    for (int d = 0; d < 4; ++d)
#pragma unroll
      for (int i = 0; i < 16; ++i) O[d][i] *= alpha;
  }
  m_run = m_new;
  bf16x8 pf[4];
  pf[0] = pack_frag(s0, 0); pf[1] = pack_frag(s0, 1); pf[2] = pack_frag(s1, 0); pf[3] = pack_frag(s1, 1);
  const int q4 = (lane & 15) >> 2, p4 = lane & 3, blk = (lane >> 4) & 1;
  const unsigned vbase = (unsigned)(size_t)(smem + 18432) + (4 * h + q4) * 320 + (16 * blk + 4 * p4) * 2;
  s16x4 va[8], vb[8];
#define TR_ISSUE(R, ADDR)                                                                                        \
  asm volatile("ds_read_b64_tr_b16 %0, %8\n\tds_read_b64_tr_b16 %1, %8 offset:2560\n\t"                          \
               "ds_read_b64_tr_b16 %2, %8 offset:64\n\tds_read_b64_tr_b16 %3, %8 offset:2624\n\t"                 \
               "ds_read_b64_tr_b16 %4, %8 offset:128\n\tds_read_b64_tr_b16 %5, %8 offset:2688\n\t"                \
               "ds_read_b64_tr_b16 %6, %8 offset:192\n\tds_read_b64_tr_b16 %7, %8 offset:2752"                    \
               : "=&v"(R[0]), "=&v"(R[1]), "=&v"(R[2]), "=&v"(R[3]), "=&v"(R[4]), "=&v"(R[5]), "=&v"(R[6]), "=&v"(R[7]) \
               : "v"(ADDR) : "memory")
#define TR_WAIT(R, N)                                                                                            \
  asm volatile("s_waitcnt lgkmcnt(" #N ")"                                                                       \
               : "+v"(R[0]), "+v"(R[1]), "+v"(R[2]), "+v"(R[3]), "+v"(R[4]), "+v"(R[5]), "+v"(R[6]), "+v"(R[7]) :: "memory")
#define PV_MFMA(R, KK)                                                                                           \
  O[0] = MFMA32(__builtin_shufflevector(R[0], R[1], 0, 1, 2, 3, 4, 5, 6, 7), pf[KK], O[0]);                      \
  O[1] = MFMA32(__builtin_shufflevector(R[2], R[3], 0, 1, 2, 3, 4, 5, 6, 7), pf[KK], O[1]);                      \
  O[2] = MFMA32(__builtin_shufflevector(R[4], R[5], 0, 1, 2, 3, 4, 5, 6, 7), pf[KK], O[2]);                      \
  O[3] = MFMA32(__builtin_shufflevector(R[6], R[7], 0, 1, 2, 3, 4, 5, 6, 7), pf[KK], O[3]);
  TR_ISSUE(va, vbase);
  TR_ISSUE(vb, vbase + 16 * 320);
  TR_WAIT(va, 8);
  PV_MFMA(va, 0)
  TR_ISSUE(va, vbase + 32 * 320);
  TR_WAIT(vb, 8);
  PV_MFMA(vb, 1)
  TR_ISSUE(vb, vbase + 48 * 320);
  TR_WAIT(va, 8);
  PV_MFMA(va, 2)
  TR_WAIT(vb, 0);
  PV_MFMA(vb, 3)
#undef TR_ISSUE
#undef TR_WAIT
#undef PV_MFMA
}

DI void attn_epilogue(const Params& p, char* smem, int qg, int pm, bool active, f32x16 (&O)[4], float l_run, size_t tok, int hh, int lane) {
  const int r = lane & 31, h = lane >> 5;
  __syncthreads();
  const float inv_l = 1.f / l_run;
  float* X = (float*)smem + qg * 4096;
  if (active && pm == 1) {
#pragma unroll
    for (int d = 0; d < 4; ++d)
#pragma unroll
      for (int i = 0; i < 16; ++i) X[(d * 32 + crow(i, h)) * 32 + r] = O[d][i] * inv_l;
  }
  __syncthreads();
  if (active && pm == 0) {
    const float lam = P_misc[0];
    float ssq = 0.f;
#pragma unroll
    for (int d = 0; d < 4; ++d)
#pragma unroll
      for (int i = 0; i < 16; ++i) {
        const float o = O[d][i] * inv_l - lam * X[(d * 32 + crow(i, h)) * 32 + r];
        O[d][i] = o; ssq += o * o;
      }
    ssq += __shfl_xor(ssq, 32);
    const float rms = rsqrtf(ssq * (1.f / 128.f) + LN_EPS) * (1.f - LAM_INIT);
    u16* dst = P_mix + tok * 1024 + 512 + hh * 128;
#pragma unroll
    for (int d = 0; d < 4; ++d)
#pragma unroll
      for (int g = 0; g < 4; ++g) {
        const int dv = d * 32 + 8 * g + 4 * h;
        const float4 sg = *(const float4*)(p.subln_g + dv);
        uint2 w;
        w.x = pack2(O[d][4 * g + 0] * rms * sg.x, O[d][4 * g + 1] * rms * sg.y);
        w.y = pack2(O[d][4 * g + 2] * rms * sg.z, O[d][4 * g + 3] * rms * sg.w);
        *(uint2*)(dst + dv) = w;
      }
  }
}

DI void attn_prompt_item(const Params& p, int b, int hh, int qp, char* smem) {
  const int tid = get_tid(), lane = tid & 63, wave = tid >> 6, qg = wave >> 1, pm = wave & 1;
  const int r = lane & 31, h = lane >> 5;
  const size_t tok0 = (size_t)b * 2048;
  const size_t tq = tok0 + qp * 128 + qg * 32 + r;
  bf16x8 qf[4];
  {
    const u16* qptr = P_qb + tq * 512 + (hh * 2 + pm) * 64 + h * 8;
#pragma unroll
    for (int ks = 0; ks < 4; ++ks) qf[ks] = *(const bf16x8*)(qptr + ks * 16);
  }
  f32x16 O[4];
#pragma unroll
  for (int d = 0; d < 4; ++d)
#pragma unroll
    for (int i = 0; i < 16; ++i) O[d][i] = 0.f;
  float m_run = -INFINITY, l_run = 0.f;
  const int my_last = qp * 2 + (qg >> 1), nkt = qp * 2 + 2;
  const int lrow = tid >> 5, cc = tid & 31;
  const u16* gsrc;
  int lds_off, lstride;
  if (cc < 16) { gsrc = P_kb + (tok0 + lrow) * 512 + hh * 128 + cc * 8; lds_off = (cc >> 3) * 9216 + lrow * 144 + (cc & 7) * 16; lstride = 144; }
  else { gsrc = P_vb + (tok0 + lrow) * 512 + hh * 128 + (cc - 16) * 8; lds_off = 18432 + lrow * 320 + (cc - 16) * 16; lstride = 320; }
  u32x4 rg[4];
#pragma unroll
  for (int j = 0; j < 4; ++j) rg[j] = *(const u32x4*)(gsrc + (size_t)(16 * j) * 512);
  for (int kt = 0; kt < nkt; ++kt) {
    __syncthreads();
#pragma unroll
    for (int j = 0; j < 4; ++j) *(u32x4*)(smem + lds_off + 16 * j * lstride) = rg[j];
    __syncthreads();
    if (kt + 1 < nkt) {
#pragma unroll
      for (int j = 0; j < 4; ++j) rg[j] = *(const u32x4*)(gsrc + (size_t)((kt + 1) * 64 + 16 * j) * 512);
    }
    __builtin_amdgcn_sched_barrier(0);
    if (kt <= my_last) attn_tile_compute(smem, pm, qf, O, m_run, l_run, false, lane);
  }
  attn_epilogue(p, smem, qg, pm, true, O, l_run, tq, hh, lane);
}

DI void attn_sample_item(const Params& p, int b, int hh, char* smem) {
  const int tid = get_tid(), lane = tid & 63, wave = tid >> 6, qg = wave >> 1, pm = wave & 1;
  const int r = lane & 31, h = lane >> 5;
  const bool active = (qg == 0);
  const size_t tokq0 = (size_t)TP + (size_t)b * 32;
  const size_t tq = tokq0 + r;
  bf16x8 qf[4];
  {
    const u16* qptr = P_qb + tq * 512 + (hh * 2 + pm) * 64 + h * 8;
#pragma unroll
    for (int ks = 0; ks < 4; ++ks) qf[ks] = *(const bf16x8*)(qptr + ks * 16);
  }
  f32x16 O[4];
#pragma unroll
  for (int d = 0; d < 4; ++d)
#pragma unroll
    for (int i = 0; i < 16; ++i) O[d][i] = 0.f;
  float m_run = -INFINITY, l_run = 0.f;
  const int lrow = tid >> 5, cc = tid & 31;
  const float* fsrc;
  const u16* bsrc;
  int lds_off, lstride;
  if (cc < 16) {
    fsrc = p.cache_k + ((size_t)b * 2048 + lrow) * 512 + hh * 128 + cc * 8;
    bsrc = P_kb + (tokq0 + lrow) * 512 + hh * 128 + cc * 8;
    lds_off = (cc >> 3) * 9216 + lrow * 144 + (cc & 7) * 16; lstride = 144;
  } else {
    fsrc = p.cache_v + ((size_t)b * 2048 + lrow) * 512 + hh * 128 + (cc - 16) * 8;
    bsrc = P_vb + (tokq0 + lrow) * 512 + hh * 128 + (cc - 16) * 8;
    lds_off = 18432 + lrow * 320 + (cc - 16) * 16; lstride = 320;
  }
  f32x4 rf[8];
#pragma unroll
  for (int j = 0; j < 4; ++j) {
    rf[2 * j] = *(const f32x4*)(fsrc + (size_t)(16 * j) * 512);
    rf[2 * j + 1] = *(const f32x4*)(fsrc + (size_t)(16 * j) * 512 + 4);
  }
  for (int kt = 0; kt <= 32; ++kt) {
    __syncthreads();
    if (kt < 32) {
#pragma unroll
      for (int j = 0; j < 4; ++j) *(u32x4*)(smem + lds_off + 16 * j * lstride) = pack8v(rf[2 * j], rf[2 * j + 1]);
    } else {
#pragma unroll
      for (int j = 0; j < 4; ++j) {
        u32x4 v = {0u, 0u, 0u, 0u};
        if (j < 2) v = *(const u32x4*)(bsrc + (size_t)(16 * j) * 512);
        *(u32x4*)(smem + lds_off + 16 * j * lstride) = v;
      }
    }
    __syncthreads();
    if (kt + 1 < 32) {
#pragma unroll
      for (int j = 0; j < 4; ++j) {
        rf[2 * j] = *(const f32x4*)(fsrc + (size_t)((kt + 1) * 64 + 16 * j) * 512);
        rf[2 * j + 1] = *(const f32x4*)(fsrc + (size_t)((kt + 1) * 64 + 16 * j) * 512 + 4);
      }
    }
    __builtin_amdgcn_sched_barrier(0);
    if (active) attn_tile_compute(smem, pm, qf, O, m_run, l_run, kt == 32, lane);
  }
  attn_epilogue(p, smem, qg, pm, active, O, l_run, tq, hh, lane);
}

DI void conv_item(const Params& p, int ci, char* smem) {
  const int tid = get_tid(), lane = tid & 63, wave = tid >> 6;
  const bool sample = ci >= 1024;
  const int b = sample ? ci - 1024 : ci >> 6;
  const int s0 = sample ? 0 : (ci & 63) * 32;
  const size_t tokbase = sample ? (size_t)TP + (size_t)b * 32 : (size_t)b * 2048;
  const float* hist = p.cache_conv + (size_t)b * 30 * 512;
  float* U = (float*)smem;
  float cw[31];
#pragma unroll
  for (int j = 0; j < 31; ++j) cw[j] = p.w_dw[j * 512 + tid];
  const float cbias = p.b_dw[tid];
  {
    u32x4 st[8];
#pragma unroll
    for (int it = 0; it < 8; ++it) {
      const int c = it * 512 + tid;
      const int rr = c >> 6, ch = c & 63;
      const int s = s0 - 30 + rr;
      u32x4 v = {0u, 0u, 0u, 0u};
      if (c < 62 * 64) {
        if (s >= 0) v = *(const u32x4*)(P_ub + (tokbase + s) * 512 + ch * 8);
        else if (sample) {
          const float* hp = hist + (30 + s) * 512 + ch * 8;
          v = pack8v(*(const f32x4*)hp, *(const f32x4*)(hp + 4));
        }
      }
      st[it] = v;
    }
    __syncthreads();
#pragma unroll
    for (int it = 0; it < 8; ++it) {
      const int c = it * 512 + tid;
      if (c < 62 * 64) {
        float* d = U + (c >> 6) * 512 + (c & 63) * 8;
        *(f32x4*)d = f32x4{bf_lo(st[it][0]), bf_hi(st[it][0]), bf_lo(st[it][1]), bf_hi(st[it][1])};
        *(f32x4*)(d + 4) = f32x4{bf_lo(st[it][2]), bf_hi(st[it][2]), bf_lo(st[it][3]), bf_hi(st[it][3])};
      }
    }
  }
  __syncthreads();
  {
    float cacc[32];
#pragma unroll
    for (int i = 0; i < 32; ++i) cacc[i] = cbias;
#pragma unroll
    for (int r = 0; r < 62; ++r) {
      const float u = U[r * 512 + tid];
#pragma unroll
      for (int i = 0; i < 32; ++i)
        if (r - i >= 0 && r - i <= 30) cacc[i] += cw[r - i] * u;
    }
    __syncthreads();
#pragma unroll
    for (int i = 0; i < 32; ++i) U[i * 512 + tid] = cacc[i];
  }
  __syncthreads();
  const int c0 = lane * 8;
  float acc[4][8];
#pragma unroll
  for (int i = 0; i < 4; ++i) {
    const float* yp = U + (wave * 4 + i) * 512 + c0;
    const f32x4 a0 = *(const f32x4*)yp, a1 = *(const f32x4*)(yp + 4);
#pragma unroll
    for (int e = 0; e < 4; ++e) { acc[i][e] = a0[e]; acc[i][4 + e] = a1[e]; }
  }
  float gg[8], gb[8];
  {
    const f32x4 g0 = *(const f32x4*)(p.conv_ln_g + c0), g1 = *(const f32x4*)(p.conv_ln_g + c0 + 4);
    const f32x4 e0 = *(const f32x4*)(p.conv_ln_b + c0), e1 = *(const f32x4*)(p.conv_ln_b + c0 + 4);
#pragma unroll
    for (int e = 0; e < 4; ++e) { gg[e] = g0[e]; gg[4 + e] = g1[e]; gb[e] = e0[e]; gb[4 + e] = e1[e]; }
  }
#pragma unroll
  for (int i = 0; i < 4; ++i) {
    float s = 0.f;
#pragma unroll
    for (int c = 0; c < 8; ++c) s += acc[i][c];
    const float mu = wave_sum(s) * (1.f / 512.f);
    float v = 0.f;
#pragma unroll
    for (int c = 0; c < 8; ++c) { acc[i][c] -= mu; v += acc[i][c] * acc[i][c]; }
    const float rstd = rsqrtf(wave_sum(v) * (1.f / 512.f) + LN_EPS);
    float y[8];
#pragma unroll
    for (int c = 0; c < 8; ++c) {
      const float t = acc[i][c] * rstd * gg[c] + gb[c];
      y[c] = t / (1.f + __expf(-t));
    }
    u32x4 w;
    w[0] = pack2(y[0], y[1]); w[1] = pack2(y[2], y[3]); w[2] = pack2(y[4], y[5]); w[3] = pack2(y[6], y[7]);
    *(u32x4*)(P_mix + (tokbase + s0 + wave * 4 + i) * 1024 + c0) = w;
  }
}

DI void phaseC(const Params& p, char* smem) {
  const int total = 128 + 1024 + 1056;
  int nxt = 0;
  if (get_tid() == 0) nxt = (int)atomicAdd(P_counters, 1u);
  for (;;) {
    __syncthreads();
    if (get_tid() == 0) *(volatile int*)(smem + SMEM_CTRL) = nxt;
    __syncthreads();
    const int item = *(volatile int*)(smem + SMEM_CTRL);
    if (item >= total) break;
    if (get_tid() == 0) nxt = (int)atomicAdd(P_counters, 1u);
    if (item < 128) attn_sample_item(p, item >> 2, item & 3, smem);
    else if (item < 1152) { const int i = item - 128; const int qp = 15 - (i >> 6), bh = i & 63; attn_prompt_item(p, bh >> 2, bh & 3, qp, smem); }
    else conv_item(p, item - 1152, smem);
  }
}

DI void d_rowstore(const Params& p, const float* Ct, int m0, int n0, int lt) {
  const int c8 = (lt & 15) * 8;
  const f32x4 bo0 = *(const f32x4*)(p.b_out + n0 + c8), bo1 = *(const f32x4*)(p.b_out + n0 + c8 + 4);
#pragma unroll
  for (int it = 0; it < 8; ++it) {
    const int row = it * 16 + (lt >> 4);
    f32x4 a = *(const f32x4*)(Ct + row * 132 + c8), b = *(const f32x4*)(Ct + row * 132 + c8 + 4);
#pragma unroll
    for (int e = 0; e < 4; ++e) { a[e] += bo0[e]; b[e] += bo1[e]; }
    *(u32x4*)(P_r + (size_t)(m0 + row) * 1024 + n0 + c8) = pack8v(a, b);
  }
}
DI void phaseD(const Params& p, char* smem) {
  const int nfull = (132 * 4) / (int)gridDim.x;
  for (int i = 0; i < nfull; ++i) {
    int pm, pn;
    if (!unit_of(i * (int)gridDim.x + (int)blockIdx.x, 132, 4, pm, pn)) break;
    f32x4 acc[2][2][4][2];
    __syncthreads();
    g8::gemm256(P_wout_t, P_mix, pn * 256, pm * 256, smem, acc);
#pragma unroll
    for (int bj = 0; bj < 2; ++bj) {
      __syncthreads();
      quad_to_lds_f32(acc, bj, smem);
      __syncthreads();
      const int t2 = get_tid(), hbk = t2 >> 8, lt = t2 & 255;
      d_rowstore(p, (const float*)(smem + hbk * HB_LDS), pm * 256 + bj * 128, pn * 256 + hbk * 128, lt);
    }
  }
  for (int q = (int)blockIdx.x;; q += (int)gridDim.x) {
    int pm, pn, ai, bj;
    if (!leftover_quad(q, 132, 4, pm, pn, ai, bj)) break;
    {
      const int t2 = get_tid(), hbk = t2 >> 8, lt = t2 & 255, lane = lt & 63, wave = lt >> 6, wm = wave >> 1, wn = wave & 1, r = lane & 31, h = lane >> 5;
      char* sm = smem + hbk * HB_LDS;
      const int m0 = pm * 256 + ai * 128, n0 = pn * 256 + bj * 128;
      const bool act = hbk == 0;
      f32x16 acc[2][2];
      gemm_tile(P_mix, P_wout_t, m0, n0, sm, acc, hbk);
      kadd(acc, smem, hbk, lt);
      __syncthreads();
      float* Ct = (float*)sm;
#pragma unroll
      for (int mi = 0; mi < 2; ++mi)
#pragma unroll
        for (int ni = 0; ni < 2; ++ni)
#pragma unroll
          for (int i = 0; i < 16; ++i) Ct[(wm * 64 + mi * 32 + crow(i, h)) * 132 + wn * 64 + ni * 32 + r] = acc[mi][ni][i];
      __syncthreads();
      if (act) d_rowstore(p, Ct, m0, n0, lt);
    }
  }
}

DI void phaseE(const Params& p) {
  const int tid = get_tid(), lane = tid & 63;
  const int gw = (tid >> 6) * gridDim.x + blockIdx.x, nw = gridDim.x * 8;
  for (int tok0 = gw; tok0 < T; tok0 += 2 * nw) {
    float v[2][16];
    int tk[2];
#pragma unroll
    for (int u = 0; u < 2; ++u) {
      const int tok = tok0 + u * nw < T ? tok0 + u * nw : tok0;
      tk[u] = tok;
      const u16* rr = P_r + (size_t)tok * 1024;
      const float* xr = tok < TP ? p.x_prompt + (size_t)tok * 1024 : p.x_sample + (size_t)(tok - TP) * 1024;
      const float* gr = P_mod + mod_row(tok) * 6144 + 2048;
#pragma unroll
      for (int hf = 0; hf < 2; ++hf) {
        const int c = hf * 512 + lane * 8;
        const u32x4 rw = *(const u32x4*)(rr + c);
        f32x4 a, b;
        a[0] = bf_lo(rw[0]); a[1] = bf_hi(rw[0]); a[2] = bf_lo(rw[1]); a[3] = bf_hi(rw[1]);
        b[0] = bf_lo(rw[2]); b[1] = bf_hi(rw[2]); b[2] = bf_lo(rw[3]); b[3] = bf_hi(rw[3]);
        const f32x4 xa = *(const f32x4*)(xr + c), xb = *(const f32x4*)(xr + c + 4);
        const f32x4 ga = *(const f32x4*)(gr + c), gb = *(const f32x4*)(gr + c + 4);
#pragma unroll
        for (int e = 0; e < 4; ++e) { v[u][hf * 8 + e] = ALPHA * xa[e] + ga[e] * a[e]; v[u][hf * 8 + 4 + e] = ALPHA * xb[e] + gb[e] * b[e]; }
      }
    }
#pragma unroll
    for (int u = 0; u < 2; ++u) {
      const int tok = tk[u];
      const float* mr = P_mod + mod_row(tok) * 6144;
      float s = 0.f;
#pragma unroll
      for (int i = 0; i < 16; ++i) s += v[u][i];
      const float mu = wave_sum(s) * (1.f / 1024.f);
      float q = 0.f;
#pragma unroll
      for (int i = 0; i < 16; ++i) { v[u][i] -= mu; q += v[u][i] * v[u][i]; }
      const float rstd = rsqrtf(wave_sum(q) * (1.f / 1024.f) + LN_EPS);
#pragma unroll
      for (int hf = 0; hf < 2; ++hf) {
        const int c = hf * 512 + lane * 8;
        f32x4 y0, y1, h0, h1;
        const f32x4 g0 = *(const f32x4*)(p.ln1_g + c), g1 = *(const f32x4*)(p.ln1_g + c + 4);
        const f32x4 b0 = *(const f32x4*)(p.ln1_b + c), b1 = *(const f32x4*)(p.ln1_b + c + 4);
        const f32x4 sc0 = *(const f32x4*)(mr + 4096 + c), sc1 = *(const f32x4*)(mr + 4096 + c + 4);
        const f32x4 sh0 = *(const f32x4*)(mr + 3072 + c), sh1 = *(const f32x4*)(mr + 3072 + c + 4);
#pragma unroll
        for (int e = 0; e < 4; ++e) {
          y0[e] = v[u][hf * 8 + e] * rstd * g0[e] + b0[e];
          y1[e] = v[u][hf * 8 + 4 + e] * rstd * g1[e] + b1[e];
          h0[e] = y0[e] * (1.f + sc0[e]) + sh0[e];
          h1[e] = y1[e] * (1.f + sc1[e]) + sh1[e];
        }
        u32x4 yw;
        yw[0] = __builtin_bit_cast(u32, h16x2{(_Float16)y0[0], (_Float16)y0[1]}); yw[1] = __builtin_bit_cast(u32, h16x2{(_Float16)y0[2], (_Float16)y0[3]});
        yw[2] = __builtin_bit_cast(u32, h16x2{(_Float16)y1[0], (_Float16)y1[1]}); yw[3] = __builtin_bit_cast(u32, h16x2{(_Float16)y1[2], (_Float16)y1[3]});
        *(u32x4*)(P_y1 + (size_t)tok * 1024 + c) = yw;
        *(u32x4*)(P_h2 + (size_t)tok * 1024 + c) = pack8v(h0, h1);
      }
    }
  }
}

DI u32 make_key(float s, int idx) {
  u32 u = __float_as_uint(s);
  u ^= ((u32)((int)u >> 31)) | 0x80000000u;
  return (u & ~127u) | (u32)idx;
}
DI float key_val(u32 key) {
  const u32 kb = key & ~127u;
  return __uint_as_float(kb ^ ((~(u32)((int)kb >> 31)) | 0x80000000u));
}
#define CE_DESC(a, b) { const u32 _x = max(a, b); const u32 _n = min(a, b); a = _x; b = _n; }
DI void bitonic_merge16(u32 (&v)[16]) {
#pragma unroll
  for (int j = 8; j > 0; j >>= 1)
#pragma unroll
    for (int i = 0; i < 16; ++i) {
      const int l = i ^ j;
      if (l > i) CE_DESC(v[i], v[l]);
    }
}
DI void sort16(u32 (&v)[16]) {
  CE_DESC(v[0], v[13]); CE_DESC(v[1], v[12]); CE_DESC(v[2], v[15]); CE_DESC(v[3], v[14]); CE_DESC(v[4], v[8]); CE_DESC(v[5], v[6]); CE_DESC(v[7], v[11]); CE_DESC(v[9], v[10]);
  CE_DESC(v[0], v[5]); CE_DESC(v[1], v[7]); CE_DESC(v[2], v[9]); CE_DESC(v[3], v[4]); CE_DESC(v[6], v[13]); CE_DESC(v[8], v[14]); CE_DESC(v[10], v[15]); CE_DESC(v[11], v[12]);
  CE_DESC(v[0], v[1]); CE_DESC(v[2], v[3]); CE_DESC(v[4], v[5]); CE_DESC(v[6], v[8]); CE_DESC(v[7], v[9]); CE_DESC(v[10], v[11]); CE_DESC(v[12], v[13]); CE_DESC(v[14], v[15]);
  CE_DESC(v[0], v[2]); CE_DESC(v[1], v[3]); CE_DESC(v[4], v[10]); CE_DESC(v[5], v[11]); CE_DESC(v[6], v[7]); CE_DESC(v[8], v[9]); CE_DESC(v[12], v[14]); CE_DESC(v[13], v[15]);
  CE_DESC(v[1], v[2]); CE_DESC(v[3], v[12]); CE_DESC(v[4], v[6]); CE_DESC(v[5], v[7]); CE_DESC(v[8], v[10]); CE_DESC(v[9], v[11]); CE_DESC(v[13], v[14]);
  CE_DESC(v[1], v[4]); CE_DESC(v[2], v[6]); CE_DESC(v[5], v[8]); CE_DESC(v[7], v[10]); CE_DESC(v[9], v[13]); CE_DESC(v[11], v[14]);
  CE_DESC(v[2], v[4]); CE_DESC(v[3], v[6]); CE_DESC(v[9], v[12]); CE_DESC(v[11], v[13]);
  CE_DESC(v[3], v[5]); CE_DESC(v[6], v[8]); CE_DESC(v[7], v[9]); CE_DESC(v[10], v[12]);
  CE_DESC(v[3], v[4]); CE_DESC(v[5], v[6]); CE_DESC(v[7], v[8]); CE_DESC(v[9], v[10]); CE_DESC(v[11], v[12]);
  CE_DESC(v[6], v[7]); CE_DESC(v[8], v[9]);
}
DI void merge_top16(u32 (&a)[16], const u32 (&b)[16]) {
#pragma unroll
  for (int i = 0; i < 16; ++i) a[i] = max(a[i], b[15 - i]);
  bitonic_merge16(a);
}

DI void f_epilogue(const Params& p, char* sm, int m0, int hp, int lt) {
  const int lane = lt & 63, wave = lt >> 6, wm = wave >> 1, wn = wave & 1;
  const int r = lane & 31, h = lane >> 5;
  u32* PL = (u32*)sm;
  char* Qs = sm + 32768;
  {
    bf16x8 ska[8], skb[8];
    {
      const u16* skp = P_sk + ((size_t)hp * 128 + wm * 64 + r) * 128 + h * 8;
#pragma unroll
      for (int ks = 0; ks < 8; ++ks) { ska[ks] = *(const bf16x8*)(skp + ks * 16); skb[ks] = *(const bf16x8*)(skp + 32 * 128 + ks * 16); }
    }
    __syncthreads();
    f32x16 st[2][2];
#pragma unroll
    for (int a = 0; a < 2; ++a)
#pragma unroll
      for (int b = 0; b < 2; ++b)
#pragma unroll
        for (int i = 0; i < 16; ++i) st[a][b][i] = 0.f;
    {
      const char* qp = Qs + (wn * 64 + r) * 272 + h * 16;
#pragma unroll
      for (int ks = 0; ks < 8; ++ks) {
        const bf16x8 b0 = *(const bf16x8*)(qp + ks * 32), b1 = *(const bf16x8*)(qp + 32 * 272 + ks * 32);
        st[0][0] = MFMA32(ska[ks], b0, st[0][0]);
        st[0][1] = MFMA32(ska[ks], b1, st[0][1]);
        st[1][0] = MFMA32(skb[ks], b0, st[1][0]);
        st[1][1] = MFMA32(skb[ks], b1, st[1][1]);
      }
    }
#pragma unroll
    for (int nt = 0; nt < 2; ++nt) {
      u32 va[16], vb[16];
#pragma unroll
      for (int i = 0; i < 16; ++i) {
        va[i] = make_key(st[0][nt][i], wm * 64 + crow(i, h));
        vb[i] = make_key(st[1][nt][i], wm * 64 + 32 + crow(i, h));
      }
      sort16(va);
      sort16(vb);
      merge_top16(va, vb);
      u32* dst = PL + ((wn * 64 + nt * 32 + r) * 4 + wm * 2 + h) * 16;
#pragma unroll
      for (int q = 0; q < 4; ++q) *(uint4*)(dst + 4 * q) = make_uint4(va[4 * q], va[4 * q + 1], va[4 * q + 2], va[4 * q + 3]);
    }
    __syncthreads();
    if (lt < 128) {
      u32 l0[16], l1[16], l2[16], l3[16];
      const u32* src = PL + lt * 64;
#pragma unroll
      for (int q = 0; q < 4; ++q) {
        const uint4 a = *(const uint4*)(src + 4 * q), b = *(const uint4*)(src + 16 + 4 * q);
        const uint4 c = *(const uint4*)(src + 32 + 4 * q), d = *(const uint4*)(src + 48 + 4 * q);
        l0[4 * q] = a.x; l0[4 * q + 1] = a.y; l0[4 * q + 2] = a.z; l0[4 * q + 3] = a.w;
        l1[4 * q] = b.x; l1[4 * q + 1] = b.y; l1[4 * q + 2] = b.z; l1[4 * q + 3] = b.w;
        l2[4 * q] = c.x; l2[4 * q + 1] = c.y; l2[4 * q + 2] = c.z; l2[4 * q + 3] = c.w;
        l3[4 * q] = d.x; l3[4 * q + 1] = d.y; l3[4 * q + 2] = d.z; l3[4 * q + 3] = d.w;
      }
      merge_top16(l0, l1);
      merge_top16(l2, l3);
      merge_top16(l0, l2);
      u32* dst = P_topk + (size_t)(m0 + lt) * 256 + hp * 16;
#pragma unroll
      for (int q = 0; q < 4; ++q) *(uint4*)(dst + 4 * q) = make_uint4(l0[4 * q], l0[4 * q + 1], l0[4 * q + 2], l0[4 * q + 3]);
    }
  }
}

DI void phaseF(const Params& p, char* smem) {
  const int nfull = (132 * 8) / (int)gridDim.x;
  for (int i = 0; i < nfull; ++i) {
    int pm, pn;
    if (!unit_of(i * (int)gridDim.x + (int)blockIdx.x, 132, 8, pm, pn)) break;
    f32x4 acc[2][2][4][2];
    __syncthreads();
    g8::gemm256(P_wq_t, P_h2, pn * 256, pm * 256, smem, acc);
#pragma unroll
    for (int bj = 0; bj < 2; ++bj) {
      __syncthreads();
      {
        const int tid = get_tid(), wid = tid >> 6, lane = tid & 63, wr = wid >> 2, wc = wid & 3, fr = lane & 15, fq = lane >> 4;
#pragma unroll
        for (int ai = 0; ai < 2; ++ai) {
          char* Qs = smem + ai * HB_LDS + 32768;
#pragma unroll
          for (int m = 0; m < 4; ++m)
#pragma unroll
            for (int n = 0; n < 2; ++n)
              *(u32x2*)(Qs + (wc * 32 + n * 16 + fr) * 272 + (wr * 64 + m * 16 + fq * 4) * 2) =
                  u32x2{pack2(acc[ai][bj][m][n][0], acc[ai][bj][m][n][1]), pack2(acc[ai][bj][m][n][2], acc[ai][bj][m][n][3])};
        }
      }
      const int t2 = get_tid(), hbk = t2 >> 8;
      f_epilogue(p, smem + hbk * HB_LDS, pm * 256 + bj * 128, pn * 2 + hbk, t2 & 255);
    }
  }
  for (int q = (int)blockIdx.x;; q += (int)gridDim.x) {
    int pm, pn, ai, bj;
    if (!leftover_quad(q, 132, 8, pm, pn, ai, bj)) break;
    {
      const int t2 = get_tid(), hbk = t2 >> 8, lt = t2 & 255, lane = lt & 63, wave = lt >> 6, wm = wave >> 1, wn = wave & 1, r = lane & 31, h = lane >> 5;
      char* sm = smem + hbk * HB_LDS;
      const int m0 = pm * 256 + ai * 128, n0 = pn * 256 + bj * 128;
      const bool act = hbk == 0;
      {
        f32x16 acc[2][2];
        gemm_tile(P_h2, P_wq_t, m0, n0, sm, acc, hbk);
      kadd(acc, smem, hbk, lt);
        char* Qs = sm + 32768;
        __syncthreads();
#pragma unroll
        for (int mi = 0; mi < 2; ++mi)
#pragma unroll
          for (int ni = 0; ni < 2; ++ni)
#pragma unroll
            for (int i = 0; i < 16; ++i)
              *(u16*)(Qs + (wm * 64 + mi * 32 + crow(i, h)) * 272 + (wn * 64 + ni * 32 + r) * 2) = (u16)f2bf(acc[mi][ni][i]);
      }
      if (act) f_epilogue(p, sm, m0, pn * 2 + bj, lt);
      else { __syncthreads(); __syncthreads(); }
    }
  }
}

__device__ const unsigned char kStairI[64] = {0, 0, 0, 0, 0, 0, 0, 0, 0, 0, 0, 0, 0, 0, 0, 0, 1, 1, 1, 1, 1, 1, 1, 1, 2, 2, 2, 2, 2, 3, 3, 3,
                                              3, 4, 4, 4, 5, 5, 6, 6, 7, 7, 8, 9, 10, 11, 12, 13, 14, 15, 0, 0, 0, 0, 0, 0, 0, 0, 0, 0, 0, 0, 0, 0};
__device__ const unsigned char kStairJ[64] = {0, 1, 2, 3, 4, 5, 6, 7, 8, 9, 10, 11, 12, 13, 14, 15, 0, 1, 2, 3, 4, 5, 6, 7, 0, 1, 2, 3, 4, 0, 1, 2,
                                              3, 0, 1, 2, 0, 1, 0, 1, 0, 1, 0, 0, 0, 0, 0, 0, 0, 0, 0, 0, 0, 0, 0, 0, 0, 0, 0, 0, 0, 0, 0, 0};

DI void phaseG1(const Params& p, char* smem) {
  const int tid = get_tid(), lane = tid & 63, wave = tid >> 6;
  const int gw = wave * gridDim.x + blockIdx.x, nw = gridDim.x * 8;
  char* wb = smem + wave * 5632;
  LAS u32* wtop = (LAS u32*)wb;
  LAS float* wcand = (LAS float*)(wb + 1024);
  LAS u32* we = (LAS u32*)(wb + 3072);
  LAS float* wg = (LAS float*)(wb + 3584);
  LAS float* wc = (LAS float*)(wb + 4096);
  LAS float* wsu = (LAS float*)(wb + 4608);
  LAS float* wsv = (LAS float*)(wb + 5120);
  const int si = kStairI[lane], sj = kStairJ[lane];
  const bool valid = lane < 50;
  u32x4 tkn = *(const u32x4*)(P_topk + (size_t)(gw < T ? gw : 0) * 256 + lane * 4);
  for (int tok = gw; tok < T; tok += nw) {
    *(LAS u32x4*)(wtop + lane * 4) = tkn;
    {
      const int ntok = tok + nw < T ? tok + nw : tok;
      tkn = *(const u32x4*)(P_topk + (size_t)ntok * 256 + lane * 4);
    }
    wave_lds_sync();
    float cand[8];
    u32 eid[8], ckey[8];
#pragma unroll
    for (int hd = 0; hd < 8; ++hd) {
      const u32 ka = wtop[(2 * hd) * 16 + si], kb = wtop[(2 * hd + 1) * 16 + sj];
      cand[hd] = valid ? key_val(ka) + key_val(kb) : -INFINITY;
      eid[hd] = (ka & 127u) * 128u + (kb & 127u);
      u32 ku = __float_as_uint(cand[hd]);
      ku ^= ((u32)((int)ku >> 31)) | 0x80000000u;
      ckey[hd] = (ku & ~63u) | (u32)(63 - lane);
      wcand[hd * 64 + lane] = __uint_as_float(ckey[hd]);
    }
    wave_lds_sync();
    int rank[8];
    float su_r[8], sv_r[8];
#pragma unroll
    for (int hd = 0; hd < 8; ++hd) { rank[hd] = 0; su_r[hd] = 0.f; sv_r[hd] = 0.f; }
#pragma unroll 1
    for (int j4 = 0; j4 < 13; ++j4) {
#pragma unroll
      for (int hd = 0; hd < 8; ++hd) {
        const u32x4 o = *(const LAS u32x4*)(wcand + hd * 64 + j4 * 4);
        const u32 m = ckey[hd];
        rank[hd] += (o[0] > m) ? 1 : 0;
        rank[hd] += (o[1] > m) ? 1 : 0;
        rank[hd] += (o[2] > m) ? 1 : 0;
        rank[hd] += (o[3] > m) ? 1 : 0;
      }
    }
#pragma unroll
    for (int hd = 0; hd < 8; ++hd) {
      const float mine = cand[hd];
      const bool sel = valid && rank[hd] < 16;
      const float mx = __uint_as_float((u32)__builtin_amdgcn_readfirstlane((int)__float_as_uint(mine)));
      const float ex = sel ? __expf(mine - mx) : 0.f;
      const float sm = wave_sum(ex);
      if (sel) {
        const int slot = hd * 16 + rank[hd];
        we[slot] = eid[hd]; wg[slot] = ex / sm;
        su_r[hd] = P_usc[eid[hd]]; sv_r[hd] = P_vsc[eid[hd]];
      }
    }
    wave_lds_sync();
    const int l5 = lane & 31, hv = lane >> 5;
    h16x2 hfp[16];
    {
      const u16* h2p = P_h2 + (size_t)tok * 1024 + 4 * l5;
#pragma unroll
      for (int j = 0; j < 8; ++j) {
        const uint2 w = *(const uint2*)(h2p + 128 * j);
        hfp[2 * j] = h16x2{(_Float16)bf_lo(w.x), (_Float16)bf_hi(w.x)};
        hfp[2 * j + 1] = h16x2{(_Float16)bf_lo(w.y), (_Float16)bf_hi(w.y)};
      }
    }
#pragma unroll 1
    for (int k0 = 0; k0 < 128; k0 += 32) {
      u32 es[16];
#pragma unroll
      for (int q = 0; q < 8; ++q) {
        const u32x4 e = *(const LAS u32x4*)(we + k0 + 4 * q);
        es[2 * q] = hv ? e[1] : e[0]; es[2 * q + 1] = hv ? e[3] : e[2];
      }
      u32x4 ra[16];
      u32x2 rb[16];
#pragma unroll
      for (int i = 0; i < 16; ++i) {
        const unsigned char* rp = P_utab + (size_t)es[i] * 768;
        ra[i] = *(const u32x4*)(rp + 16 * l5);
        rb[i] = *(const u32x2*)(rp + 512 + 8 * l5);
      }
      if (k0 == 0) {
#pragma unroll
        for (int hd = 0; hd < 8; ++hd)
          if (valid && rank[hd] < 16) { wsu[hd * 16 + rank[hd]] = su_r[hd]; wsv[hd * 16 + rank[hd]] = sv_r[hd]; }
      }
      float d[16];
#pragma unroll
      for (int i = 0; i < 16; ++i) {
        const h16x32 f = __builtin_amdgcn_cvt_scalef32_pk32_f16_fp6(u32x6{ra[i][0], ra[i][1], ra[i][2], ra[i][3], rb[i][0], rb[i][1]}, 1.0f);
        float acc0 = 0.f, acc1 = 0.f;
#pragma unroll
        for (int m = 0; m < 16; m += 2) {
          acc0 = __builtin_amdgcn_fdot2(h16x2{f[2 * m], f[2 * m + 1]}, hfp[m], acc0, false);
          acc1 = __builtin_amdgcn_fdot2(h16x2{f[2 * m + 2], f[2 * m + 3]}, hfp[m + 1], acc1, false);
        }
        d[i] = acc0 + acc1;
        if (i < 15) asm volatile("" : "+v"(ra[i + 1]) : "v"(d[i]));
      }
      float e8[8], e4[4], e2[2], e1s;
      {
        const bool up = (l5 & 16) != 0;
#pragma unroll
        for (int i = 0; i < 8; ++i) {
          const float send = up ? d[i] : d[i + 8], keep = up ? d[i + 8] : d[i];
          e8[i] = keep + __shfl_xor(send, 16);
        }
      }
      {
        const bool up = (l5 & 8) != 0;
#pragma unroll
        for (int i = 0; i < 4; ++i) {
          const float send = up ? e8[i] : e8[i + 4], keep = up ? e8[i + 4] : e8[i];
          e4[i] = keep + __shfl_xor(send, 8);
        }
      }
      {
        const bool up = (l5 & 4) != 0;
#pragma unroll
        for (int i = 0; i < 2; ++i) {
          const float send = up ? e4[i] : e4[i + 2], keep = up ? e4[i + 2] : e4[i];
          e2[i] = keep + __shfl_xor(send, 4);
        }
      }
      {
        const bool up = (l5 & 2) != 0;
        const float send = up ? e2[0] : e2[1], keep = up ? e2[1] : e2[0];
        e1s = keep + dpp_xor2(send);
      }
      e1s += dpp_xor1(e1s);
      if ((l5 & 1) == 0) {
        const int k = k0 + 2 * (l5 >> 1) + hv;
        const float a = e1s * wsu[k];
        wc[k] = 0.5f * a * (1.f + erff(a * 0.70710678118654752f)) * wg[k] * wsv[k];
      }
    }
    wave_lds_sync();
    {
      const u32x2 ev = *(const LAS u32x2*)(we + 2 * lane);
      const f32x2 cv = *(const LAS f32x2*)(wc + 2 * lane);
      const h16x2 ch = h16x2{(_Float16)(cv[0] * 1024.f), (_Float16)(cv[1] * 1024.f)};
      const u32 cw = __builtin_bit_cast(u32, ch);
      *(u32x2*)(P_elist + (size_t)tok * 128 + 2 * lane) = u32x2{ev[0] | (cw << 16), ev[1] | (cw & 0xffff0000u)};
    }
    wave_lds_sync();
  }
}

DI void phaseG2(const Params& p, char* smem) {
  const int tid = get_tid(), lane = tid & 63, wave = tid >> 6;
  const int gw = wave * gridDim.x + blockIdx.x, nw = gridDim.x * 8;
  char* wb = smem + wave * 5632;
  LAS u32* we = (LAS u32*)(wb + 3072);

  const int l5 = lane & 31, hv = lane >> 5;
  const int cb = 512 * hv + 4 * l5;
  f32x4 l2g[4], l2b[4];
#pragma unroll
  for (int j = 0; j < 4; ++j) { l2g[j] = *(const f32x4*)(p.ln2_g + cb + 128 * j); l2b[j] = *(const f32x4*)(p.ln2_b + cb + 128 * j); }
  u32x2 eln = *(const u32x2*)(P_elist + (size_t)(gw < T ? gw : 0) * 128 + 2 * lane);
  for (int tok = gw; tok < T; tok += nw) {
    *(LAS u32x2*)(we + 2 * lane) = eln;
    {
      const int ntok = tok + nw < T ? tok + nw : tok;
      eln = *(const u32x2*)(P_elist + (size_t)ntok * 128 + 2 * lane);
    }
    h16x4 yh[4];
    f32x4 g2v[4];
    {
      const _Float16* y1p = P_y1 + (size_t)tok * 1024 + cb;
      const float* g2p = P_mod + mod_row(tok) * 6144 + 5120 + cb;
#pragma unroll
      for (int j = 0; j < 4; ++j) { yh[j] = *(const h16x4*)(y1p + 128 * j); g2v[j] = *(const f32x4*)(g2p + 128 * j); }
    }
    wave_lds_sync();
    h16x2 ffh[16];
#pragma unroll
    for (int i = 0; i < 16; ++i) ffh[i] = h16x2{(_Float16)0.f, (_Float16)0.f};
#pragma unroll 1
    for (int k0 = 0; k0 < 128; k0 += 32) {
      u32 es[16];
#pragma unroll
      for (int q = 0; q < 8; ++q) {
        const u32x4 e = *(const LAS u32x4*)(we + k0 + 4 * q);
        es[2 * q] = hv ? e[1] : e[0]; es[2 * q + 1] = hv ? e[3] : e[2];
      }
      u32x4 ra[16];
      u32x2 rb[16];
#pragma unroll
      for (int i = 0; i < 16; ++i) {
        const unsigned char* rp = P_vtab + (size_t)(es[i] & 0xffffu) * 768;
        ra[i] = *(const u32x4*)(rp + 16 * l5);
        rb[i] = *(const u32x2*)(rp + 512 + 8 * l5);
      }
#pragma unroll
      for (int i = 0; i < 16; ++i) {
        const h16x32 f = __builtin_amdgcn_cvt_scalef32_pk32_f16_fp6(u32x6{ra[i][0], ra[i][1], ra[i][2], ra[i][3], rb[i][0], rb[i][1]}, 1.0f);
        const u32 ewd = es[i];
        const h16x2 ew = __builtin_bit_cast(h16x2, ewd);
        const h16x2 cc = h16x2{ew[1], ew[1]};
#pragma unroll
        for (int m = 0; m < 16; ++m) ffh[m] = h16x2{f[2 * m], f[2 * m + 1]} * cc + ffh[m];
        if (i < 15) asm volatile("" : "+v"(ra[i + 1]) : "v"(ffh[0]), "v"(ffh[7]), "v"(ffh[15]));
      }
    }
    float fs[16];
#pragma unroll
    for (int i = 0; i < 8; ++i) {
      const h16x2 mine = hv ? ffh[8 + i] : ffh[i], other = hv ? ffh[i] : ffh[8 + i];
      const h16x2 oth = __builtin_bit_cast(h16x2, __shfl_xor(__builtin_bit_cast(int, other), 32));
      fs[2 * i] = ((float)mine[0] + (float)oth[0]) * (1.f / 1024.f);
      fs[2 * i + 1] = ((float)mine[1] + (float)oth[1]) * (1.f / 1024.f);
    }
    float rv[16];
#pragma unroll
    for (int j = 0; j < 4; ++j) {
      const f32x4 y = f32x4{(float)yh[j][0], (float)yh[j][1], (float)yh[j][2], (float)yh[j][3]}, g = g2v[j];
#pragma unroll
      for (int i = 0; i < 4; ++i) rv[4 * j + i] = ALPHA * y[i] + g[i] * fs[4 * j + i];
    }
    float s = 0.f;
#pragma unroll
    for (int i = 0; i < 16; ++i) s += rv[i];
    const float mu = wave_sum(s) * (1.f / 1024.f);
    float q = 0.f;
#pragma unroll
    for (int i = 0; i < 16; ++i) { rv[i] -= mu; q += rv[i] * rv[i]; }
    const float rstd = rsqrtf(wave_sum(q) * (1.f / 1024.f) + LN_EPS);
    const float poison = P_misc[1] != 0.f ? __builtin_nanf("") : 0.f;
    float* outp = (tok < TP ? P_y_prompt + (size_t)tok * 1024 : P_y_sample + (size_t)(tok - TP) * 1024) + cb;
#pragma unroll
    for (int j = 0; j < 4; ++j) {
      const f32x4 g = l2g[j], b = l2b[j];
      f32x4 o;
#pragma unroll
      for (int i = 0; i < 4; ++i) o[i] = rv[4 * j + i] * rstd * g[i] + b[i] + poison;
      *(f32x4*)(outp + 128 * j) = o;
    }
    wave_lds_sync();
  }
}

typedef const __attribute__((address_space(4))) Params* kparams_t;
DI Params fresh_params(kparams_t pp) {
#if defined(__HIP_DEVICE_COMPILE__)
  asm volatile("" : "+s"(pp));
  return *pp;
#else
  return Params{};
#endif
}

__global__ void __launch_bounds__(512, 2) fwd_megakernel(Params p_arg) {
  cg::grid_group grid = cg::this_grid();
  __shared__ __attribute__((aligned(16))) char smem[SMEM_BYTES];
  kparams_t pp = (kparams_t)__builtin_amdgcn_kernarg_segment_ptr();
  if (threadIdx.x == 0) { *(volatile LAS unsigned*)(smem + SMEM_CTRL + 8) = 0u; *(volatile LAS unsigned*)(smem + SMEM_CTRL + 12) = 0u; }
  __syncthreads();
  const XcdBarrier xb = xcd_barrier_post((unsigned*)(fresh_params(pp).ws + OFF_BAR), (volatile LAS unsigned*)(smem + SMEM_CTRL + 8));
  if (p_arg.out == nullptr) grid.sync();
  phaseA(fresh_params(pp), smem);
  xcd_barrier(xb);
  phaseA2(fresh_params(pp));
  xcd_barrier(xb);
  phaseB(fresh_params(pp), smem);
  xcd_barrier(xb);
  phaseC(fresh_params(pp), smem);
  xcd_barrier(xb);
  phaseD(fresh_params(pp), smem);
  xcd_barrier(xb);
  phaseE(fresh_params(pp));
  xcd_barrier(xb);
  phaseF(fresh_params(pp), smem);
  xcd_barrier(xb);
  phaseG1(fresh_params(pp), smem);
  xcd_barrier(xb);
  phaseG2(fresh_params(pp), smem);
}

extern "C" void kernel_launch(void* const* d_in, const int* in_sizes, int n_in, void* d_out, int out_size,
                              void* d_ws, size_t ws_size, hipStream_t stream) {
  static int grid_blocks = 0;
  if (!grid_blocks) {
    int dev = 0, cus = 0, per_cu = 0;
    (void)hipGetDevice(&dev);
    (void)hipDeviceGetAttribute(&cus, hipDeviceAttributeMultiprocessorCount, dev);
    (void)hipOccupancyMaxActiveBlocksPerMultiprocessor(&per_cu, fwd_megakernel, 512, 0);
    if (per_cu > 1) per_cu = 1;
    grid_blocks = cus * per_cu;
    if (ws_size < WS_NEED) fprintf(stderr, "workspace too small: %zu < %zu\n", ws_size, (size_t)WS_NEED);
  }
  Params p{};
  const float* const* in = (const float* const*)d_in;
  p.x_prompt = in[0]; p.x_sample = in[1]; p.cache_k = in[2]; p.cache_v = in[3]; p.cache_conv = in[4]; p.c_prompt = in[5]; p.c_sample = in[6];
  p.w_ada = in[7]; p.b_ada = in[8]; p.w_in = in[9]; p.b_in = in[10]; p.w_dw = in[11]; p.b_dw = in[12]; p.conv_ln_g = in[13]; p.conv_ln_b = in[14];
  p.lam_q1 = in[15]; p.lam_k1 = in[16]; p.lam_q2 = in[17]; p.lam_k2 = in[18]; p.subln_g = in[19]; p.w_out = in[20]; p.b_out = in[21];
  p.ln1_g = in[22]; p.ln1_b = in[23]; p.w_query = in[24]; p.sub_keys = in[25]; p.u_tab = in[26]; p.v_tab = in[27]; p.ln2_g = in[28]; p.ln2_b = in[29];
  p.out = (float*)d_out;
  p.ws = (char*)d_ws;
  char* ws = (char*)d_ws;
  (void)hipMemsetAsync(ws + OFF_MISC + 256, 0, 4096 - 256 + 16384, stream);
  void* args[] = {&p};
  hipError_t e = hipLaunchCooperativeKernel((void*)fwd_megakernel, dim3(grid_blocks), dim3(512), args, 0, stream);
  if (e != hipSuccess) fprintf(stderr, "cooperative launch failed: %s (grid %d)\n", hipGetErrorString(e), grid_blocks);
}
```

```cpp
#include <hip/hip_runtime.h>
#include <hip/hip_cooperative_groups.h>
#include <cstdio>
#include <cstdint>
namespace cg = cooperative_groups;

typedef unsigned short u16;
typedef unsigned int u32;
using bf16x8 = __attribute__((ext_vector_type(8))) short;
using s16x4 = __attribute__((ext_vector_type(4))) short;
using f32x16 = __attribute__((ext_vector_type(16))) float;
using u32x4 = __attribute__((ext_vector_type(4))) unsigned;
using f32x4 = __attribute__((ext_vector_type(4))) float;
using f32x2 = __attribute__((ext_vector_type(2))) float;
using h16x2 = __attribute__((ext_vector_type(2))) _Float16;
using h16x4 = __attribute__((ext_vector_type(4))) _Float16;
using h16x32 = __attribute__((ext_vector_type(32))) _Float16;
using u32x2 = __attribute__((ext_vector_type(2))) unsigned;
using u32x6 = __attribute__((ext_vector_type(6))) unsigned;
using f32x32 = __attribute__((ext_vector_type(32))) float;
typedef __bf16 bf16x2_t __attribute__((ext_vector_type(2)));
#define DI __device__ __forceinline__
#define LAS __attribute__((address_space(3)))
#define GAS __attribute__((address_space(1)))
#define MFMA32(a, b, c) __builtin_amdgcn_mfma_f32_32x32x16_bf16((a), (b), (c), 0, 0, 0)

constexpr int TP = 32768, TS = 1024, T = TP + TS;
constexpr float LN_EPS = 1e-5f;
constexpr float ALPHA = 1.189207115002721f;
constexpr float LAM_INIT = 0.2f;

constexpr size_t OFF_MOD = 0;
constexpr size_t OFF_ROPE = OFF_MOD + 1179648;
constexpr size_t OFF_MISC = OFF_ROPE + 532480;
constexpr size_t OFF_BAR = OFF_MISC + 4096;
constexpr size_t OFF_WIN = OFF_BAR + 16384;
constexpr size_t OFF_WOUT = OFF_WIN + 5242880;
constexpr size_t OFF_WQ = OFF_WOUT + 2097152;
constexpr size_t OFF_SK = OFF_WQ + 4194304;
constexpr size_t OFF_UTAB = OFF_SK + 524288;
constexpr size_t OFF_VTAB = OFF_UTAB + 16777216;
constexpr size_t OFF_USC = OFF_VTAB + 16777216;
constexpr size_t OFF_VSC = OFF_USC + 65536;
constexpr size_t OFF_X = OFF_VSC + 65536;
constexpr size_t OFF_Y = OFF_X + 69206016;
constexpr size_t OFF_Z = OFF_Y + 138412032;
constexpr size_t OFF_H2 = OFF_Z + 138412032;
constexpr size_t WS_NEED = OFF_H2 + 69206016;

constexpr int HB_LDS = 73728;
constexpr int SMEM_BYTES = 2 * HB_LDS + 64;
constexpr int SMEM_CTRL = 2 * HB_LDS;

struct Params {
  const float *x_prompt, *x_sample, *cache_k, *cache_v, *cache_conv, *c_prompt, *c_sample;
  const float *w_ada, *b_ada, *w_in, *b_in, *w_dw, *b_dw, *conv_ln_g, *conv_ln_b;
  const float *lam_q1, *lam_k1, *lam_q2, *lam_k2, *subln_g, *w_out, *b_out, *ln1_g, *ln1_b;
  const float *w_query, *sub_keys, *u_tab, *v_tab, *ln2_g, *ln2_b;
  float* out;
  char* ws;
};
#define P_y_prompt (p.out)
#define P_y_sample (p.out + 33554432)
#define P_k_prompt (p.out + 34603008)
#define P_v_prompt (p.out + 51380224)
#define P_conv_prompt (p.out + 68157440)
#define P_k_sample (p.out + 68403200)
#define P_v_sample (p.out + 68927488)
#define P_conv_sample (p.out + 69451776)
#define P_mod ((float*)(p.ws + OFF_MOD))
#define P_rope ((float2*)(p.ws + OFF_ROPE))
#define P_misc ((float*)(p.ws + OFF_MISC))
#define P_counters ((u32*)(p.ws + OFF_MISC + 256))
#define P_win_t ((u16*)(p.ws + OFF_WIN))
#define P_wout_t ((u16*)(p.ws + OFF_WOUT))
#define P_wq_t ((u16*)(p.ws + OFF_WQ))
#define P_sk ((u16*)(p.ws + OFF_SK))
#define P_utab ((unsigned char*)(p.ws + OFF_UTAB))
#define P_vtab ((unsigned char*)(p.ws + OFF_VTAB))
#define P_usc ((float*)(p.ws + OFF_USC))
#define P_vsc ((float*)(p.ws + OFF_VSC))
#define P_hb ((u16*)(p.ws + OFF_X))
#define P_mix ((u16*)(p.ws + OFF_X))
#define P_ub ((u16*)(p.ws + OFF_Y))
#define P_qb ((u16*)(p.ws + OFF_Y + 34603008))
#define P_kb ((u16*)(p.ws + OFF_Y + 2 * 34603008))
#define P_vb ((u16*)(p.ws + OFF_Y + 3 * 34603008))
#define P_y1 ((_Float16*)(p.ws + OFF_Y))
#define P_r ((u16*)(p.ws + OFF_Z))
#define P_topk ((u32*)(p.ws + OFF_Z))
#define P_elist ((u32*)(p.ws + OFF_Z + 41943040))
#define P_h2 ((u16*)(p.ws + OFF_H2))

DI u32 f2bf(float x) { u32 u = __float_as_uint(x); u += 0x7fffu + ((u >> 16) & 1u); return u >> 16; }
DI u32 pack2(float lo, float hi) { return f2bf(lo) | (f2bf(hi) << 16); }
DI float bf_lo(u32 w) { return __uint_as_float(w << 16); }
DI float bf_hi(u32 w) { return __uint_as_float(w & 0xffff0000u); }
DI int get_tid() { int t = threadIdx.x; asm volatile("" : "+v"(t)); return t; }
DI int crow(int reg, int h) { return (reg & 3) + 8 * (reg >> 2) + 4 * h; }
DI float dpp_xor1(float v) { return __uint_as_float((u32)__builtin_amdgcn_mov_dpp((int)__float_as_uint(v), 0xB1, 0xF, 0xF, true)); }
DI float dpp_xor2(float v) { return __uint_as_float((u32)__builtin_amdgcn_mov_dpp((int)__float_as_uint(v), 0x4E, 0xF, 0xF, true)); }
DI float dpp_ror8(float v) { return __uint_as_float((u32)__builtin_amdgcn_mov_dpp((int)__float_as_uint(v), 0x128, 0xF, 0xF, true)); }
DI float dpp_ror4(float v) { return __uint_as_float((u32)__builtin_amdgcn_mov_dpp((int)__float_as_uint(v), 0x124, 0xF, 0xF, true)); }
DI float xsum32(float x) { const auto r = __builtin_amdgcn_permlane32_swap(__float_as_uint(x), __float_as_uint(x), false, false); return __uint_as_float(r[0]) + __uint_as_float(r[1]); }
DI float xmax32(float x) { const auto r = __builtin_amdgcn_permlane32_swap(__float_as_uint(x), __float_as_uint(x), false, false); return fmaxf(__uint_as_float(r[0]), __uint_as_float(r[1])); }
DI float xsum16(float x) { const auto r = __builtin_amdgcn_permlane16_swap(__float_as_uint(x), __float_as_uint(x), false, false); return __uint_as_float(r[0]) + __uint_as_float(r[1]); }
DI float xmax16(float x) { const auto r = __builtin_amdgcn_permlane16_swap(__float_as_uint(x), __float_as_uint(x), false, false); return fmaxf(__uint_as_float(r[0]), __uint_as_float(r[1])); }
DI float wave_sum(float v) {
  v = xsum32(v);
  v = xsum16(v);
  v += dpp_ror8(v);
  v += dpp_ror4(v);
  v += dpp_xor2(v);
  v += dpp_xor1(v);
  return v;
}
DI float wave_max(float v) {
  v = xmax32(v);
  v = xmax16(v);
  v = fmaxf(v, dpp_ror8(v));
  v = fmaxf(v, dpp_ror4(v));
  v = fmaxf(v, dpp_xor2(v));
  v = fmaxf(v, dpp_xor1(v));
  return v;
}
DI void wave_lds_sync() { asm volatile("s_waitcnt lgkmcnt(0)" ::: "memory"); }
DI uint4 pack8(const float4& a, const float4& b) {
  uint4 r; r.x = pack2(a.x, a.y); r.y = pack2(a.z, a.w); r.z = pack2(b.x, b.y); r.w = pack2(b.z, b.w); return r;
}
DI u32x4 pack8v(const f32x4& a, const f32x4& b) {
  u32x4 r; r[0] = pack2(a[0], a[1]); r[1] = pack2(a[2], a[3]); r[2] = pack2(b[0], b[1]); r[3] = pack2(b[2], b[3]); return r;
}
DI int mod_row(int tok) { return tok < TP ? (tok >> 11) : 16 + ((tok - TP) >> 5); }
DI float dot2bf(u32 a, u32 b, float acc) {
  return __builtin_amdgcn_fdot2_f32_bf16(__builtin_bit_cast(bf16x2_t, a), __builtin_bit_cast(bf16x2_t, b), acc, false);
}


#define XB_TMO      128
#define XB_XCNT(j)  (256  + 64 * (j))
#define XB_XSUB(j)  (1280 + 64 * (j))
#define XB_XGEN(j)  (2304 + 64 * (j))
#define XB_TOP      3328
#define XB_TOPGEN   3392
#define XCD_BAR_WORDS 3456
#define XB_SPIN_CAP (1u << 18)
DI unsigned xb_ld(unsigned* p)              { return __hip_atomic_load(p, __ATOMIC_RELAXED, __HIP_MEMORY_SCOPE_AGENT); }
DI unsigned xb_add(unsigned* p, unsigned v) { return __hip_atomic_fetch_add(p, v, __ATOMIC_RELAXED, __HIP_MEMORY_SCOPE_AGENT); }
DI unsigned xb_xcc_id() { return (unsigned)__builtin_amdgcn_s_getreg((3 << 11) | 20) & 0xFu; }
#define XB_SPIN(cond, bar) do { unsigned _sp = 0; while (cond) { __builtin_amdgcn_s_sleep(1); \
    if ((++_sp & 255u) == 0u) { if (xb_ld(&(bar)[XB_TMO])) break; if (_sp > XB_SPIN_CAP) { atomicAdd(&(bar)[XB_TMO], 1u); break; } } } } while (0)
struct XcdBarrier { unsigned* bar; unsigned x; volatile LAS unsigned* st; };
DI XcdBarrier xcd_barrier_post(unsigned* bar, volatile LAS unsigned* st) {
  XcdBarrier b; b.bar = bar; b.x = xb_xcc_id(); b.st = st;
  if (threadIdx.x == 0) (void)xb_add(&bar[XB_XCNT(b.x)], 1u);
  return b;
}
DI void xcd_barrier_complete(unsigned* bar, unsigned x, unsigned& nloc, unsigned& nx) {
  const unsigned G = gridDim.x * gridDim.y * gridDim.z;
  unsigned sum, cnt, mine, sp = 0u;
  for (;;) {
    sum = 0u; cnt = 0u; mine = 0u;
#pragma unroll
    for (unsigned j = 0; j < 16; ++j) { const unsigned c = xb_ld(&bar[XB_XCNT(j)]); sum += c; cnt += (c > 0u) ? 1u : 0u; mine = (j == x) ? c : mine; }
    if (sum == G) break;
    __builtin_amdgcn_s_sleep(1);
    if ((++sp & 255u) == 0u) { if (xb_ld(&bar[XB_TMO])) break; if (sp > XB_SPIN_CAP) { atomicAdd(&bar[XB_TMO], 1u); break; } }
  }
  nloc = mine > 0u ? mine : 1u; nx = cnt > 0u ? cnt : 1u;
}
DI void xcd_barrier(const XcdBarrier& b) {
  asm volatile("s_waitcnt vmcnt(0)" ::: "memory");
  __syncthreads();
  if (threadIdx.x == 0) {
    unsigned* bar = b.bar;
    __builtin_amdgcn_s_waitcnt(0);
    unsigned nloc = b.st[0], nx = b.st[1];
    if (nloc == 0u) { xcd_barrier_complete(bar, b.x, nloc, nx); b.st[0] = nloc; b.st[1] = nx; }
    const unsigned old = xb_add(&bar[XB_XSUB(b.x)], 1u);
    const unsigned gen = old / nloc;
    if (old + 1u == (gen + 1u) * nloc) {
      __builtin_amdgcn_fence(__ATOMIC_RELEASE, "agent");
      asm volatile("s_waitcnt vmcnt(0)" ::: "memory");
      const unsigned og = xb_add(&bar[XB_TOP], 1u);
      const unsigned tg = og / nx;
      if (og + 1u == (tg + 1u) * nx) xb_add(&bar[XB_TOPGEN], 1u);
      else XB_SPIN(xb_ld(&bar[XB_TOPGEN]) == tg, bar);
      __builtin_amdgcn_fence(__ATOMIC_ACQUIRE, "agent");
      xb_add(&bar[XB_XGEN(b.x)], 1u);
      asm volatile("s_waitcnt vmcnt(0)" ::: "memory");
    } else {
      XB_SPIN(xb_ld(&bar[XB_XGEN(b.x)]) == gen, bar);
      __builtin_amdgcn_fence(__ATOMIC_ACQUIRE, "agent");
      asm volatile("s_waitcnt vmcnt(0)" ::: "memory");
    }
  }
  __syncthreads();
}

DI void prep_mod(const Params& p, int item, char* smem) {
  float* sc = (float*)smem;
  float* red = (float*)(smem + 24576);
  const int tid = (get_tid() & 255), col = tid & 31, kg = tid >> 5;
  const int n0 = item * 32;
  float acc[48];
#pragma unroll
  for (int b = 0; b < 48; ++b) acc[b] = 0.f;
  for (int kc = 0; kc < 1024; kc += 128) {
    f32x4 cv[6];
#pragma unroll
    for (int j2 = 0; j2 < 6; ++j2) {
      const int b = (tid >> 5) + 8 * j2;
      const float* cp = (b < 16) ? p.c_prompt + b * 1024 : p.c_sample + (b - 16) * 1024;
      cv[j2] = *(const f32x4*)(cp + kc + (tid & 31) * 4);
    }
    float wv[16];
#pragma unroll
    for (int i = 0; i < 16; ++i) wv[i] = p.w_ada[(size_t)(kc + kg * 16 + i) * 6144 + n0 + col];
    __syncthreads();
#pragma unroll
    for (int j2 = 0; j2 < 6; ++j2) {
      const int b = (tid >> 5) + 8 * j2;
#pragma unroll
      for (int e = 0; e < 4; ++e) {
        const float c = cv[j2][e];
        sc[((tid & 31) * 4 + e) * 48 + b] = c / (1.f + __expf(-c));
      }
    }
    __syncthreads();
#pragma unroll
    for (int i = 0; i < 16; ++i) {
      const int kk = kg * 16 + i;
      const float w = wv[i];
      const float4* s4 = (const float4*)(sc + kk * 48);
#pragma unroll
      for (int q = 0; q < 12; ++q) {
        const float4 sv = s4[q];
        acc[4 * q + 0] += sv.x * w; acc[4 * q + 1] += sv.y * w; acc[4 * q + 2] += sv.z * w; acc[4 * q + 3] += sv.w * w;
      }
    }
  }
  __syncthreads();
#pragma unroll
  for (int b = 0; b < 48; ++b) red[(kg * 48 + b) * 32 + col] = acc[b];
  __syncthreads();
  for (int i = tid; i < 1536; i += 256) {
    const int b = i >> 5, c = i & 31;
    float sum = 0.f;
#pragma unroll
    for (int g = 0; g < 8; ++g) sum += red[(g * 48 + b) * 32 + c];
    P_mod[b * 6144 + n0 + c] = sum + p.b_ada[n0 + c];
  }
}

DI void prep_transpose(const float* __restrict__ W, int N, u16* __restrict__ Wt, int tile, bool conv_perm, char* smem) {
  float* ts = (float*)smem;
  const int tid = (get_tid() & 255);
  const int nT = N >> 6;
  const int kt = tile / nT, nt = tile - kt * nT;
  __syncthreads();
#pragma unroll
  for (int j = 0; j < 4; ++j) {
    const int kr = (tid >> 4) + 16 * j, c4 = (tid & 15) * 4;
    const float4 v = *(const float4*)(W + (size_t)(kt * 64 + kr) * N + nt * 64 + c4);
    ts[kr * 65 + c4 + 0] = v.x; ts[kr * 65 + c4 + 1] = v.y; ts[kr * 65 + c4 + 2] = v.z; ts[kr * 65 + c4 + 3] = v.w;
  }
  __syncthreads();
  const int n = tid >> 2, k0 = (tid & 3) * 16;
  u32 w[8];
#pragma unroll
  for (int i = 0; i < 8; ++i) w[i] = pack2(ts[(k0 + 2 * i) * 65 + n], ts[(k0 + 2 * i + 1) * 65 + n]);
  int nn = nt * 64 + n;
  if (conv_perm && nn < 1024) { const int c = nn & 511, isb = nn >> 9; nn = (c >> 5) * 64 + isb * 32 + (c & 31); }
  uint4* dst = (uint4*)(Wt + (size_t)nn * 1024 + kt * 64 + k0);
  dst[0] = make_uint4(w[0], w[1], w[2], w[3]);
  dst[1] = make_uint4(w[4], w[5], w[6], w[7]);
}

DI void prep_convert(const float* __restrict__ src, u16* __restrict__ dst, size_t base) {
  const int tid = (get_tid() & 255);
#pragma unroll
  for (int j = 0; j < 4; ++j) {
    const size_t e = base + (size_t)(j * 256 + tid) * 8;
    const float4 a = *(const float4*)(src + e), b = *(const float4*)(src + e + 4);
    *(uint4*)(dst + e) = pack8(a, b);
  }
}


DI void prep_row_fp6(const float* __restrict__ src, unsigned char* __restrict__ dst, float* __restrict__ scl, int row, int lane) {
  const int l5 = lane & 31;
  const float* rp = src + (size_t)row * 1024;
  f32x4 v[8];
#pragma unroll
  for (int j = 0; j < 8; ++j) v[j] = *(const f32x4*)(rp + 128 * j + 4 * l5);
  float am = 0.f;
#pragma unroll
  for (int j = 0; j < 8; ++j) am = fmaxf(am, fmaxf(fmaxf(fabsf(v[j][0]), fabsf(v[j][1])), fmaxf(fabsf(v[j][2]), fabsf(v[j][3]))));
  am = xmax16(am); am = fmaxf(am, dpp_ror8(am)); am = fmaxf(am, dpp_ror4(am)); am = fmaxf(am, dpp_xor2(am)); am = fmaxf(am, dpp_xor1(am));
  const float sc = am > 0.f ? am * (1.f / 7.f) : 1.f;
  const float inv = 1.f / sc;
  f32x16 lo, hi;
#pragma unroll
  for (int m = 0; m < 16; ++m) { lo[m] = v[m >> 1][2 * (m & 1)] * inv; hi[m] = v[m >> 1][2 * (m & 1) + 1] * inv; }
  const u32x6 q = __builtin_amdgcn_cvt_scalef32_2xpk16_fp6_f32(lo, hi, 1.0f);
  unsigned char* rd = dst + (size_t)row * 768;
  *(u32x4*)(rd + 16 * l5) = u32x4{q[0], q[1], q[2], q[3]};
  *(u32x2*)(rd + 512 + 8 * l5) = u32x2{q[4], q[5]};
  if (l5 == 0) scl[row] = sc;
}

DI void prep_rope(const Params& p, int item) {
  const int idx = item * 256 + (get_tid() & 255);
  if (idx >= 2080 * 32) return;
  const int pos = idx >> 5, d = idx & 31;
  double inv = 1.0;
  for (int i = 0; i < d; ++i) inv *= 0.74989420933245582730;
  const double a = (double)pos * inv;
  const double n = rint(a * 0.63661977236758134308);
  const double r = (a - n * 1.57079632673412561417e+00) - n * 6.07710050650619224932e-11;
  const int q = ((int)n) & 3;
  const double r2 = r * r;
  const double sp = r * (1.0 + r2 * (-1.0 / 6 + r2 * (1.0 / 120 + r2 * (-1.0 / 5040 + r2 * (1.0 / 362880 + r2 * (-1.0 / 39916800 + r2 * (1.0 / 6227020800.0)))))));
  const double cp = 1.0 + r2 * (-0.5 + r2 * (1.0 / 24 + r2 * (-1.0 / 720 + r2 * (1.0 / 40320 + r2 * (-1.0 / 3628800 + r2 * (1.0 / 479001600.0 + r2 * (-1.0 / 87178291200.0)))))));
  double s, c;
  if (q == 0) { s = sp; c = cp; } else if (q == 1) { s = cp; c = -sp; } else if (q == 2) { s = -sp; c = -cp; } else { s = -cp; c = sp; }
  P_rope[idx] = make_float2((float)c, (float)s);
}

DI void phaseA(const Params& p, char* smem) {
  const int hbk = get_tid() >> 8;
  char* sm = smem + hbk * HB_LDS;
  const int total = 1894 + 4096;
  int nxt = 0;
  if (get_tid() == 0) nxt = (int)atomicAdd(P_counters + 32, 1u);
  for (;;) {
    __syncthreads();
    if (get_tid() == 0) *(volatile int*)(smem + SMEM_CTRL) = nxt;
    __syncthreads();
    const int pair = *(volatile int*)(smem + SMEM_CTRL);
    if (pair * 2 >= total) break;
    if (get_tid() == 0) nxt = (int)atomicAdd(P_counters + 32, 1u);
    const int item = pair * 2 + hbk;
    if (item < 192) prep_mod(p, item, sm);
    else if (item < 832) prep_transpose(p.w_in, 2560, P_win_t, item - 192, true, sm);
    else if (item < 1088) prep_transpose(p.w_out, 1024, P_wout_t, item - 832, false, sm);
    else if (item < 1600) prep_transpose(p.w_query, 2048, P_wq_t, item - 1088, false, sm);
    else if (item < 1632) prep_convert(p.sub_keys, P_sk, (size_t)(item - 1600) * 8192);
    else if (item < 1892) prep_rope(p, item - 1632);
    else if (item < 1894) {
      const int l = get_tid() & 255;
      if (item == 1892 && l < 64) {
        const float s1 = wave_sum(p.lam_q1[l] * p.lam_k1[l]);
        const float s2 = wave_sum(p.lam_q2[l] * p.lam_k2[l]);
        if (l == 0) P_misc[0] = expf(s1) - expf(s2) + LAM_INIT;
      }
      if (item == 1892 && l >= 64 && l < 128) {
        const float rep[16] = {0.125f, 0.25f, 0.375f, 0.5f, 0.75f, 1.0f, 1.25f, 1.5f, 1.75f, 2.0f, 2.5f, 3.0f, 3.5f, 4.0f, 5.0f, 7.0f};
        f32x16 lo, hi;
#pragma unroll
        for (int q = 0; q < 16; ++q) { lo[q] = (q & 1) ? -rep[q >> 1] : rep[q >> 1]; hi[q] = (q & 1) ? -rep[8 + (q >> 1)] : rep[8 + (q >> 1)]; }
        const u32x6 qq = __builtin_amdgcn_cvt_scalef32_2xpk16_fp6_f32(lo, hi, 1.0f);
        const f32x32 f = __builtin_amdgcn_cvt_scalef32_pk32_f32_fp6(qq, 1.0f);
        bool ok = true;
#pragma unroll
        for (int q = 0; q < 16; ++q) ok = ok && (f[2 * q] == lo[q]) && (f[2 * q + 1] == hi[q]);
        if (l == 64) P_misc[1] = ok ? 0.f : 1.f;
      }
    } else {
      const int it = item - 1894;
      const int tid = get_tid() & 255, lane = tid & 63, wave = tid >> 6;
      if (it < 2048) prep_row_fp6(p.u_tab, P_utab, P_usc, it * 8 + wave * 2 + (lane >> 5), lane);
      else prep_row_fp6(p.v_tab, P_vtab, P_vsc, (it - 2048) * 8 + wave * 2 + (lane >> 5), lane);
    }
  }
}

DI void phaseA2(const Params& p) {
  const int tid = get_tid(), lane = tid & 63;
  const int gw = (tid >> 6) * gridDim.x + blockIdx.x, nw = gridDim.x * 8;
  for (int tok0 = gw; tok0 < T; tok0 += 2 * nw) {
    f32x4 x[2][4];
    int tk[2];
#pragma unroll
    for (int u = 0; u < 2; ++u) {
      const int tok = tok0 + u * nw < T ? tok0 + u * nw : tok0;
      tk[u] = tok;
      const float* xr = tok < TP ? p.x_prompt + (size_t)tok * 1024 : p.x_sample + (size_t)(tok - TP) * 1024;
#pragma unroll
      for (int hf = 0; hf < 2; ++hf) {
        x[u][2 * hf] = *(const f32x4*)(xr + hf * 512 + lane * 8);
        x[u][2 * hf + 1] = *(const f32x4*)(xr + hf * 512 + lane * 8 + 4);
      }
    }
#pragma unroll
    for (int u = 0; u < 2; ++u) {
      const float* mr = P_mod + mod_row(tk[u]) * 6144;
#pragma unroll
      for (int hf = 0; hf < 2; ++hf) {
        const int c = hf * 512 + lane * 8;
        const f32x4 h0 = *(const f32x4*)(mr + c), h1 = *(const f32x4*)(mr + c + 4);
        const f32x4 s0 = *(const f32x4*)(mr + 1024 + c), s1 = *(const f32x4*)(mr + 1024 + c + 4);
        f32x4 a = x[u][2 * hf], b = x[u][2 * hf + 1];
#pragma unroll
        for (int e = 0; e < 4; ++e) { a[e] = a[e] * (1.f + s0[e]) + h0[e]; b[e] = b[e] * (1.f + s1[e]) + h1[e]; }
        *(u32x4*)(P_hb + (size_t)tk[u] * 1024 + c) = pack8v(a, b);
      }
    }
  }
}

namespace g8 {
constexpr int BK = 64, HALF = 128, HTB = HALF * BK * 2, KD = 1024;
DI int lds_byte(int r, int c) { const int st = (r >> 4) * 2 + (c >> 5), rr = r & 15, cc = c & 31, ob = rr * 64 + cc * 2; return st * 1024 + (ob ^ (((ob >> 9) & 1) << 5)); }
DI void stage_rc(int b, int& R, int& C) { const int st = b / 1024, sb = b % 1024, swz = sb ^ (((sb >> 9) & 1) << 5); R = (st >> 1) * 16 + swz / 64; C = (st & 1) * 32 + (swz % 64) / 2; }
DI void gemm256(const u16* __restrict__ A, const u16* __restrict__ Bt, int brow, int bcol, char* shm, f32x4 (&acc)[2][2][4][2]) {
  const int tid = get_tid();
  const int wid = __builtin_amdgcn_readfirstlane(tid >> 6), lane = tid & 63, wr = wid >> 2, wc = wid & 3, fr = lane & 15, fq = lane >> 4;
#define SA(b, h) (shm + ((b) * 2 + (h)) * HTB)
#define SB(b, h) (shm + (4 + (b) * 2 + (h)) * HTB)
#define STAGE(P, BASE, br, kt) do { const u16* _gb = (BASE) + ((size_t)(br) * KD + (size_t)(kt) * BK); \
    __builtin_amdgcn_global_load_lds((const GAS unsigned*)(_gb + toff0), (LAS unsigned*)((P) + tid * 16), 16, 0, 0); \
    __builtin_amdgcn_global_load_lds((const GAS unsigned*)(_gb + 64 * KD + toff0), (LAS unsigned*)((P) + tid * 16 + 8192), 16, 0, 0); } while (0)
#define LDA(dst, b, h) _Pragma("unroll") for (int m = 0; m < 4; ++m) _Pragma("unroll") for (int k = 0; k < 2; ++k) \
    dst[m][k] = *(const bf16x8*)(SA(b, h) + lds_byte(wr * 64 + m * 16 + fr, k * 32 + fq * 8))
#define LDB(dst, b, h) _Pragma("unroll") for (int n = 0; n < 2; ++n) _Pragma("unroll") for (int k = 0; k < 2; ++k) \
    dst[n][k] = *(const bf16x8*)(SB(b, h) + lds_byte(wc * 32 + n * 16 + fr, k * 32 + fq * 8))
#define MMA(ai, bj, At_, Bt_) do { __builtin_amdgcn_s_setprio(1); \
    _Pragma("unroll") for (int m = 0; m < 4; ++m) _Pragma("unroll") for (int n = 0; n < 2; ++n) _Pragma("unroll") for (int k = 0; k < 2; ++k) \
      acc[ai][bj][m][n] = __builtin_amdgcn_mfma_f32_16x16x32_bf16(At_[m][k], Bt_[n][k], acc[ai][bj][m][n], 0, 0, 0); \
    __builtin_amdgcn_s_setprio(0); } while (0)
#define WAIT_V(n) asm volatile("s_waitcnt vmcnt(" #n ")" ::: "memory")
#define WAIT_L(n) asm volatile("s_waitcnt lgkmcnt(" #n ")" ::: "memory")
#define BAR __builtin_amdgcn_s_barrier()
#define SCHED __builtin_amdgcn_sched_barrier(0)
#pragma unroll
  for (int a = 0; a < 2; ++a)
#pragma unroll
    for (int b = 0; b < 2; ++b)
#pragma unroll
      for (int m = 0; m < 4; ++m)
#pragma unroll
        for (int n = 0; n < 2; ++n) acc[a][b][m][n] = f32x4{0.f, 0.f, 0.f, 0.f};
  bf16x8 At[4][2], B0[2][2], B1[2][2];
  constexpr int nt = KD / BK;
  unsigned toff0;
  { int r_, c_; stage_rc(tid * 16, r_, c_); toff0 = (unsigned)(r_ * KD + c_); }
  STAGE(SB(0, 0), Bt, bcol, 0); STAGE(SA(0, 0), A, brow, 0);
  STAGE(SB(0, 1), Bt, bcol + HALF, 0); STAGE(SA(0, 1), A, brow + HALF, 0);
  if (wr == 1) BAR;
  WAIT_V(4); BAR;
  STAGE(SB(1, 0), Bt, bcol, 1); STAGE(SA(1, 0), A, brow, 1); STAGE(SB(1, 1), Bt, bcol + HALF, 1);
  WAIT_V(6); BAR;
#pragma unroll 1
  for (int t = 0; t < nt - 2; t += 2) {
    LDB(B0, 0, 0); SCHED; LDA(At, 0, 0); STAGE(SA(1, 1), A, brow + HALF, t + 1);
    WAIT_L(8); BAR; WAIT_L(0); MMA(0, 0, At, B0); BAR; SCHED;
    LDB(B1, 0, 1); STAGE(SB(0, 0), Bt, bcol, t + 2);
    BAR; WAIT_L(0); MMA(0, 1, At, B1); BAR;
    LDA(At, 0, 1); STAGE(SA(0, 0), A, brow, t + 2);
    BAR; WAIT_L(0); MMA(1, 0, At, B0); BAR; SCHED;
    STAGE(SB(0, 1), Bt, bcol + HALF, t + 2);
    WAIT_V(6); BAR; MMA(1, 1, At, B1); BAR;
    LDB(B0, 1, 0); SCHED; LDA(At, 1, 0); STAGE(SA(0, 1), A, brow + HALF, t + 2);
    WAIT_L(8); BAR; WAIT_L(0); MMA(0, 0, At, B0); BAR; SCHED;
    LDB(B1, 1, 1); STAGE(SB(1, 0), Bt, bcol, t + 3);
    BAR; WAIT_L(0); MMA(0, 1, At, B1); BAR;
    LDA(At, 1, 1); STAGE(SA(1, 0), A, brow, t + 3);
    BAR; WAIT_L(0); MMA(1, 0, At, B0); BAR; SCHED;
    STAGE(SB(1, 1), Bt, bcol + HALF, t + 3);
    WAIT_V(6); BAR; MMA(1, 1, At, B1); BAR;
  }
  { LDB(B0, 0, 0); LDA(At, 0, 0); STAGE(SA(1, 1), A, brow + HALF, nt - 1);
    BAR; WAIT_L(0); MMA(0, 0, At, B0); BAR;
    LDB(B1, 0, 1); BAR; WAIT_L(0); MMA(0, 1, At, B1); BAR;
    LDA(At, 0, 1); WAIT_V(4); BAR; WAIT_L(0); MMA(1, 0, At, B0); MMA(1, 1, At, B1); BAR; }
  { LDB(B0, 1, 0); LDA(At, 1, 0); WAIT_V(2); BAR; WAIT_L(0); MMA(0, 0, At, B0); BAR;
    LDB(B1, 1, 1); WAIT_V(0); BAR; WAIT_L(0); MMA(0, 1, At, B1); BAR;
    LDA(At, 1, 1); BAR; WAIT_L(0); MMA(1, 0, At, B0); MMA(1, 1, At, B1); BAR; }
  if (wr == 0) BAR;
#undef SA
#undef SB
#undef STAGE
#undef LDA
#undef LDB
#undef MMA
#undef WAIT_V
#undef WAIT_L
#undef BAR
#undef SCHED
}
}

DI bool unit_of(int L, int nM, int nN, int& pm, int& pn) {
  const int nwg = nM * nN;
  if (L >= nwg) return false;
  int wgid = L;
  { const int q = nwg / 8, r = nwg % 8, xcd = wgid % 8, off = wgid / 8; wgid = (xcd < r ? xcd * (q + 1) : r * (q + 1) + (xcd - r) * q) + off; }
  const int nig = 8 * nN, gid = wgid / nig, fm = gid * 8, gsz = (nM - fm) < 8 ? (nM - fm) : 8;
  pm = fm + ((wgid % nig) % gsz); pn = (wgid % nig) / gsz;
  return true;
}
DI void quad_to_lds_f32(const f32x4 (&acc)[2][2][4][2], int bj, char* smem) {
  const int tid = get_tid(), wid = tid >> 6, lane = tid & 63, wr = wid >> 2, wc = wid & 3, fr = lane & 15, fq = lane >> 4;
#pragma unroll
  for (int ai = 0; ai < 2; ++ai) {
    float* Ct = (float*)(smem + ai * HB_LDS);
#pragma unroll
    for (int m = 0; m < 4; ++m)
#pragma unroll
      for (int n = 0; n < 2; ++n)
        *(f32x4*)(Ct + (wc * 32 + n * 16 + fr) * 132 + wr * 64 + m * 16 + fq * 4) = acc[ai][bj][m][n];
  }
}

DI void gemm_tile(const u16* __restrict__ A, const u16* __restrict__ Bt, int m0, int n0, char* smem, f32x16 (&acc)[2][2], int khalf) {
  constexpr int KD = 1024, NK = KD / 128;
  const int tid = get_tid() & 255, lane = tid & 63, wave = tid >> 6, wm = wave >> 1, wn = wave & 1;
  const int r = lane & 31, h = lane >> 5;
  char* As = smem;
  char* Bs = smem + 18432;
  const int lrow = tid >> 3, kc = tid & 7;
  const u16* ag = A + (size_t)(m0 + lrow) * KD + kc * 8 + khalf * 512;
  const u16* bg = Bt + (size_t)(n0 + lrow) * KD + kc * 8 + khalf * 512;
  u32x4 ra0[4], rb0[4], ra1[4], rb1[4];
  {
#pragma unroll
    for (int j = 0; j < 4; ++j) {
      ra0[j] = *(const u32x4*)(ag + (size_t)j * 32 * KD);
      rb0[j] = *(const u32x4*)(bg + (size_t)j * 32 * KD);
    }
#pragma unroll
    for (int j = 0; j < 4; ++j) {
      ra1[j] = *(const u32x4*)(ag + (size_t)j * 32 * KD + 64);
      rb1[j] = *(const u32x4*)(bg + (size_t)j * 32 * KD + 64);
    }
  }
#pragma unroll
  for (int mi = 0; mi < 2; ++mi)
#pragma unroll
    for (int ni = 0; ni < 2; ++ni)
#pragma unroll
      for (int i = 0; i < 16; ++i) acc[mi][ni][i] = 0.f;
  const char* ap = As + (wm * 64 + r) * 144 + h * 16;
  const char* bp = Bs + (wn * 64 + r) * 144 + h * 16;
  char* aw = As + lrow * 144 + kc * 16;
  char* bw = Bs + lrow * 144 + kc * 16;
#define GEMM_STEP(RA, RB, KT)                                                                   \
  {                                                                                             \
    __syncthreads();                                                                            \
    _Pragma("unroll") for (int j = 0; j < 4; ++j) {  \
      *(u32x4*)(aw + j * 32 * 144) = RA[j];                                                     \
      *(u32x4*)(bw + j * 32 * 144) = RB[j];                                                     \
    }                                                                                           \
    __syncthreads();                                                                            \
    if ((KT) + 2 < NK) {                                                                        \
      _Pragma("unroll") for (int j = 0; j < 4; ++j) {                                           \
        RA[j] = *(const u32x4*)(ag + (size_t)j * 32 * KD + ((KT) + 2) * 64);                    \
        RB[j] = *(const u32x4*)(bg + (size_t)j * 32 * KD + ((KT) + 2) * 64);                    \
      }                                                                                         \
    }                                                                                           \
    __builtin_amdgcn_sched_barrier(0);                                                          \
    _Pragma("unroll") for (int ks = 0; ks < 4; ++ks) {                                          \
      const bf16x8 a0 = *(const bf16x8*)(ap + ks * 32), a1 = *(const bf16x8*)(ap + 32 * 144 + ks * 32); \
      const bf16x8 b0 = *(const bf16x8*)(bp + ks * 32), b1 = *(const bf16x8*)(bp + 32 * 144 + ks * 32); \
      acc[0][0] = MFMA32(a0, b0, acc[0][0]);                                                    \
      acc[0][1] = MFMA32(a0, b1, acc[0][1]);                                                    \
      acc[1][0] = MFMA32(a1, b0, acc[1][0]);                                                    \
      acc[1][1] = MFMA32(a1, b1, acc[1][1]);                                                    \
    }                                                                                           \
  }
#pragma unroll 1
  for (int kt = 0; kt < NK; kt += 2) {
    GEMM_STEP(ra0, rb0, kt)
    GEMM_STEP(ra1, rb1, kt + 1)
  }
#undef GEMM_STEP
}


DI void kadd(f32x16 (&acc)[2][2], char* smem, int hbk, int lt) {
  float* Pf = (float*)(smem + HB_LDS);
  const int lane = lt & 63, wave = lt >> 6;
  __syncthreads();
  if (hbk == 1) {
#pragma unroll
    for (int mi = 0; mi < 2; ++mi)
#pragma unroll
      for (int ni = 0; ni < 2; ++ni)
#pragma unroll
        for (int i = 0; i < 16; ++i) Pf[(wave * 64 + (mi * 2 + ni) * 16 + i) * 64 + lane] = acc[mi][ni][i];
  }
  __syncthreads();
  if (hbk == 0) {
#pragma unroll
    for (int mi = 0; mi < 2; ++mi)
#pragma unroll
      for (int ni = 0; ni < 2; ++ni)
#pragma unroll
        for (int i = 0; i < 16; ++i) acc[mi][ni][i] += Pf[(wave * 64 + (mi * 2 + ni) * 16 + i) * 64 + lane];
  }
}

DI bool leftover_quad(int q, int nM, int nN, int& pm, int& pn, int& ai, int& bj) {
  const int G = (int)gridDim.x, nwg = nM * nN, nfull = nwg / G, nl = nwg - nfull * G;
  if (q >= 4 * nl) return false;
  ai = (q >> 1) & 1; bj = q & 1;
  return unit_of(nfull * G + (q >> 2), nM, nN, pm, pn);
}

DI void b_rowpass(const Params& p, const float* Ct, int m0, int n0, int lt) {
#pragma unroll 2
    for (int it = 0; it < 4; ++it) {
      const int idx = it * 256 + lt;
      const int j = idx & 3, g = (idx >> 2) & 1, row = idx >> 3;
      const int grow = m0 + row;
      const float* cp = Ct + row * 132 + g * 64 + 8 * j;
      f32x4 x1a = *(const f32x4*)cp, x1b = *(const f32x4*)(cp + 4), x2a = *(const f32x4*)(cp + 32), x2b = *(const f32x4*)(cp + 36);
      const int vc = n0 + g * 64 + 8 * j;
      if (n0 < 1024) {
        const int ca = (vc >> 6) * 32 + 8 * j;
        const f32x4 ba0 = *(const f32x4*)(p.b_in + ca), ba1 = *(const f32x4*)(p.b_in + ca + 4);
        const f32x4 bb0 = *(const f32x4*)(p.b_in + 512 + ca), bb1 = *(const f32x4*)(p.b_in + 512 + ca + 4);
        f32x4 u0, u1;
#pragma unroll
        for (int e = 0; e < 4; ++e) {
          u0[e] = (x1a[e] + ba0[e]) / (1.f + __expf(-(x2a[e] + bb0[e])));
          u1[e] = (x1b[e] + ba1[e]) / (1.f + __expf(-(x2b[e] + bb1[e])));
        }
        *(u32x4*)(P_ub + (size_t)grow * 512 + ca) = pack8v(u0, u1);
        float* cs = nullptr;
        if (grow < TP) { const int s = grow & 2047; if (s >= 2018) cs = P_conv_prompt + ((size_t)(grow >> 11) * 30 + (s - 2018)) * 512 + ca; }
        else { const int rs = grow - TP, s = rs & 31; if (s >= 2) cs = P_conv_sample + ((size_t)(rs >> 5) * 30 + (s - 2)) * 512 + ca; }
        if (cs) { *(f32x4*)cs = u0; *(f32x4*)(cs + 4) = u1; }
      } else {
        const f32x4 b1a = *(const f32x4*)(p.b_in + vc), b1b = *(const f32x4*)(p.b_in + vc + 4);
        const f32x4 b2a = *(const f32x4*)(p.b_in + vc + 32), b2b = *(const f32x4*)(p.b_in + vc + 36);
#pragma unroll
        for (int e = 0; e < 4; ++e) { x1a[e] += b1a[e]; x1b[e] += b1b[e]; x2a[e] += b2a[e]; x2b[e] += b2b[e]; }
        if (n0 < 2048) {
          const int pos = grow < TP ? (grow & 2047) : 2048 + ((grow - TP) & 31);
          const f32x4* rp = (const f32x4*)(P_rope + pos * 32 + 8 * j);
          const f32x4 r0 = rp[0], r1 = rp[1], r2 = rp[2], r3 = rp[3];
          f32x4 o1a, o1b, o2a, o2b;
          o1a[0] = x1a[0] * r0[0] - x2a[0] * r0[1]; o2a[0] = x2a[0] * r0[0] + x1a[0] * r0[1];
          o1a[1] = x1a[1] * r0[2] - x2a[1] * r0[3]; o2a[1] = x2a[1] * r0[2] + x1a[1] * r0[3];
          o1a[2] = x1a[2] * r1[0] - x2a[2] * r1[1]; o2a[2] = x2a[2] * r1[0] + x1a[2] * r1[1];
          o1a[3] = x1a[3] * r1[2] - x2a[3] * r1[3]; o2a[3] = x2a[3] * r1[2] + x1a[3] * r1[3];
          o1b[0] = x1b[0] * r2[0] - x2b[0] * r2[1]; o2b[0] = x2b[0] * r2[0] + x1b[0] * r2[1];
          o1b[1] = x1b[1] * r2[2] - x2b[1] * r2[3]; o2b[1] = x2b[1] * r2[2] + x1b[1] * r2[3];
          o1b[2] = x1b[2] * r3[0] - x2b[2] * r3[1]; o2b[2] = x2b[2] * r3[0] + x1b[2] * r3[1];
          o1b[3] = x1b[3] * r3[2] - x2b[3] * r3[3]; o2b[3] = x2b[3] * r3[2] + x1b[3] * r3[3];
          x1a = o1a; x1b = o1b; x2a = o2a; x2b = o2b;
        }
        const bool isq = n0 < 1536, isk = !isq && n0 < 2048;
        const int col = vc - (isq ? 1024 : (isk ? 1536 : 2048));
        u16* db = (isq ? P_qb : (isk ? P_kb : P_vb)) + (size_t)grow * 512 + col;
        *(u32x4*)db = pack8v(x1a, x1b);
        *(u32x4*)(db + 32) = pack8v(x2a, x2b);
        if (!isq) {
          float* fo = (isk ? (grow < TP ? P_k_prompt + (size_t)grow * 512 : P_k_sample + (size_t)(grow - TP) * 512)
                           : (grow < TP ? P_v_prompt + (size_t)grow * 512 : P_v_sample + (size_t)(grow - TP) * 512)) + col;
          *(f32x4*)fo = x1a; *(f32x4*)(fo + 4) = x1b; *(f32x4*)(fo + 32) = x2a; *(f32x4*)(fo + 36) = x2b;
        }
      }
    }
}

DI void phaseB(const Params& p, char* smem) {
  const int nfull = (132 * 10) / (int)gridDim.x;
  for (int i = 0; i < nfull; ++i) {
    int pm, pn;
    if (!unit_of(i * (int)gridDim.x + (int)blockIdx.x, 132, 10, pm, pn)) break;
    f32x4 acc[2][2][4][2];
    __syncthreads();
    g8::gemm256(P_win_t, P_hb, pn * 256, pm * 256, smem, acc);
#pragma unroll
    for (int bj = 0; bj < 2; ++bj) {
      __syncthreads();
      quad_to_lds_f32(acc, bj, smem);
      __syncthreads();
      const int t2 = get_tid(), hbk = t2 >> 8;
      b_rowpass(p, (const float*)(smem + hbk * HB_LDS), pm * 256 + bj * 128, pn * 256 + hbk * 128, t2 & 255);
    }
  }
  for (int q = (int)blockIdx.x;; q += (int)gridDim.x) {
    int pm, pn, ai, bj;
    if (!leftover_quad(q, 132, 10, pm, pn, ai, bj)) break;
    {
      const int t2 = get_tid(), hbk = t2 >> 8, lt = t2 & 255, lane = lt & 63, wave = lt >> 6, wm = wave >> 1, wn = wave & 1, r = lane & 31, h = lane >> 5;
      char* sm = smem + hbk * HB_LDS;
      const int m0 = pm * 256 + ai * 128, n0 = pn * 256 + bj * 128;
      const bool act = hbk == 0;
      f32x16 acc[2][2];
      gemm_tile(P_hb, P_win_t, m0, n0, sm, acc, hbk);
      kadd(acc, smem, hbk, lt);
      __syncthreads();
      float* Ct = (float*)sm;
#pragma unroll
      for (int mi = 0; mi < 2; ++mi)
#pragma unroll
        for (int ni = 0; ni < 2; ++ni)
#pragma unroll
          for (int i = 0; i < 16; ++i) Ct[(wm * 64 + mi * 32 + crow(i, h)) * 132 + wn * 64 + ni * 32 + r] = acc[mi][ni][i];
      __syncthreads();
      if (act) b_rowpass(p, Ct, m0, n0, lt);
    }
  }
}

DI bf16x8 pack_frag(const f32x16& x, int s) {
  u32x4 o;
  if (s == 0)
    asm volatile("v_cvt_pk_bf16_f32 %0, %4, %5\n\tv_cvt_pk_bf16_f32 %1, %6, %7\n\tv_cvt_pk_bf16_f32 %2, %8, %9\n\tv_cvt_pk_bf16_f32 %3, %10, %11\n\ts_nop 1"
                 : "=&v"(o[0]), "=&v"(o[1]), "=&v"(o[2]), "=&v"(o[3])
                 : "v"(x[0]), "v"(x[1]), "v"(x[2]), "v"(x[3]), "v"(x[4]), "v"(x[5]), "v"(x[6]), "v"(x[7]));
  else
    asm volatile("v_cvt_pk_bf16_f32 %0, %4, %5\n\tv_cvt_pk_bf16_f32 %1, %6, %7\n\tv_cvt_pk_bf16_f32 %2, %8, %9\n\tv_cvt_pk_bf16_f32 %3, %10, %11\n\ts_nop 1"
                 : "=&v"(o[0]), "=&v"(o[1]), "=&v"(o[2]), "=&v"(o[3])
                 : "v"(x[8]), "v"(x[9]), "v"(x[10]), "v"(x[11]), "v"(x[12]), "v"(x[13]), "v"(x[14]), "v"(x[15]));
  return __builtin_bit_cast(bf16x8, o);
}

DI void attn_tile_compute(char* smem, int pm, const bf16x8 (&qf)[4], f32x16 (&O)[4], float& m_run, float& l_run, bool mask_hi, int lane) {
  const int r = lane & 31, h = lane >> 5;
  const char* Kp = smem + pm * 9216 + r * 144 + h * 16;
  f32x16 s0, s1;
#pragma unroll
  for (int i = 0; i < 16; ++i) { s0[i] = 0.f; s1[i] = 0.f; }
#pragma unroll
  for (int ks = 0; ks < 4; ++ks) {
    const bf16x8 k0 = *(const bf16x8*)(Kp + ks * 32), k1 = *(const bf16x8*)(Kp + 32 * 144 + ks * 32);
    s0 = MFMA32(k0, qf[ks], s0);
    s1 = MFMA32(k1, qf[ks], s1);
  }
  if (mask_hi) {
#pragma unroll
    for (int i = 0; i < 16; ++i) s1[i] = -INFINITY;
  }
  float mx = s0[0];
#pragma unroll
  for (int i = 1; i < 16; ++i) mx = fmaxf(mx, s0[i]);
#pragma unroll
  for (int i = 0; i < 16; ++i) mx = fmaxf(mx, s1[i]);
  mx = xmax32(mx);
  const float m_new = fmaxf(m_run, mx);
  const float c = 0.125f * 1.4426950408889634f;
  const float alpha = __builtin_amdgcn_exp2f((m_run - m_new) * c);
  const float mc = m_new * c;
  float rs = 0.f;
#pragma unroll
  for (int i = 0; i < 16; ++i) { s0[i] = __builtin_amdgcn_exp2f(s0[i] * c - mc); rs += s0[i]; }
#pragma unroll
  for (int i = 0; i < 16; ++i) { s1[i] = __builtin_amdgcn_exp2f(s1[i] * c - mc); rs += s1[i]; }
  rs = xsum32(rs);
  l_run = l_run * alpha + rs;
  if (__builtin_amdgcn_ballot_w64(m_new != m_run) != 0ull) {
#pragma unroll
    for (int d = 0; d < 4; ++d)
#pragma unroll
      for (int i = 0; i < 16; ++i) O[d][i] *= alpha;
  }
  m_run = m_new;
  bf16x8 pf[4];
  pf[0] = pack_frag(s0, 0); pf[1] = pack_frag(s0, 1); pf[2] = pack_frag(s1, 0); pf[3] = pack_frag(s1, 1);
  const int q4 = (lane & 15) >> 2, p4 = lane & 3, blk = (lane >> 4) & 1;
  const unsigned vbase = (unsigned)(size_t)(smem + 18432) + (4 * h + q4) * 320 + (16 * blk + 4 * p4) * 2;
  s16x4 va[8], vb[8];
#define TR_ISSUE(R, ADDR)                                                                                        \
  asm volatile("ds_read_b64_tr_b16 %0, %8\n\tds_read_b64_tr_b16 %1, %8 offset:2560\n\t"                          \
               "ds_read_b64_tr_b16 %2, %8 offset:64\n\tds_read_b64_tr_b16 %3, %8 offset:2624\n\t"                 \
               "ds_read_b64_tr_b16 %4, %8 offset:128\n\tds_read_b64_tr_b16 %5, %8 offset:2688\n\t"                \
               "ds_read_b64_tr_b16 %6, %8 offset:192\n\tds_read_b64_tr_b16 %7, %8 offset:2752"                    \
               : "=&v"(R[0]), "=&v"(R[1]), "=&v"(R[2]), "=&v"(R[3]), "=&v"(R[4]), "=&v"(R[5]), "=&v"(R[6]), "=&v"(R[7]) \
               : "v"(ADDR) : "memory")
#define TR_WAIT(R, N)                                                                                            \
  asm volatile("s_waitcnt lgkmcnt(" #N ")"                                                                       \
               : "+v"(R[0]), "+v"(R[1]), "+v"(R[2]), "+v"(R[3]), "+v"(R[4]), "+v"(R[5]), "+v"(R[6]), "+v"(R[7]) :: "memory")
#define PV_MFMA(R, KK)                                                                                           \
  O[0] = MFMA32(__builtin_shufflevector(R[0], R[1], 0, 1, 2, 3, 4, 5, 6, 7), pf[KK], O[0]);                      \
  O[1] = MFMA32(__builtin_shufflevector(R[2], R[3], 0, 1, 2, 3, 4, 5, 6, 7), pf[KK], O[1]);                      \
  O[2] = MFMA32(__builtin_shufflevector(R[4], R[5], 0, 1, 2, 3, 4, 5, 6, 7), pf[KK], O[2]);                      \
  O[3] = MFMA32(__builtin_shufflevector(R[6], R[7], 0, 1, 2, 3, 4, 5, 6, 7), pf[KK], O[3]);
  TR_ISSUE(va, vbase);
  TR_ISSUE(vb, vbase + 16 * 320);
  TR_WAIT(va, 8);
  PV_MFMA(va, 0)
  TR_ISSUE(va, vbase + 32 * 320);
  TR_WAIT(vb, 8);
  PV_MFMA(vb, 1)
  TR_ISSUE(vb, vbase + 48 * 320);
  TR_WAIT(va, 8);
  PV_MFMA(va, 2)
  TR_WAIT(vb, 0);
  PV_MFMA(vb, 3)
#undef TR_ISSUE
#undef TR_WAIT
#undef PV_MFMA
}

DI void attn_epilogue(const Params& p, char* smem, int qg, int pm, bool active, f32x16 (&O)[4], float l_run, size_t tok, int hh, int lane) {
  const int r = lane & 31, h = lane >> 5;
  __syncthreads();
  const float inv_l = 1.f / l_run;
  float* X = (float*)smem + qg * 4096;
  if (active && pm == 1) {
#pragma unroll
    for (int d = 0; d < 4; ++d)
#pragma unroll
      for (int i = 0; i < 16; ++i) X[(d * 32 + crow(i, h)) * 32 + r] = O[d][i] * inv_l;
  }
  __syncthreads();
  if (active && pm == 0) {
    const float lam = P_misc[0];
    float ssq = 0.f;
#pragma unroll
    for (int d = 0; d < 4; ++d)
#pragma unroll
      for (int i = 0; i < 16; ++i) {
        const float o = O[d][i] * inv_l - lam * X[(d * 32 + crow(i, h)) * 32 + r];
        O[d][i] = o; ssq += o * o;
      }
    ssq = xsum32(ssq);
    const float rms = rsqrtf(ssq * (1.f / 128.f) + LN_EPS) * (1.f - LAM_INIT);
    u16* dst = P_mix + tok * 1024 + 512 + hh * 128;
#pragma unroll
    for (int d = 0; d < 4; ++d)
#pragma unroll
      for (int g = 0; g < 4; ++g) {
        const int dv = d * 32 + 8 * g + 4 * h;
        const float4 sg = *(const float4*)(p.subln_g + dv);
        uint2 w;
        w.x = pack2(O[d][4 * g + 0] * rms * sg.x, O[d][4 * g + 1] * rms * sg.y);
        w.y = pack2(O[d][4 * g + 2] * rms * sg.z, O[d][4 * g + 3] * rms * sg.w);
        *(uint2*)(dst + dv) = w;
      }
  }
}

DI void attn_prompt_item(const Params& p, int b, int hh, int qp, char* smem) {
  const int tid = get_tid(), lane = tid & 63, wave = tid >> 6, qg = wave >> 1, pm = wave & 1;
  const int r = lane & 31, h = lane >> 5;
  const size_t tok0 = (size_t)b * 2048;
  const size_t tq = tok0 + qp * 128 + qg * 32 + r;
  bf16x8 qf[4];
  {
    const u16* qptr = P_qb + tq * 512 + (hh * 2 + pm) * 64 + h * 8;
#pragma unroll
    for (int ks = 0; ks < 4; ++ks) qf[ks] = *(const bf16x8*)(qptr + ks * 16);
  }
  f32x16 O[4];
#pragma unroll
  for (int d = 0; d < 4; ++d)
#pragma unroll
    for (int i = 0; i < 16; ++i) O[d][i] = 0.f;
  float m_run = -INFINITY, l_run = 0.f;
  const int my_last = qp * 2 + (qg >> 1), nkt = qp * 2 + 2;
  const int lrow = tid >> 5, cc = tid & 31;
  const u16* gsrc;
  int lds_off, lstride;
  if (cc < 16) { gsrc = P_kb + (tok0 + lrow) * 512 + hh * 128 + cc * 8; lds_off = (cc >> 3) * 9216 + lrow * 144 + (cc & 7) * 16; lstride = 144; }
  else { gsrc = P_vb + (tok0 + lrow) * 512 + hh * 128 + (cc - 16) * 8; lds_off = 18432 + lrow * 320 + (cc - 16) * 16; lstride = 320; }
  u32x4 rg[4];
#pragma unroll
  for (int j = 0; j < 4; ++j) rg[j] = *(const u32x4*)(gsrc + (size_t)(16 * j) * 512);
  for (int kt = 0; kt < nkt; ++kt) {
    __syncthreads();
#pragma unroll
    for (int j = 0; j < 4; ++j) *(u32x4*)(smem + lds_off + 16 * j * lstride) = rg[j];
    __syncthreads();
    if (kt + 1 < nkt) {
#pragma unroll
      for (int j = 0; j < 4; ++j) rg[j] = *(const u32x4*)(gsrc + (size_t)((kt + 1) * 64 + 16 * j) * 512);
    }
    __builtin_amdgcn_sched_barrier(0);
    if (kt <= my_last) attn_tile_compute(smem, pm, qf, O, m_run, l_run, false, lane);
  }
  attn_epilogue(p, smem, qg, pm, true, O, l_run, tq, hh, lane);
}

DI void attn_sample_item(const Params& p, int b, int hh, char* smem) {
  const int tid = get_tid(), lane = tid & 63, wave = tid >> 6, qg = wave >> 1, pm = wave & 1;
  const int r = lane & 31, h = lane >> 5;
  const bool active = (qg == 0);
  const size_t tokq0 = (size_t)TP + (size_t)b * 32;
  const size_t tq = tokq0 + r;
  bf16x8 qf[4];
  {
    const u16* qptr = P_qb + tq * 512 + (hh * 2 + pm) * 64 + h * 8;
#pragma unroll
    for (int ks = 0; ks < 4; ++ks) qf[ks] = *(const bf16x8*)(qptr + ks * 16);
  }
  f32x16 O[4];
#pragma unroll
  for (int d = 0; d < 4; ++d)
#pragma unroll
    for (int i = 0; i < 16; ++i) O[d][i] = 0.f;
  float m_run = -INFINITY, l_run = 0.f;
  const int lrow = tid >> 5, cc = tid & 31;
  const float* fsrc;
  const u16* bsrc;
  int lds_off, lstride;
  if (cc < 16) {
    fsrc = p.cache_k + ((size_t)b * 2048 + lrow) * 512 + hh * 128 + cc * 8;
    bsrc = P_kb + (tokq0 + lrow) * 512 + hh * 128 + cc * 8;
    lds_off = (cc >> 3) * 9216 + lrow * 144 + (cc & 7) * 16; lstride = 144;
  } else {
    fsrc = p.cache_v + ((size_t)b * 2048 + lrow) * 512 + hh * 128 + (cc - 16) * 8;
    bsrc = P_vb + (tokq0 + lrow) * 512 + hh * 128 + (cc - 16) * 8;
    lds_off = 18432 + lrow * 320 + (cc - 16) * 16; lstride = 320;
  }
  f32x4 rf[8];
#pragma unroll
  for (int j = 0; j < 4; ++j) {
    rf[2 * j] = *(const f32x4*)(fsrc + (size_t)(16 * j) * 512);
    rf[2 * j + 1] = *(const f32x4*)(fsrc + (size_t)(16 * j) * 512 + 4);
  }
  for (int kt = 0; kt <= 32; ++kt) {
    __syncthreads();
    if (kt < 32) {
#pragma unroll
      for (int j = 0; j < 4; ++j) *(u32x4*)(smem + lds_off + 16 * j * lstride) = pack8v(rf[2 * j], rf[2 * j + 1]);
    } else {
#pragma unroll
      for (int j = 0; j < 4; ++j) {
        u32x4 v = {0u, 0u, 0u, 0u};
        if (j < 2) v = *(const u32x4*)(bsrc + (size_t)(16 * j) * 512);
        *(u32x4*)(smem + lds_off + 16 * j * lstride) = v;
      }
    }
    __syncthreads();
    if (kt + 1 < 32) {
#pragma unroll
      for (int j = 0; j < 4; ++j) {
        rf[2 * j] = *(const f32x4*)(fsrc + (size_t)((kt + 1) * 64 + 16 * j) * 512);
        rf[2 * j + 1] = *(const f32x4*)(fsrc + (size_t)((kt + 1) * 64 + 16 * j) * 512 + 4);
      }
    }
    __builtin_amdgcn_sched_barrier(0);
    if (active) attn_tile_compute(smem, pm, qf, O, m_run, l_run, kt == 32, lane);
  }
  attn_epilogue(p, smem, qg, pm, active, O, l_run, tq, hh, lane);
}

DI void conv_item(const Params& p, int ci, char* smem) {
  const int tid = get_tid(), lane = tid & 63, wave = tid >> 6;
  const bool sample = ci >= 1024;
  const int b = sample ? ci - 1024 : ci >> 6;
  const int s0 = sample ? 0 : (ci & 63) * 32;
  const size_t tokbase = sample ? (size_t)TP + (size_t)b * 32 : (size_t)b * 2048;
  const float* hist = p.cache_conv + (size_t)b * 30 * 512;
  float* U = (float*)smem;
  float cw[31];
#pragma unroll
  for (int j = 0; j < 31; ++j) cw[j] = p.w_dw[j * 512 + tid];
  const float cbias = p.b_dw[tid];
  {
    u32x4 st[8];
#pragma unroll
    for (int it = 0; it < 8; ++it) {
      const int c = it * 512 + tid;
      const int rr = c >> 6, ch = c & 63;
      const int s = s0 - 30 + rr;
      u32x4 v = {0u, 0u, 0u, 0u};
      if (c < 62 * 64) {
        if (s >= 0) v = *(const u32x4*)(P_ub + (tokbase + s) * 512 + ch * 8);
        else if (sample) {
          const float* hp = hist + (30 + s) * 512 + ch * 8;
          v = pack8v(*(const f32x4*)hp, *(const f32x4*)(hp + 4));
        }
      }
      st[it] = v;
    }
    __syncthreads();
#pragma unroll
    for (int it = 0; it < 8; ++it) {
      const int c = it * 512 + tid;
      if (c < 62 * 64) {
        float* d = U + (c >> 6) * 512 + (c & 63) * 8;
        *(f32x4*)d = f32x4{bf_lo(st[it][0]), bf_hi(st[it][0]), bf_lo(st[it][1]), bf_hi(st[it][1])};
        *(f32x4*)(d + 4) = f32x4{bf_lo(st[it][2]), bf_hi(st[it][2]), bf_lo(st[it][3]), bf_hi(st[it][3])};
      }
    }
  }
  __syncthreads();
  {
    float cacc[32];
#pragma unroll
    for (int i = 0; i < 32; ++i) cacc[i] = cbias;
#pragma unroll
    for (int r = 0; r < 62; ++r) {
      const float u = U[r * 512 + tid];
#pragma unroll
      for (int i = 0; i < 32; ++i)
        if (r - i >= 0 && r - i <= 30) cacc[i] += cw[r - i] * u;
    }
    __syncthreads();
#pragma unroll
    for (int i = 0; i < 32; ++i) U[i * 512 + tid] = cacc[i];
  }
  __syncthreads();
  const int c0 = lane * 8;
  float acc[4][8];
#pragma unroll
  for (int i = 0; i < 4; ++i) {
    const float* yp = U + (wave * 4 + i) * 512 + c0;
    const f32x4 a0 = *(const f32x4*)yp, a1 = *(const f32x4*)(yp + 4);
#pragma unroll
    for (int e = 0; e < 4; ++e) { acc[i][e] = a0[e]; acc[i][4 + e] = a1[e]; }
  }
  float gg[8], gb[8];
  {
    const f32x4 g0 = *(const f32x4*)(p.conv_ln_g + c0), g1 = *(const f32x4*)(p.conv_ln_g + c0 + 4);
    const f32x4 e0 = *(const f32x4*)(p.conv_ln_b + c0), e1 = *(const f32x4*)(p.conv_ln_b + c0 + 4);
#pragma unroll
    for (int e = 0; e < 4; ++e) { gg[e] = g0[e]; gg[4 + e] = g1[e]; gb[e] = e0[e]; gb[4 + e] = e1[e]; }
  }
#pragma unroll
  for (int i = 0; i < 4; ++i) {
    float s = 0.f;
#pragma unroll
    for (int c = 0; c < 8; ++c) s += acc[i][c];
    const float mu = wave_sum(s) * (1.f / 512.f);
    float v = 0.f;
#pragma unroll
    for (int c = 0; c < 8; ++c) { acc[i][c] -= mu; v += acc[i][c] * acc[i][c]; }
    const float rstd = rsqrtf(wave_sum(v) * (1.f / 512.f) + LN_EPS);
    float y[8];
#pragma unroll
    for (int c = 0; c < 8; ++c) {
      const float t = acc[i][c] * rstd * gg[c] + gb[c];
      y[c] = t / (1.f + __expf(-t));
    }
    u32x4 w;
    w[0] = pack2(y[0], y[1]); w[1] = pack2(y[2], y[3]); w[2] = pack2(y[4], y[5]); w[3] = pack2(y[6], y[7]);
    *(u32x4*)(P_mix + (tokbase + s0 + wave * 4 + i) * 1024 + c0) = w;
  }
}

DI void phaseC(const Params& p, char* smem) {
  const int total = 128 + 1024 + 1056;
  int nxt = 0;
  if (get_tid() == 0) nxt = (int)atomicAdd(P_counters, 1u);
  for (;;) {
    __syncthreads();
    if (get_tid() == 0) *(volatile int*)(smem + SMEM_CTRL) = nxt;
    __syncthreads();
    const int item = *(volatile int*)(smem + SMEM_CTRL);
    if (item >= total) break;
    if (get_tid() == 0) nxt = (int)atomicAdd(P_counters, 1u);
    if (item < 128) attn_sample_item(p, item >> 2, item & 3, smem);
    else if (item < 1152) { const int i = item - 128; const int qp = 15 - (i >> 6), bh = i & 63; attn_prompt_item(p, bh >> 2, bh & 3, qp, smem); }
    else conv_item(p, item - 1152, smem);
  }
}

DI void d_rowstore(const Params& p, const float* Ct, int m0, int n0, int lt) {
  const int c8 = (lt & 15) * 8;
  const f32x4 bo0 = *(const f32x4*)(p.b_out + n0 + c8), bo1 = *(const f32x4*)(p.b_out + n0 + c8 + 4);
#pragma unroll
  for (int it = 0; it < 8; ++it) {
    const int row = it * 16 + (lt >> 4);
    f32x4 a = *(const f32x4*)(Ct + row * 132 + c8), b = *(const f32x4*)(Ct + row * 132 + c8 + 4);
#pragma unroll
    for (int e = 0; e < 4; ++e) { a[e] += bo0[e]; b[e] += bo1[e]; }
    *(u32x4*)(P_r + (size_t)(m0 + row) * 1024 + n0 + c8) = pack8v(a, b);
  }
}
DI void phaseD(const Params& p, char* smem) {
  const int nfull = (132 * 4) / (int)gridDim.x;
  for (int i = 0; i < nfull; ++i) {
    int pm, pn;
    if (!unit_of(i * (int)gridDim.x + (int)blockIdx.x, 132, 4, pm, pn)) break;
    f32x4 acc[2][2][4][2];
    __syncthreads();
    g8::gemm256(P_wout_t, P_mix, pn * 256, pm * 256, smem, acc);
#pragma unroll
    for (int bj = 0; bj < 2; ++bj) {
      __syncthreads();
      quad_to_lds_f32(acc, bj, smem);
      __syncthreads();
      const int t2 = get_tid(), hbk = t2 >> 8, lt = t2 & 255;
      d_rowstore(p, (const float*)(smem + hbk * HB_LDS), pm * 256 + bj * 128, pn * 256 + hbk * 128, lt);
    }
  }
  for (int q = (int)blockIdx.x;; q += (int)gridDim.x) {
    int pm, pn, ai, bj;
    if (!leftover_quad(q, 132, 4, pm, pn, ai, bj)) break;
    {
      const int t2 = get_tid(), hbk = t2 >> 8, lt = t2 & 255, lane = lt & 63, wave = lt >> 6, wm = wave >> 1, wn = wave & 1, r = lane & 31, h = lane >> 5;
      char* sm = smem + hbk * HB_LDS;
      const int m0 = pm * 256 + ai * 128, n0 = pn * 256 + bj * 128;
      const bool act = hbk == 0;
      f32x16 acc[2][2];
      gemm_tile(P_mix, P_wout_t, m0, n0, sm, acc, hbk);
      kadd(acc, smem, hbk, lt);
      __syncthreads();
      float* Ct = (float*)sm;
#pragma unroll
      for (int mi = 0; mi < 2; ++mi)
#pragma unroll
        for (int ni = 0; ni < 2; ++ni)
#pragma unroll
          for (int i = 0; i < 16; ++i) Ct[(wm * 64 + mi * 32 + crow(i, h)) * 132 + wn * 64 + ni * 32 + r] = acc[mi][ni][i];
      __syncthreads();
      if (act) d_rowstore(p, Ct, m0, n0, lt);
    }
  }
}

DI void phaseE(const Params& p) {
  const int tid = get_tid(), lane = tid & 63;
  const int gw = (tid >> 6) * gridDim.x + blockIdx.x, nw = gridDim.x * 8;
  for (int tok0 = gw; tok0 < T; tok0 += 2 * nw) {
    float v[2][16];
    int tk[2];
#pragma unroll
    for (int u = 0; u < 2; ++u) {
      const int tok = tok0 + u * nw < T ? tok0 + u * nw : tok0;
      tk[u] = tok;
      const u16* rr = P_r + (size_t)tok * 1024;
      const float* xr = tok < TP ? p.x_prompt + (size_t)tok * 1024 : p.x_sample + (size_t)(tok - TP) * 1024;
      const float* gr = P_mod + mod_row(tok) * 6144 + 2048;
#pragma unroll
      for (int hf = 0; hf < 2; ++hf) {
        const int c = hf * 512 + lane * 8;
        const u32x4 rw = *(const u32x4*)(rr + c);
        f32x4 a, b;
        a[0] = bf_lo(rw[0]); a[1] = bf_hi(rw[0]); a[2] = bf_lo(rw[1]); a[3] = bf_hi(rw[1]);
        b[0] = bf_lo(rw[2]); b[1] = bf_hi(rw[2]); b[2] = bf_lo(rw[3]); b[3] = bf_hi(rw[3]);
        const f32x4 xa = *(const f32x4*)(xr + c), xb = *(const f32x4*)(xr + c + 4);
        const f32x4 ga = *(const f32x4*)(gr + c), gb = *(const f32x4*)(gr + c + 4);
#pragma unroll
        for (int e = 0; e < 4; ++e) { v[u][hf * 8 + e] = ALPHA * xa[e] + ga[e] * a[e]; v[u][hf * 8 + 4 + e] = ALPHA * xb[e] + gb[e] * b[e]; }
      }
    }
#pragma unroll
    for (int u = 0; u < 2; ++u) {
      const int tok = tk[u];
      const float* mr = P_mod + mod_row(tok) * 6144;
      float s = 0.f;
#pragma unroll
      for (int i = 0; i < 16; ++i) s += v[u][i];
      const float mu = wave_sum(s) * (1.f / 1024.f);
      float q = 0.f;
#pragma unroll
      for (int i = 0; i < 16; ++i) { v[u][i] -= mu; q += v[u][i] * v[u][i]; }
      const float rstd = rsqrtf(wave_sum(q) * (1.f / 1024.f) + LN_EPS);
#pragma unroll
      for (int hf = 0; hf < 2; ++hf) {
        const int c = hf * 512 + lane * 8;
        f32x4 y0, y1, h0, h1;
        const f32x4 g0 = *(const f32x4*)(p.ln1_g + c), g1 = *(const f32x4*)(p.ln1_g + c + 4);
        const f32x4 b0 = *(const f32x4*)(p.ln1_b + c), b1 = *(const f32x4*)(p.ln1_b + c + 4);
        const f32x4 sc0 = *(const f32x4*)(mr + 4096 + c), sc1 = *(const f32x4*)(mr + 4096 + c + 4);
        const f32x4 sh0 = *(const f32x4*)(mr + 3072 + c), sh1 = *(const f32x4*)(mr + 3072 + c + 4);
#pragma unroll
        for (int e = 0; e < 4; ++e) {
          y0[e] = v[u][hf * 8 + e] * rstd * g0[e] + b0[e];
          y1[e] = v[u][hf * 8 + 4 + e] * rstd * g1[e] + b1[e];
          h0[e] = y0[e] * (1.f + sc0[e]) + sh0[e];
          h1[e] = y1[e] * (1.f + sc1[e]) + sh1[e];
        }
        u32x4 yw;
        yw[0] = __builtin_bit_cast(u32, h16x2{(_Float16)y0[0], (_Float16)y0[1]}); yw[1] = __builtin_bit_cast(u32, h16x2{(_Float16)y0[2], (_Float16)y0[3]});
        yw[2] = __builtin_bit_cast(u32, h16x2{(_Float16)y1[0], (_Float16)y1[1]}); yw[3] = __builtin_bit_cast(u32, h16x2{(_Float16)y1[2], (_Float16)y1[3]});
        *(u32x4*)(P_y1 + (size_t)tok * 1024 + c) = yw;
        *(u32x4*)(P_h2 + (size_t)tok * 1024 + c) = pack8v(h0, h1);
      }
    }
  }
}

DI u32 make_key(float s, int idx) {
  u32 u = __float_as_uint(s);
  u ^= ((u32)((int)u >> 31)) | 0x80000000u;
  return (u & ~127u) | (u32)idx;
}
DI float key_val(u32 key) {
  const u32 kb = key & ~127u;
  return __uint_as_float(kb ^ ((~(u32)((int)kb >> 31)) | 0x80000000u));
}
#define CE_DESC(a, b) { const u32 _x = max(a, b); const u32 _n = min(a, b); a = _x; b = _n; }
DI void bitonic_merge16(u32 (&v)[16]) {
#pragma unroll
  for (int j = 8; j > 0; j >>= 1)
#pragma unroll
    for (int i = 0; i < 16; ++i) {
      const int l = i ^ j;
      if (l > i) CE_DESC(v[i], v[l]);
    }
}
DI void sort16(u32 (&v)[16]) {
  CE_DESC(v[0], v[13]); CE_DESC(v[1], v[12]); CE_DESC(v[2], v[15]); CE_DESC(v[3], v[14]); CE_DESC(v[4], v[8]); CE_DESC(v[5], v[6]); CE_DESC(v[7], v[11]); CE_DESC(v[9], v[10]);
  CE_DESC(v[0], v[5]); CE_DESC(v[1], v[7]); CE_DESC(v[2], v[9]); CE_DESC(v[3], v[4]); CE_DESC(v[6], v[13]); CE_DESC(v[8], v[14]); CE_DESC(v[10], v[15]); CE_DESC(v[11], v[12]);
  CE_DESC(v[0], v[1]); CE_DESC(v[2], v[3]); CE_DESC(v[4], v[5]); CE_DESC(v[6], v[8]); CE_DESC(v[7], v[9]); CE_DESC(v[10], v[11]); CE_DESC(v[12], v[13]); CE_DESC(v[14], v[15]);
  CE_DESC(v[0], v[2]); CE_DESC(v[1], v[3]); CE_DESC(v[4], v[10]); CE_DESC(v[5], v[11]); CE_DESC(v[6], v[7]); CE_DESC(v[8], v[9]); CE_DESC(v[12], v[14]); CE_DESC(v[13], v[15]);
  CE_DESC(v[1], v[2]); CE_DESC(v[3], v[12]); CE_DESC(v[4], v[6]); CE_DESC(v[5], v[7]); CE_DESC(v[8], v[10]); CE_DESC(v[9], v[11]); CE_DESC(v[13], v[14]);
  CE_DESC(v[1], v[4]); CE_DESC(v[2], v[6]); CE_DESC(v[5], v[8]); CE_DESC(v[7], v[10]); CE_DESC(v[9], v[13]); CE_DESC(v[11], v[14]);
  CE_DESC(v[2], v[4]); CE_DESC(v[3], v[6]); CE_DESC(v[9], v[12]); CE_DESC(v[11], v[13]);
  CE_DESC(v[3], v[5]); CE_DESC(v[6], v[8]); CE_DESC(v[7], v[9]); CE_DESC(v[10], v[12]);
  CE_DESC(v[3], v[4]); CE_DESC(v[5], v[6]); CE_DESC(v[7], v[8]); CE_DESC(v[9], v[10]); CE_DESC(v[11], v[12]);
  CE_DESC(v[6], v[7]); CE_DESC(v[8], v[9]);
}
DI void merge_top16(u32 (&a)[16], const u32 (&b)[16]) {
#pragma unroll
  for (int i = 0; i < 16; ++i) a[i] = max(a[i], b[15 - i]);
  bitonic_merge16(a);
}

DI void f_epilogue(const Params& p, char* sm, int m0, int hp, int lt) {
  const int lane = lt & 63, wave = lt >> 6, wm = wave >> 1, wn = wave & 1;
  const int r = lane & 31, h = lane >> 5;
  u32* PL = (u32*)sm;
  char* Qs = sm + 32768;
  {
    bf16x8 ska[8], skb[8];
    {
      const u16* skp = P_sk + ((size_t)hp * 128 + wm * 64 + r) * 128 + h * 8;
#pragma unroll
      for (int ks = 0; ks < 8; ++ks) { ska[ks] = *(const bf16x8*)(skp + ks * 16); skb[ks] = *(const bf16x8*)(skp + 32 * 128 + ks * 16); }
    }
    __syncthreads();
    f32x16 st[2][2];
#pragma unroll
    for (int a = 0; a < 2; ++a)
#pragma unroll
      for (int b = 0; b < 2; ++b)
#pragma unroll
        for (int i = 0; i < 16; ++i) st[a][b][i] = 0.f;
    {
      const char* qp = Qs + (wn * 64 + r) * 272 + h * 16;
#pragma unroll
      for (int ks = 0; ks < 8; ++ks) {
        const bf16x8 b0 = *(const bf16x8*)(qp + ks * 32), b1 = *(const bf16x8*)(qp + 32 * 272 + ks * 32);
        st[0][0] = MFMA32(ska[ks], b0, st[0][0]);
        st[0][1] = MFMA32(ska[ks], b1, st[0][1]);
        st[1][0] = MFMA32(skb[ks], b0, st[1][0]);
        st[1][1] = MFMA32(skb[ks], b1, st[1][1]);
      }
    }
#pragma unroll
    for (int nt = 0; nt < 2; ++nt) {
      u32 va[16], vb[16];
#pragma unroll
      for (int i = 0; i < 16; ++i) {
        va[i] = make_key(st[0][nt][i], wm * 64 + crow(i, h));
        vb[i] = make_key(st[1][nt][i], wm * 64 + 32 + crow(i, h));
      }
      sort16(va);
      sort16(vb);
      merge_top16(va, vb);
      u32* dst = PL + ((wn * 64 + nt * 32 + r) * 4 + wm * 2 + h) * 16;
#pragma unroll
      for (int q = 0; q < 4; ++q) *(uint4*)(dst + 4 * q) = make_uint4(va[4 * q], va[4 * q + 1], va[4 * q + 2], va[4 * q + 3]);
    }
    __syncthreads();
    if (lt < 128) {
      u32 l0[16], l1[16], l2[16], l3[16];
      const u32* src = PL + lt * 64;
#pragma unroll
      for (int q = 0; q < 4; ++q) {
        const uint4 a = *(const uint4*)(src + 4 * q), b = *(const uint4*)(src + 16 + 4 * q);
        const uint4 c = *(const uint4*)(src + 32 + 4 * q), d = *(const uint4*)(src + 48 + 4 * q);
        l0[4 * q] = a.x; l0[4 * q + 1] = a.y; l0[4 * q + 2] = a.z; l0[4 * q + 3] = a.w;
        l1[4 * q] = b.x; l1[4 * q + 1] = b.y; l1[4 * q + 2] = b.z; l1[4 * q + 3] = b.w;
        l2[4 * q] = c.x; l2[4 * q + 1] = c.y; l2[4 * q + 2] = c.z; l2[4 * q + 3] = c.w;
        l3[4 * q] = d.x; l3[4 * q + 1] = d.y; l3[4 * q + 2] = d.z; l3[4 * q + 3] = d.w;
      }
      merge_top16(l0, l1);
      merge_top16(l2, l3);
      merge_top16(l0, l2);
      u32* dst = P_topk + (size_t)(m0 + lt) * 256 + hp * 16;
#pragma unroll
      for (int q = 0; q < 4; ++q) *(uint4*)(dst + 4 * q) = make_uint4(l0[4 * q], l0[4 * q + 1], l0[4 * q + 2], l0[4 * q + 3]);
    }
  }
}

DI void phaseF(const Params& p, char* smem) {
  const int nfull = (132 * 8) / (int)gridDim.x;
  for (int i = 0; i < nfull; ++i) {
    int pm, pn;
    if (!unit_of(i * (int)gridDim.x + (int)blockIdx.x, 132, 8, pm, pn)) break;
    f32x4 acc[2][2][4][2];
    __syncthreads();
    g8::gemm256(P_wq_t, P_h2, pn * 256, pm * 256, smem, acc);
#pragma unroll
    for (int bj = 0; bj < 2; ++bj) {
      __syncthreads();
      {
        const int tid = get_tid(), wid = tid >> 6, lane = tid & 63, wr = wid >> 2, wc = wid & 3, fr = lane & 15, fq = lane >> 4;
#pragma unroll
        for (int ai = 0; ai < 2; ++ai) {
          char* Qs = smem + ai * HB_LDS + 32768;
#pragma unroll
          for (int m = 0; m < 4; ++m)
#pragma unroll
            for (int n = 0; n < 2; ++n)
              *(u32x2*)(Qs + (wc * 32 + n * 16 + fr) * 272 + (wr * 64 + m * 16 + fq * 4) * 2) =
                  u32x2{pack2(acc[ai][bj][m][n][0], acc[ai][bj][m][n][1]), pack2(acc[ai][bj][m][n][2], acc[ai][bj][m][n][3])};
        }
      }
      const int t2 = get_tid(), hbk = t2 >> 8;
      f_epilogue(p, smem + hbk * HB_LDS, pm * 256 + bj * 128, pn * 2 + hbk, t2 & 255);
    }
  }
  for (int q = (int)blockIdx.x;; q += (int)gridDim.x) {
    int pm, pn, ai, bj;
    if (!leftover_quad(q, 132, 8, pm, pn, ai, bj)) break;
    {
      const int t2 = get_tid(), hbk = t2 >> 8, lt = t2 & 255, lane = lt & 63, wave = lt >> 6, wm = wave >> 1, wn = wave & 1, r = lane & 31, h = lane >> 5;
      char* sm = smem + hbk * HB_LDS;
      const int m0 = pm * 256 + ai * 128, n0 = pn * 256 + bj * 128;
      const bool act = hbk == 0;
      {
        f32x16 acc[2][2];
        gemm_tile(P_h2, P_wq_t, m0, n0, sm, acc, hbk);
      kadd(acc, smem, hbk, lt);
        char* Qs = sm + 32768;
        __syncthreads();
#pragma unroll
        for (int mi = 0; mi < 2; ++mi)
#pragma unroll
          for (int ni = 0; ni < 2; ++ni)
#pragma unroll
            for (int i = 0; i < 16; ++i)
              *(u16*)(Qs + (wm * 64 + mi * 32 + crow(i, h)) * 272 + (wn * 64 + ni * 32 + r) * 2) = (u16)f2bf(acc[mi][ni][i]);
      }
      if (act) f_epilogue(p, sm, m0, pn * 2 + bj, lt);
      else { __syncthreads(); __syncthreads(); }
    }
  }
}

__device__ const unsigned char kStairI[64] = {0, 0, 0, 0, 0, 0, 0, 0, 0, 0, 0, 0, 0, 0, 0, 0, 1, 1, 1, 1, 1, 1, 1, 1, 2, 2, 2, 2, 2, 3, 3, 3,
                                              3, 4, 4, 4, 5, 5, 6, 6, 7, 7, 8, 9, 10, 11, 12, 13, 14, 15, 0, 0, 0, 0, 0, 0, 0, 0, 0, 0, 0, 0, 0, 0};
__device__ const unsigned char kStairJ[64] = {0, 1, 2, 3, 4, 5, 6, 7, 8, 9, 10, 11, 12, 13, 14, 15, 0, 1, 2, 3, 4, 5, 6, 7, 0, 1, 2, 3, 4, 0, 1, 2,
                                              3, 0, 1, 2, 0, 1, 0, 1, 0, 1, 0, 0, 0, 0, 0, 0, 0, 0, 0, 0, 0, 0, 0, 0, 0, 0, 0, 0, 0, 0, 0, 0};

DI void phaseG1(const Params& p, char* smem) {
  const int tid = get_tid(), lane = tid & 63, wave = tid >> 6;
  const int gw = wave * gridDim.x + blockIdx.x, nw = gridDim.x * 8;
  char* wb = smem + wave * 5632;
  LAS u32* wtop = (LAS u32*)wb;
  LAS float* wcand = (LAS float*)(wb + 1024);
  LAS u32* we = (LAS u32*)(wb + 3072);
  LAS float* wg = (LAS float*)(wb + 3584);
  LAS float* wc = (LAS float*)(wb + 4096);
  LAS float* wsu = (LAS float*)(wb + 4608);
  LAS float* wsv = (LAS float*)(wb + 5120);
  const int si = kStairI[lane], sj = kStairJ[lane];
  const bool valid = lane < 50;
  u32x4 tkn = *(const u32x4*)(P_topk + (size_t)(gw < T ? gw : 0) * 256 + lane * 4);
  for (int tok = gw; tok < T; tok += nw) {
    *(LAS u32x4*)(wtop + lane * 4) = tkn;
    {
      const int ntok = tok + nw < T ? tok + nw : tok;
      tkn = *(const u32x4*)(P_topk + (size_t)ntok * 256 + lane * 4);
    }
    wave_lds_sync();
    float cand[8];
    u32 eid[8], ckey[8];
#pragma unroll
    for (int hd = 0; hd < 8; ++hd) {
      const u32 ka = wtop[(2 * hd) * 16 + si], kb = wtop[(2 * hd + 1) * 16 + sj];
      cand[hd] = valid ? key_val(ka) + key_val(kb) : -INFINITY;
      eid[hd] = (ka & 127u) * 128u + (kb & 127u);
      u32 ku = __float_as_uint(cand[hd]);
      ku ^= ((u32)((int)ku >> 31)) | 0x80000000u;
      ckey[hd] = (ku & ~63u) | (u32)(63 - lane);
      wcand[hd * 64 + lane] = __uint_as_float(ckey[hd]);
    }
    wave_lds_sync();
    int rank[8];
    float su_r[8], sv_r[8];
#pragma unroll
    for (int hd = 0; hd < 8; ++hd) { rank[hd] = 0; su_r[hd] = 0.f; sv_r[hd] = 0.f; }
#pragma unroll 1
    for (int j4 = 0; j4 < 13; ++j4) {
#pragma unroll
      for (int hd = 0; hd < 8; ++hd) {
        const u32x4 o = *(const LAS u32x4*)(wcand + hd * 64 + j4 * 4);
        const u32 m = ckey[hd];
        rank[hd] += (o[0] > m) ? 1 : 0;
        rank[hd] += (o[1] > m) ? 1 : 0;
        rank[hd] += (o[2] > m) ? 1 : 0;
        rank[hd] += (o[3] > m) ? 1 : 0;
      }
    }
#pragma unroll
    for (int hd = 0; hd < 8; ++hd) {
      const float mine = cand[hd];
      const bool sel = valid && rank[hd] < 16;
      const float mx = __uint_as_float((u32)__builtin_amdgcn_readfirstlane((int)__float_as_uint(mine)));
      const float ex = sel ? __expf(mine - mx) : 0.f;
      const float sm = wave_sum(ex);
      if (sel) {
        const int slot = hd * 16 + rank[hd];
        we[slot] = eid[hd]; wg[slot] = ex / sm;
        su_r[hd] = P_usc[eid[hd]]; sv_r[hd] = P_vsc[eid[hd]];
      }
    }
    wave_lds_sync();
    const int l5 = lane & 31, hv = lane >> 5;
    h16x2 hfp[16];
    {
      const u16* h2p = P_h2 + (size_t)tok * 1024 + 4 * l5;
#pragma unroll
      for (int j = 0; j < 8; ++j) {
        const uint2 w = *(const uint2*)(h2p + 128 * j);
        hfp[2 * j] = h16x2{(_Float16)bf_lo(w.x), (_Float16)bf_hi(w.x)};
        hfp[2 * j + 1] = h16x2{(_Float16)bf_lo(w.y), (_Float16)bf_hi(w.y)};
      }
    }
#pragma unroll 1
    for (int k0 = 0; k0 < 128; k0 += 32) {
      u32 es[16];
#pragma unroll
      for (int q = 0; q < 8; ++q) {
        const u32x4 e = *(const LAS u32x4*)(we + k0 + 4 * q);
        es[2 * q] = hv ? e[1] : e[0]; es[2 * q + 1] = hv ? e[3] : e[2];
      }
      u32x4 ra[16];
      u32x2 rb[16];
#pragma unroll
      for (int i = 0; i < 16; ++i) {
        const unsigned char* rp = P_utab + (size_t)es[i] * 768;
        ra[i] = *(const u32x4*)(rp + 16 * l5);
        rb[i] = *(const u32x2*)(rp + 512 + 8 * l5);
      }
      if (k0 == 0) {
#pragma unroll
        for (int hd = 0; hd < 8; ++hd)
          if (valid && rank[hd] < 16) { wsu[hd * 16 + rank[hd]] = su_r[hd]; wsv[hd * 16 + rank[hd]] = sv_r[hd]; }
      }
      float d[16];
#pragma unroll
      for (int i = 0; i < 16; ++i) {
        const h16x32 f = __builtin_amdgcn_cvt_scalef32_pk32_f16_fp6(u32x6{ra[i][0], ra[i][1], ra[i][2], ra[i][3], rb[i][0], rb[i][1]}, 1.0f);
        float acc0 = 0.f, acc1 = 0.f;
#pragma unroll
        for (int m = 0; m < 16; m += 2) {
          acc0 = __builtin_amdgcn_fdot2(h16x2{f[2 * m], f[2 * m + 1]}, hfp[m], acc0, false);
          acc1 = __builtin_amdgcn_fdot2(h16x2{f[2 * m + 2], f[2 * m + 3]}, hfp[m + 1], acc1, false);
        }
        d[i] = acc0 + acc1;
        if (i < 15) asm volatile("" : "+v"(ra[i + 1]) : "v"(d[i]));
      }
      float e8[8], e4[4], e2[2], e1s;
      {
        const bool up = (l5 & 16) != 0;
#pragma unroll
        for (int i = 0; i < 8; ++i) {
          const float send = up ? d[i] : d[i + 8], keep = up ? d[i + 8] : d[i];
          e8[i] = keep + __shfl_xor(send, 16);
        }
      }
      {
        const bool up = (l5 & 8) != 0;
#pragma unroll
        for (int i = 0; i < 4; ++i) {
          const float send = up ? e8[i] : e8[i + 4], keep = up ? e8[i + 4] : e8[i];
          e4[i] = keep + __shfl_xor(send, 8);
        }
      }
      {
        const bool up = (l5 & 4) != 0;
#pragma unroll
        for (int i = 0; i < 2; ++i) {
          const float send = up ? e4[i] : e4[i + 2], keep = up ? e4[i + 2] : e4[i];
          e2[i] = keep + __shfl_xor(send, 4);
        }
      }
      {
        const bool up = (l5 & 2) != 0;
        const float send = up ? e2[0] : e2[1], keep = up ? e2[1] : e2[0];
        e1s = keep + dpp_xor2(send);
      }
      e1s += dpp_xor1(e1s);
      if ((l5 & 1) == 0) {
        const int k = k0 + 2 * (l5 >> 1) + hv;
        const float a = e1s * wsu[k];
        wc[k] = 0.5f * a * (1.f + erff(a * 0.70710678118654752f)) * wg[k] * wsv[k];
      }
    }
    wave_lds_sync();
    {
      const u32x2 ev = *(const LAS u32x2*)(we + 2 * lane);
      const f32x2 cv = *(const LAS f32x2*)(wc + 2 * lane);
      const h16x2 ch = h16x2{(_Float16)(cv[0] * 1024.f), (_Float16)(cv[1] * 1024.f)};
      const u32 cw = __builtin_bit_cast(u32, ch);
      *(u32x2*)(P_elist + (size_t)tok * 128 + 2 * lane) = u32x2{ev[0] | (cw << 16), ev[1] | (cw & 0xffff0000u)};
    }
    wave_lds_sync();
  }
}

DI void phaseG2(const Params& p, char* smem) {
  const int tid = get_tid(), lane = tid & 63, wave = tid >> 6;
  const int gw = wave * gridDim.x + blockIdx.x, nw = gridDim.x * 8;
  char* wb = smem + wave * 5632;
  LAS u32* we = (LAS u32*)(wb + 3072);

  const int l5 = lane & 31, hv = lane >> 5;
  const int cb = 512 * hv + 4 * l5;
  f32x4 l2g[4], l2b[4];
#pragma unroll
  for (int j = 0; j < 4; ++j) { l2g[j] = *(const f32x4*)(p.ln2_g + cb + 128 * j); l2b[j] = *(const f32x4*)(p.ln2_b + cb + 128 * j); }
  u32x2 eln = *(const u32x2*)(P_elist + (size_t)(gw < T ? gw : 0) * 128 + 2 * lane);
  for (int tok = gw; tok < T; tok += nw) {
    *(LAS u32x2*)(we + 2 * lane) = eln;
    {
      const int ntok = tok + nw < T ? tok + nw : tok;
      eln = *(const u32x2*)(P_elist + (size_t)ntok * 128 + 2 * lane);
    }
    h16x4 yh[4];
    f32x4 g2v[4];
    {
      const _Float16* y1p = P_y1 + (size_t)tok * 1024 + cb;
      const float* g2p = P_mod + mod_row(tok) * 6144 + 5120 + cb;
#pragma unroll
      for (int j = 0; j < 4; ++j) { yh[j] = *(const h16x4*)(y1p + 128 * j); g2v[j] = *(const f32x4*)(g2p + 128 * j); }
    }
    wave_lds_sync();
    h16x2 ffh[16];
#pragma unroll
    for (int i = 0; i < 16; ++i) ffh[i] = h16x2{(_Float16)0.f, (_Float16)0.f};
#pragma unroll 1
    for (int k0 = 0; k0 < 128; k0 += 32) {
      u32 es[16];
#pragma unroll
      for (int q = 0; q < 8; ++q) {
        const u32x4 e = *(const LAS u32x4*)(we + k0 + 4 * q);
        es[2 * q] = hv ? e[1] : e[0]; es[2 * q + 1] = hv ? e[3] : e[2];
      }
      u32x4 ra[16];
      u32x2 rb[16];
#pragma unroll
      for (int i = 0; i < 16; ++i) {
        const unsigned char* rp = P_vtab + (size_t)(es[i] & 0xffffu) * 768;
        ra[i] = *(const u32x4*)(rp + 16 * l5);
        rb[i] = *(const u32x2*)(rp + 512 + 8 * l5);
      }
#pragma unroll
      for (int i = 0; i < 16; ++i) {
        const h16x32 f = __builtin_amdgcn_cvt_scalef32_pk32_f16_fp6(u32x6{ra[i][0], ra[i][1], ra[i][2], ra[i][3], rb[i][0], rb[i][1]}, 1.0f);
        const u32 ewd = es[i];
        const h16x2 ew = __builtin_bit_cast(h16x2, ewd);
        const h16x2 cc = h16x2{ew[1], ew[1]};
#pragma unroll
        for (int m = 0; m < 16; ++m) ffh[m] = h16x2{f[2 * m], f[2 * m + 1]} * cc + ffh[m];
        if (i < 15) asm volatile("" : "+v"(ra[i + 1]) : "v"(ffh[0]), "v"(ffh[7]), "v"(ffh[15]));
      }
    }
    float fs[16];
#pragma unroll
    for (int i = 0; i < 8; ++i) {
      const auto r = __builtin_amdgcn_permlane32_swap(__builtin_bit_cast(u32, ffh[i]), __builtin_bit_cast(u32, ffh[8 + i]), false, false);
      const u32 w0 = r[0], w1 = r[1];
      const h16x2 mine = __builtin_bit_cast(h16x2, w0), oth = __builtin_bit_cast(h16x2, w1);
      fs[2 * i] = ((float)mine[0] + (float)oth[0]) * (1.f / 1024.f);
      fs[2 * i + 1] = ((float)mine[1] + (float)oth[1]) * (1.f / 1024.f);
    }
    float rv[16];
#pragma unroll
    for (int j = 0; j < 4; ++j) {
      const f32x4 y = f32x4{(float)yh[j][0], (float)yh[j][1], (float)yh[j][2], (float)yh[j][3]}, g = g2v[j];
#pragma unroll
      for (int i = 0; i < 4; ++i) rv[4 * j + i] = ALPHA * y[i] + g[i] * fs[4 * j + i];
    }
    float s = 0.f;
#pragma unroll
    for (int i = 0; i < 16; ++i) s += rv[i];
    const float mu = wave_sum(s) * (1.f / 1024.f);
    float q = 0.f;
#pragma unroll
    for (int i = 0; i < 16; ++i) { rv[i] -= mu; q += rv[i] * rv[i]; }
    const float rstd = rsqrtf(wave_sum(q) * (1.f / 1024.f) + LN_EPS);
    const float poison = P_misc[1] != 0.f ? __builtin_nanf("") : 0.f;
    float* outp = (tok < TP ? P_y_prompt + (size_t)tok * 1024 : P_y_sample + (size_t)(tok - TP) * 1024) + cb;
#pragma unroll
    for (int j = 0; j < 4; ++j) {
      const f32x4 g = l2g[j], b = l2b[j];
      f32x4 o;
#pragma unroll
      for (int i = 0; i < 4; ++i) o[i] = rv[4 * j + i] * rstd * g[i] + b[i] + poison;
      *(f32x4*)(outp + 128 * j) = o;
    }
    wave_lds_sync();
  }
}

typedef const __attribute__((address_space(4))) Params* kparams_t;
DI Params fresh_params(kparams_t pp) {
#if defined(__HIP_DEVICE_COMPILE__)
  asm volatile("" : "+s"(pp));
  return *pp;
#else
  return Params{};
#endif
}

__global__ void __launch_bounds__(512, 2) fwd_megakernel(Params p_arg) {
  cg::grid_group grid = cg::this_grid();
  __shared__ __attribute__((aligned(16))) char smem[SMEM_BYTES];
  kparams_t pp = (kparams_t)__builtin_amdgcn_kernarg_segment_ptr();
  if (threadIdx.x == 0) { *(volatile LAS unsigned*)(smem + SMEM_CTRL + 8) = 0u; *(volatile LAS unsigned*)(smem + SMEM_CTRL + 12) = 0u; }
  __syncthreads();
  const XcdBarrier xb = xcd_barrier_post((unsigned*)(fresh_params(pp).ws + OFF_BAR), (volatile LAS unsigned*)(smem + SMEM_CTRL + 8));
  if (p_arg.out == nullptr) grid.sync();
  phaseA(fresh_params(pp), smem);
  xcd_barrier(xb);
  phaseA2(fresh_params(pp));
  xcd_barrier(xb);
  phaseB(fresh_params(pp), smem);
  xcd_barrier(xb);
  phaseC(fresh_params(pp), smem);
  xcd_barrier(xb);
  phaseD(fresh_params(pp), smem);
  xcd_barrier(xb);
  phaseE(fresh_params(pp));
  xcd_barrier(xb);
  phaseF(fresh_params(pp), smem);
  xcd_barrier(xb);
  phaseG1(fresh_params(pp), smem);
  xcd_barrier(xb);
  phaseG2(fresh_params(pp), smem);
}

extern "C" void kernel_launch(void* const* d_in, const int* in_sizes, int n_in, void* d_out, int out_size,
                              void* d_ws, size_t ws_size, hipStream_t stream) {
  static int grid_blocks = 0;
  if (!grid_blocks) {
    int dev = 0, cus = 0, per_cu = 0;
    (void)hipGetDevice(&dev);
    (void)hipDeviceGetAttribute(&cus, hipDeviceAttributeMultiprocessorCount, dev);
    (void)hipOccupancyMaxActiveBlocksPerMultiprocessor(&per_cu, fwd_megakernel, 512, 0);
    if (per_cu > 1) per_cu = 1;
    grid_blocks = cus * per_cu;
    if (ws_size < WS_NEED) fprintf(stderr, "workspace too small: %zu < %zu\n", ws_size, (size_t)WS_NEED);
  }
  Params p{};
  const float* const* in = (const float* const*)d_in;
  p.x_prompt = in[0]; p.x_sample = in[1]; p.cache_k = in[2]; p.cache_v = in[3]; p.cache_conv = in[4]; p.c_prompt = in[5]; p.c_sample = in[6];
  p.w_ada = in[7]; p.b_ada = in[8]; p.w_in = in[9]; p.b_in = in[10]; p.w_dw = in[11]; p.b_dw = in[12]; p.conv_ln_g = in[13]; p.conv_ln_b = in[14];
  p.lam_q1 = in[15]; p.lam_k1 = in[16]; p.lam_q2 = in[17]; p.lam_k2 = in[18]; p.subln_g = in[19]; p.w_out = in[20]; p.b_out = in[21];
  p.ln1_g = in[22]; p.ln1_b = in[23]; p.w_query = in[24]; p.sub_keys = in[25]; p.u_tab = in[26]; p.v_tab = in[27]; p.ln2_g = in[28]; p.ln2_b = in[29];
  p.out = (float*)d_out;
  p.ws = (char*)d_ws;
  char* ws = (char*)d_ws;
  (void)hipMemsetAsync(ws + OFF_MISC + 256, 0, 4096 - 256 + 16384, stream);
  void* args[] = {&p};
  hipError_t e = hipLaunchCooperativeKernel((void*)fwd_megakernel, dim3(grid_blocks), dim3(512), args, 0, stream);
  if (e != hipSuccess) fprintf(stderr, "cooperative launch failed: %s (grid %d)\n", hipGetErrorString(e), grid_blocks);
}
```

```cpp
#include <hip/hip_runtime.h>
#include <hip/hip_cooperative_groups.h>
#include <cstdio>
#include <cstdint>
namespace cg = cooperative_groups;

typedef unsigned short u16;
typedef unsigned int u32;
using bf16x8 = __attribute__((ext_vector_type(8))) short;
using s16x4 = __attribute__((ext_vector_type(4))) short;
using f32x16 = __attribute__((ext_vector_type(16))) float;
using u32x4 = __attribute__((ext_vector_type(4))) unsigned;
using f32x4 = __attribute__((ext_vector_type(4))) float;
using f32x2 = __attribute__((ext_vector_type(2))) float;
using h16x2 = __attribute__((ext_vector_type(2))) _Float16;
using h16x4 = __attribute__((ext_vector_type(4))) _Float16;
using h16x32 = __attribute__((ext_vector_type(32))) _Float16;
using u32x2 = __attribute__((ext_vector_type(2))) unsigned;
using u32x6 = __attribute__((ext_vector_type(6))) unsigned;
using f32x32 = __attribute__((ext_vector_type(32))) float;
typedef __bf16 bf16x2_t __attribute__((ext_vector_type(2)));
#define DI __device__ __forceinline__
#define LAS __attribute__((address_space(3)))
#define GAS __attribute__((address_space(1)))
#define MFMA32(a, b, c) __builtin_amdgcn_mfma_f32_32x32x16_bf16((a), (b), (c), 0, 0, 0)

constexpr int TP = 32768, TS = 1024, T = TP + TS;
constexpr float LN_EPS = 1e-5f;
constexpr float ALPHA = 1.189207115002721f;
constexpr float LAM_INIT = 0.2f;

constexpr size_t OFF_MOD = 0;
constexpr size_t OFF_ROPE = OFF_MOD + 1179648;
constexpr size_t OFF_MISC = OFF_ROPE + 532480;
constexpr size_t OFF_BAR = OFF_MISC + 4096;
constexpr size_t OFF_WIN = OFF_BAR + 16384;
constexpr size_t OFF_WOUT = OFF_WIN + 5242880;
constexpr size_t OFF_WQ = OFF_WOUT + 2097152;
constexpr size_t OFF_SK = OFF_WQ + 4194304;
constexpr size_t OFF_UTAB = OFF_SK + 524288;
constexpr size_t OFF_VTAB = OFF_UTAB + 16777216;
constexpr size_t OFF_USC = OFF_VTAB + 16777216;
constexpr size_t OFF_VSC = OFF_USC + 65536;
constexpr size_t OFF_X = OFF_VSC + 65536;
constexpr size_t OFF_Y = OFF_X + 69206016;
constexpr size_t OFF_Z = OFF_Y + 138412032;
constexpr size_t OFF_H2 = OFF_Z + 138412032;
constexpr size_t WS_NEED = OFF_H2 + 69206016;

constexpr int HB_LDS = 73728;
constexpr int SMEM_BYTES = 2 * HB_LDS + 64;
constexpr int SMEM_CTRL = 2 * HB_LDS;

struct Params {
  const float *x_prompt, *x_sample, *cache_k, *cache_v, *cache_conv, *c_prompt, *c_sample;
  const float *w_ada, *b_ada, *w_in, *b_in, *w_dw, *b_dw, *conv_ln_g, *conv_ln_b;
  const float *lam_q1, *lam_k1, *lam_q2, *lam_k2, *subln_g, *w_out, *b_out, *ln1_g, *ln1_b;
  const float *w_query, *sub_keys, *u_tab, *v_tab, *ln2_g, *ln2_b;
  float* out;
  char* ws;
};
#define P_y_prompt (p.out)
#define P_y_sample (p.out + 33554432)
#define P_k_prompt (p.out + 34603008)
#define P_v_prompt (p.out + 51380224)
#define P_conv_prompt (p.out + 68157440)
#define P_k_sample (p.out + 68403200)
#define P_v_sample (p.out + 68927488)
#define P_conv_sample (p.out + 69451776)
#define P_mod ((float*)(p.ws + OFF_MOD))
#define P_rope ((float2*)(p.ws + OFF_ROPE))
#define P_misc ((float*)(p.ws + OFF_MISC))
#define P_counters ((u32*)(p.ws + OFF_MISC + 256))
#define P_win_t ((u16*)(p.ws + OFF_WIN))
#define P_wout_t ((u16*)(p.ws + OFF_WOUT))
#define P_wq_t ((u16*)(p.ws + OFF_WQ))
#define P_sk ((u16*)(p.ws + OFF_SK))
#define P_utab ((unsigned char*)(p.ws + OFF_UTAB))
#define P_vtab ((unsigned char*)(p.ws + OFF_VTAB))
#define P_usc ((float*)(p.ws + OFF_USC))
#define P_vsc ((float*)(p.ws + OFF_VSC))
#define P_hb ((u16*)(p.ws + OFF_X))
#define P_mix ((u16*)(p.ws + OFF_X))
#define P_ub ((u16*)(p.ws + OFF_Y))
#define P_qb ((u16*)(p.ws + OFF_Y + 34603008))
#define P_kb ((u16*)(p.ws + OFF_Y + 2 * 34603008))
#define P_vb ((u16*)(p.ws + OFF_Y + 3 * 34603008))
#define P_y1 ((_Float16*)(p.ws + OFF_Y))
#define P_r ((u16*)(p.ws + OFF_Z))
#define P_topk ((u32*)(p.ws + OFF_Z))
#define P_elist ((u32*)(p.ws + OFF_Z + 41943040))
#define P_h2 ((u16*)(p.ws + OFF_H2))

DI u32 f2bf(float x) { u32 u = __float_as_uint(x); u += 0x7fffu + ((u >> 16) & 1u); return u >> 16; }
DI u32 pack2(float lo, float hi) { return f2bf(lo) | (f2bf(hi) << 16); }
DI float bf_lo(u32 w) { return __uint_as_float(w << 16); }
DI float bf_hi(u32 w) { return __uint_as_float(w & 0xffff0000u); }
DI int get_tid() { int t = threadIdx.x; asm volatile("" : "+v"(t)); return t; }
DI int crow(int reg, int h) { return (reg & 3) + 8 * (reg >> 2) + 4 * h; }
DI float dpp_xor1(float v) { return __uint_as_float((u32)__builtin_amdgcn_mov_dpp((int)__float_as_uint(v), 0xB1, 0xF, 0xF, true)); }
DI float dpp_xor2(float v) { return __uint_as_float((u32)__builtin_amdgcn_mov_dpp((int)__float_as_uint(v), 0x4E, 0xF, 0xF, true)); }
DI float dpp_ror8(float v) { return __uint_as_float((u32)__builtin_amdgcn_mov_dpp((int)__float_as_uint(v), 0x128, 0xF, 0xF, true)); }
DI float dpp_ror4(float v) { return __uint_as_float((u32)__builtin_amdgcn_mov_dpp((int)__float_as_uint(v), 0x124, 0xF, 0xF, true)); }
DI float xsum32(float x) { const auto r = __builtin_amdgcn_permlane32_swap(__float_as_uint(x), __float_as_uint(x), false, false); return __uint_as_float(r[0]) + __uint_as_float(r[1]); }
DI float xmax32(float x) { const auto r = __builtin_amdgcn_permlane32_swap(__float_as_uint(x), __float_as_uint(x), false, false); return fmaxf(__uint_as_float(r[0]), __uint_as_float(r[1])); }
DI float xsum16(float x) { const auto r = __builtin_amdgcn_permlane16_swap(__float_as_uint(x), __float_as_uint(x), false, false); return __uint_as_float(r[0]) + __uint_as_float(r[1]); }
DI float xmax16(float x) { const auto r = __builtin_amdgcn_permlane16_swap(__float_as_uint(x), __float_as_uint(x), false, false); return fmaxf(__uint_as_float(r[0]), __uint_as_float(r[1])); }
DI float wave_sum(float v) {
  v = xsum32(v);
  v = xsum16(v);
  v += dpp_ror8(v);
  v += dpp_ror4(v);
  v += dpp_xor2(v);
  v += dpp_xor1(v);
  return v;
}
DI float wave_max(float v) {
  v = xmax32(v);
  v = xmax16(v);
  v = fmaxf(v, dpp_ror8(v));
  v = fmaxf(v, dpp_ror4(v));
  v = fmaxf(v, dpp_xor2(v));
  v = fmaxf(v, dpp_xor1(v));
  return v;
}
DI void wave_lds_sync() { asm volatile("s_waitcnt lgkmcnt(0)" ::: "memory"); }
DI uint4 pack8(const float4& a, const float4& b) {
  uint4 r; r.x = pack2(a.x, a.y); r.y = pack2(a.z, a.w); r.z = pack2(b.x, b.y); r.w = pack2(b.z, b.w); return r;
}
DI u32x4 pack8v(const f32x4& a, const f32x4& b) {
  u32x4 r; r[0] = pack2(a[0], a[1]); r[1] = pack2(a[2], a[3]); r[2] = pack2(b[0], b[1]); r[3] = pack2(b[2], b[3]); return r;
}
DI int mod_row(int tok) { return tok < TP ? (tok >> 11) : 16 + ((tok - TP) >> 5); }
DI float dot2bf(u32 a, u32 b, float acc) {
  return __builtin_amdgcn_fdot2_f32_bf16(__builtin_bit_cast(bf16x2_t, a), __builtin_bit_cast(bf16x2_t, b), acc, false);
}


#define XB_TMO      128
#define XB_XCNT(j)  (256  + 64 * (j))
#define XB_XSUB(j)  (1280 + 64 * (j))
#define XB_XGEN(j)  (2304 + 64 * (j))
#define XB_TOP      3328
#define XB_TOPGEN   3392
#define XCD_BAR_WORDS 3456
#define XB_SPIN_CAP (1u << 18)
DI unsigned xb_ld(unsigned* p)              { return __hip_atomic_load(p, __ATOMIC_RELAXED, __HIP_MEMORY_SCOPE_AGENT); }
DI unsigned xb_add(unsigned* p, unsigned v) { return __hip_atomic_fetch_add(p, v, __ATOMIC_RELAXED, __HIP_MEMORY_SCOPE_AGENT); }
DI unsigned xb_xcc_id() { return (unsigned)__builtin_amdgcn_s_getreg((3 << 11) | 20) & 0xFu; }
#define XB_SPIN(cond, bar) do { unsigned _sp = 0; while (cond) { __builtin_amdgcn_s_sleep(1); \
    if ((++_sp & 255u) == 0u) { if (xb_ld(&(bar)[XB_TMO])) break; if (_sp > XB_SPIN_CAP) { atomicAdd(&(bar)[XB_TMO], 1u); break; } } } } while (0)
struct XcdBarrier { unsigned* bar; unsigned x; volatile LAS unsigned* st; };
DI XcdBarrier xcd_barrier_post(unsigned* bar, volatile LAS unsigned* st) {
  XcdBarrier b; b.bar = bar; b.x = xb_xcc_id(); b.st = st;
  if (threadIdx.x == 0) (void)xb_add(&bar[XB_XCNT(b.x)], 1u);
  return b;
}
DI void xcd_barrier_complete(unsigned* bar, unsigned x, unsigned& nloc, unsigned& nx) {
  const unsigned G = gridDim.x * gridDim.y * gridDim.z;
  unsigned sum, cnt, mine, sp = 0u;
  for (;;) {
    sum = 0u; cnt = 0u; mine = 0u;
#pragma unroll
    for (unsigned j = 0; j < 16; ++j) { const unsigned c = xb_ld(&bar[XB_XCNT(j)]); sum += c; cnt += (c > 0u) ? 1u : 0u; mine = (j == x) ? c : mine; }
    if (sum == G) break;
    __builtin_amdgcn_s_sleep(1);
    if ((++sp & 255u) == 0u) { if (xb_ld(&bar[XB_TMO])) break; if (sp > XB_SPIN_CAP) { atomicAdd(&bar[XB_TMO], 1u); break; } }
  }
  nloc = mine > 0u ? mine : 1u; nx = cnt > 0u ? cnt : 1u;
}
DI void xcd_barrier(const XcdBarrier& b) {
  asm volatile("s_waitcnt vmcnt(0)" ::: "memory");
  __syncthreads();
  if (threadIdx.x == 0) {
    unsigned* bar = b.bar;
    __builtin_amdgcn_s_waitcnt(0);
    unsigned nloc = b.st[0], nx = b.st[1];
    if (nloc == 0u) { xcd_barrier_complete(bar, b.x, nloc, nx); b.st[0] = nloc; b.st[1] = nx; }
    const unsigned old = xb_add(&bar[XB_XSUB(b.x)], 1u);
    const unsigned gen = old / nloc;
    if (old + 1u == (gen + 1u) * nloc) {
      __builtin_amdgcn_fence(__ATOMIC_RELEASE, "agent");
      asm volatile("s_waitcnt vmcnt(0)" ::: "memory");
      const unsigned og = xb_add(&bar[XB_TOP], 1u);
      const unsigned tg = og / nx;
      if (og + 1u == (tg + 1u) * nx) xb_add(&bar[XB_TOPGEN], 1u);
      else XB_SPIN(xb_ld(&bar[XB_TOPGEN]) == tg, bar);
      __builtin_amdgcn_fence(__ATOMIC_ACQUIRE, "agent");
      xb_add(&bar[XB_XGEN(b.x)], 1u);
      asm volatile("s_waitcnt vmcnt(0)" ::: "memory");
    } else {
      XB_SPIN(xb_ld(&bar[XB_XGEN(b.x)]) == gen, bar);
      __builtin_amdgcn_fence(__ATOMIC_ACQUIRE, "agent");
      asm volatile("s_waitcnt vmcnt(0)" ::: "memory");
    }
  }
  __syncthreads();
}

DI void prep_mod(const Params& p, int item, char* smem) {
  float* sc = (float*)smem;
  float* red = (float*)(smem + 24576);
  const int tid = (get_tid() & 255), col = tid & 31, kg = tid >> 5;
  const int n0 = item * 32;
  float acc[48];
#pragma unroll
  for (int b = 0; b < 48; ++b) acc[b] = 0.f;
  for (int kc = 0; kc < 1024; kc += 128) {
    f32x4 cv[6];
#pragma unroll
    for (int j2 = 0; j2 < 6; ++j2) {
      const int b = (tid >> 5) + 8 * j2;
      const float* cp = (b < 16) ? p.c_prompt + b * 1024 : p.c_sample + (b - 16) * 1024;
      cv[j2] = *(const f32x4*)(cp + kc + (tid & 31) * 4);
    }
    float wv[16];
#pragma unroll
    for (int i = 0; i < 16; ++i) wv[i] = p.w_ada[(size_t)(kc + kg * 16 + i) * 6144 + n0 + col];
    __syncthreads();
#pragma unroll
    for (int j2 = 0; j2 < 6; ++j2) {
      const int b = (tid >> 5) + 8 * j2;
#pragma unroll
      for (int e = 0; e < 4; ++e) {
        const float c = cv[j2][e];
        sc[((tid & 31) * 4 + e) * 48 + b] = c / (1.f + __expf(-c));
      }
    }
    __syncthreads();
#pragma unroll
    for (int i = 0; i < 16; ++i) {
      const int kk = kg * 16 + i;
      const float w = wv[i];
      const float4* s4 = (const float4*)(sc + kk * 48);
#pragma unroll
      for (int q = 0; q < 12; ++q) {
        const float4 sv = s4[q];
        acc[4 * q + 0] += sv.x * w; acc[4 * q + 1] += sv.y * w; acc[4 * q + 2] += sv.z * w; acc[4 * q + 3] += sv.w * w;
      }
    }
  }
  __syncthreads();
#pragma unroll
  for (int b = 0; b < 48; ++b) red[(kg * 48 + b) * 32 + col] = acc[b];
  __syncthreads();
  for (int i = tid; i < 1536; i += 256) {
    const int b = i >> 5, c = i & 31;
    float sum = 0.f;
#pragma unroll
    for (int g = 0; g < 8; ++g) sum += red[(g * 48 + b) * 32 + c];
    P_mod[b * 6144 + n0 + c] = sum + p.b_ada[n0 + c];
  }
}

DI void prep_transpose(const float* __restrict__ W, int N, u16* __restrict__ Wt, int tile, bool conv_perm, char* smem) {
  float* ts = (float*)smem;
  const int tid = (get_tid() & 255);
  const int nT = N >> 6;
  const int kt = tile / nT, nt = tile - kt * nT;
  __syncthreads();
#pragma unroll
  for (int j = 0; j < 4; ++j) {
    const int kr = (tid >> 4) + 16 * j, c4 = (tid & 15) * 4;
    const float4 v = *(const float4*)(W + (size_t)(kt * 64 + kr) * N + nt * 64 + c4);
    ts[kr * 65 + c4 + 0] = v.x; ts[kr * 65 + c4 + 1] = v.y; ts[kr * 65 + c4 + 2] = v.z; ts[kr * 65 + c4 + 3] = v.w;
  }
  __syncthreads();
  const int n = tid >> 2, k0 = (tid & 3) * 16;
  u32 w[8];
#pragma unroll
  for (int i = 0; i < 8; ++i) w[i] = pack2(ts[(k0 + 2 * i) * 65 + n], ts[(k0 + 2 * i + 1) * 65 + n]);
  int nn = nt * 64 + n;
  if (conv_perm && nn < 1024) { const int c = nn & 511, isb = nn >> 9; nn = (c >> 5) * 64 + isb * 32 + (c & 31); }
  uint4* dst = (uint4*)(Wt + (size_t)nn * 1024 + kt * 64 + k0);
  dst[0] = make_uint4(w[0], w[1], w[2], w[3]);
  dst[1] = make_uint4(w[4], w[5], w[6], w[7]);
}

DI void prep_convert(const float* __restrict__ src, u16* __restrict__ dst, size_t base) {
  const int tid = (get_tid() & 255);
#pragma unroll
  for (int j = 0; j < 4; ++j) {
    const size_t e = base + (size_t)(j * 256 + tid) * 8;
    const float4 a = *(const float4*)(src + e), b = *(const float4*)(src + e + 4);
    *(uint4*)(dst + e) = pack8(a, b);
  }
}


DI void prep_row_fp6(const float* __restrict__ src, unsigned char* __restrict__ dst, float* __restrict__ scl, int row, int lane) {
  const int l5 = lane & 31;
  const float* rp = src + (size_t)row * 1024;
  f32x4 v[8];
#pragma unroll
  for (int j = 0; j < 8; ++j) v[j] = *(const f32x4*)(rp + 128 * j + 4 * l5);
  float am = 0.f;
#pragma unroll
  for (int j = 0; j < 8; ++j) am = fmaxf(am, fmaxf(fmaxf(fabsf(v[j][0]), fabsf(v[j][1])), fmaxf(fabsf(v[j][2]), fabsf(v[j][3]))));
  am = xmax16(am); am = fmaxf(am, dpp_ror8(am)); am = fmaxf(am, dpp_ror4(am)); am = fmaxf(am, dpp_xor2(am)); am = fmaxf(am, dpp_xor1(am));
  const float sc = am > 0.f ? am * (1.f / 7.f) : 1.f;
  const float inv = 1.f / sc;
  f32x16 lo, hi;
#pragma unroll
  for (int m = 0; m < 16; ++m) { lo[m] = v[m >> 1][2 * (m & 1)] * inv; hi[m] = v[m >> 1][2 * (m & 1) + 1] * inv; }
  const u32x6 q = __builtin_amdgcn_cvt_scalef32_2xpk16_fp6_f32(lo, hi, 1.0f);
  unsigned char* rd = dst + (size_t)row * 768;
  *(u32x4*)(rd + 16 * l5) = u32x4{q[0], q[1], q[2], q[3]};
  *(u32x2*)(rd + 512 + 8 * l5) = u32x2{q[4], q[5]};
  if (l5 == 0) scl[row] = sc;
}

DI void prep_rope(const Params& p, int item) {
  const int idx = item * 256 + (get_tid() & 255);
  if (idx >= 2080 * 32) return;
  const int pos = idx >> 5, d = idx & 31;
  double inv = 1.0;
  for (int i = 0; i < d; ++i) inv *= 0.74989420933245582730;
  const double a = (double)pos * inv;
  const double n = rint(a * 0.63661977236758134308);
  const double r = (a - n * 1.57079632673412561417e+00) - n * 6.07710050650619224932e-11;
  const int q = ((int)n) & 3;
  const double r2 = r * r;
  const double sp = r * (1.0 + r2 * (-1.0 / 6 + r2 * (1.0 / 120 + r2 * (-1.0 / 5040 + r2 * (1.0 / 362880 + r2 * (-1.0 / 39916800 + r2 * (1.0 / 6227020800.0)))))));
  const double cp = 1.0 + r2 * (-0.5 + r2 * (1.0 / 24 + r2 * (-1.0 / 720 + r2 * (1.0 / 40320 + r2 * (-1.0 / 3628800 + r2 * (1.0 / 479001600.0 + r2 * (-1.0 / 87178291200.0)))))));
  double s, c;
  if (q == 0) { s = sp; c = cp; } else if (q == 1) { s = cp; c = -sp; } else if (q == 2) { s = -sp; c = -cp; } else { s = -cp; c = sp; }
  P_rope[idx] = make_float2((float)c, (float)s);
}

DI void phaseA(const Params& p, char* smem) {
  const int hbk = get_tid() >> 8;
  char* sm = smem + hbk * HB_LDS;
  const int total = 1894 + 4096;
  int nxt = 0;
  if (get_tid() == 0) nxt = (int)atomicAdd(P_counters + 32, 1u);
  for (;;) {
    __syncthreads();
    if (get_tid() == 0) *(volatile int*)(smem + SMEM_CTRL) = nxt;
    __syncthreads();
    const int pair = *(volatile int*)(smem + SMEM_CTRL);
    if (pair * 2 >= total) break;
    if (get_tid() == 0) nxt = (int)atomicAdd(P_counters + 32, 1u);
    const int item = pair * 2 + hbk;
    if (item < 192) prep_mod(p, item, sm);
    else if (item < 832) prep_transpose(p.w_in, 2560, P_win_t, item - 192, true, sm);
    else if (item < 1088) prep_transpose(p.w_out, 1024, P_wout_t, item - 832, false, sm);
    else if (item < 1600) prep_transpose(p.w_query, 2048, P_wq_t, item - 1088, false, sm);
    else if (item < 1632) prep_convert(p.sub_keys, P_sk, (size_t)(item - 1600) * 8192);
    else if (item < 1892) prep_rope(p, item - 1632);
    else if (item < 1894) {
      const int l = get_tid() & 255;
      if (item == 1892 && l < 64) {
        const float s1 = wave_sum(p.lam_q1[l] * p.lam_k1[l]);
        const float s2 = wave_sum(p.lam_q2[l] * p.lam_k2[l]);
        if (l == 0) P_misc[0] = expf(s1) - expf(s2) + LAM_INIT;
      }
      if (item == 1892 && l >= 64 && l < 128) {
        const float rep[16] = {0.125f, 0.25f, 0.375f, 0.5f, 0.75f, 1.0f, 1.25f, 1.5f, 1.75f, 2.0f, 2.5f, 3.0f, 3.5f, 4.0f, 5.0f, 7.0f};
        f32x16 lo, hi;
#pragma unroll
        for (int q = 0; q < 16; ++q) { lo[q] = (q & 1) ? -rep[q >> 1] : rep[q >> 1]; hi[q] = (q & 1) ? -rep[8 + (q >> 1)] : rep[8 + (q >> 1)]; }
        const u32x6 qq = __builtin_amdgcn_cvt_scalef32_2xpk16_fp6_f32(lo, hi, 1.0f);
        const f32x32 f = __builtin_amdgcn_cvt_scalef32_pk32_f32_fp6(qq, 1.0f);
        bool ok = true;
#pragma unroll
        for (int q = 0; q < 16; ++q) ok = ok && (f[2 * q] == lo[q]) && (f[2 * q + 1] == hi[q]);
        if (l == 64) P_misc[1] = ok ? 0.f : 1.f;
      }
    } else {
      const int it = item - 1894;
      const int tid = get_tid() & 255, lane = tid & 63, wave = tid >> 6;
      if (it < 2048) prep_row_fp6(p.u_tab, P_utab, P_usc, it * 8 + wave * 2 + (lane >> 5), lane);
      else prep_row_fp6(p.v_tab, P_vtab, P_vsc, (it - 2048) * 8 + wave * 2 + (lane >> 5), lane);
    }
  }
}

DI void phaseA2(const Params& p) {
  const int tid = get_tid(), lane = tid & 63;
  const int gw = (tid >> 6) * gridDim.x + blockIdx.x, nw = gridDim.x * 8;
  for (int tok0 = gw; tok0 < T; tok0 += 2 * nw) {
    f32x4 x[2][4];
    int tk[2];
#pragma unroll
    for (int u = 0; u < 2; ++u) {
      const int tok = tok0 + u * nw < T ? tok0 + u * nw : tok0;
      tk[u] = tok;
      const float* xr = tok < TP ? p.x_prompt + (size_t)tok * 1024 : p.x_sample + (size_t)(tok - TP) * 1024;
#pragma unroll
      for (int hf = 0; hf < 2; ++hf) {
        x[u][2 * hf] = *(const f32x4*)(xr + hf * 512 + lane * 8);
        x[u][2 * hf + 1] = *(const f32x4*)(xr + hf * 512 + lane * 8 + 4);
      }
    }
#pragma unroll
    for (int u = 0; u < 2; ++u) {
      const float* mr = P_mod + mod_row(tk[u]) * 6144;
#pragma unroll
      for (int hf = 0; hf < 2; ++hf) {
        const int c = hf * 512 + lane * 8;
        const f32x4 h0 = *(const f32x4*)(mr + c), h1 = *(const f32x4*)(mr + c + 4);
        const f32x4 s0 = *(const f32x4*)(mr + 1024 + c), s1 = *(const f32x4*)(mr + 1024 + c + 4);
        f32x4 a = x[u][2 * hf], b = x[u][2 * hf + 1];
#pragma unroll
        for (int e = 0; e < 4; ++e) { a[e] = a[e] * (1.f + s0[e]) + h0[e]; b[e] = b[e] * (1.f + s1[e]) + h1[e]; }
        *(u32x4*)(P_hb + (size_t)tk[u] * 1024 + c) = pack8v(a, b);
      }
    }
  }
}

namespace g8 {
constexpr int BK = 64, HALF = 128, HTB = HALF * BK * 2, KD = 1024;
DI int lds_byte(int r, int c) { const int st = (r >> 4) * 2 + (c >> 5), rr = r & 15, cc = c & 31, ob = rr * 64 + cc * 2; return st * 1024 + (ob ^ (((ob >> 9) & 1) << 5)); }
DI void stage_rc(int b, int& R, int& C) { const int st = b / 1024, sb = b % 1024, swz = sb ^ (((sb >> 9) & 1) << 5); R = (st >> 1) * 16 + swz / 64; C = (st & 1) * 32 + (swz % 64) / 2; }
DI void gemm256(const u16* __restrict__ A, const u16* __restrict__ Bt, int brow, int bcol, char* shm, f32x4 (&acc)[2][2][4][2]) {
  const int tid = get_tid();
  const int wid = __builtin_amdgcn_readfirstlane(tid >> 6), lane = tid & 63, wr = wid >> 2, wc = wid & 3, fr = lane & 15, fq = lane >> 4;
#define SA(b, h) (shm + ((b) * 2 + (h)) * HTB)
#define SB(b, h) (shm + (4 + (b) * 2 + (h)) * HTB)
#define STAGE(P, BASE, br, kt) do { const u16* _gb = (BASE) + ((size_t)(br) * KD + (size_t)(kt) * BK); \
    __builtin_amdgcn_global_load_lds((const GAS unsigned*)(_gb + toff0), (LAS unsigned*)((P) + tid * 16), 16, 0, 0); \
    __builtin_amdgcn_global_load_lds((const GAS unsigned*)(_gb + 64 * KD + toff0), (LAS unsigned*)((P) + tid * 16 + 8192), 16, 0, 0); } while (0)
#define LDA(dst, b, h) _Pragma("unroll") for (int m = 0; m < 4; ++m) _Pragma("unroll") for (int k = 0; k < 2; ++k) \
    dst[m][k] = *(const bf16x8*)(SA(b, h) + lds_byte(wr * 64 + m * 16 + fr, k * 32 + fq * 8))
#define LDB(dst, b, h) _Pragma("unroll") for (int n = 0; n < 2; ++n) _Pragma("unroll") for (int k = 0; k < 2; ++k) \
    dst[n][k] = *(const bf16x8*)(SB(b, h) + lds_byte(wc * 32 + n * 16 + fr, k * 32 + fq * 8))
#define MMA(ai, bj, At_, Bt_) do { __builtin_amdgcn_s_setprio(1); \
    _Pragma("unroll") for (int m = 0; m < 4; ++m) _Pragma("unroll") for (int n = 0; n < 2; ++n) _Pragma("unroll") for (int k = 0; k < 2; ++k) \
      acc[ai][bj][m][n] = __builtin_amdgcn_mfma_f32_16x16x32_bf16(At_[m][k], Bt_[n][k], acc[ai][bj][m][n], 0, 0, 0); \
    __builtin_amdgcn_s_setprio(0); } while (0)
#define WAIT_V(n) asm volatile("s_waitcnt vmcnt(" #n ")" ::: "memory")
#define WAIT_L(n) asm volatile("s_waitcnt lgkmcnt(" #n ")" ::: "memory")
#define BAR __builtin_amdgcn_s_barrier()
#define SCHED __builtin_amdgcn_sched_barrier(0)
#pragma unroll
  for (int a = 0; a < 2; ++a)
#pragma unroll
    for (int b = 0; b < 2; ++b)
#pragma unroll
      for (int m = 0; m < 4; ++m)
#pragma unroll
        for (int n = 0; n < 2; ++n) acc[a][b][m][n] = f32x4{0.f, 0.f, 0.f, 0.f};
  bf16x8 At[4][2], B0[2][2], B1[2][2];
  constexpr int nt = KD / BK;
  unsigned toff0;
  { int r_, c_; stage_rc(tid * 16, r_, c_); toff0 = (unsigned)(r_ * KD + c_); }
  STAGE(SB(0, 0), Bt, bcol, 0); STAGE(SA(0, 0), A, brow, 0);
  STAGE(SB(0, 1), Bt, bcol + HALF, 0); STAGE(SA(0, 1), A, brow + HALF, 0);
  if (wr == 1) BAR;
  WAIT_V(4); BAR;
  STAGE(SB(1, 0), Bt, bcol, 1); STAGE(SA(1, 0), A, brow, 1); STAGE(SB(1, 1), Bt, bcol + HALF, 1);
  WAIT_V(6); BAR;
#pragma unroll 1
  for (int t = 0; t < nt - 2; t += 2) {
    LDB(B0, 0, 0); SCHED; LDA(At, 0, 0); STAGE(SA(1, 1), A, brow + HALF, t + 1);
    WAIT_L(8); BAR; WAIT_L(0); MMA(0, 0, At, B0); BAR; SCHED;
    LDB(B1, 0, 1); STAGE(SB(0, 0), Bt, bcol, t + 2);
    BAR; WAIT_L(0); MMA(0, 1, At, B1); BAR;
    LDA(At, 0, 1); STAGE(SA(0, 0), A, brow, t + 2);
    BAR; WAIT_L(0); MMA(1, 0, At, B0); BAR; SCHED;
    STAGE(SB(0, 1), Bt, bcol + HALF, t + 2);
    WAIT_V(6); BAR; MMA(1, 1, At, B1); BAR;
    LDB(B0, 1, 0); SCHED; LDA(At, 1, 0); STAGE(SA(0, 1), A, brow + HALF, t + 2);
    WAIT_L(8); BAR; WAIT_L(0); MMA(0, 0, At, B0); BAR; SCHED;
    LDB(B1, 1, 1); STAGE(SB(1, 0), Bt, bcol, t + 3);
    BAR; WAIT_L(0); MMA(0, 1, At, B1); BAR;
    LDA(At, 1, 1); STAGE(SA(1, 0), A, brow, t + 3);
    BAR; WAIT_L(0); MMA(1, 0, At, B0); BAR; SCHED;
    STAGE(SB(1, 1), Bt, bcol + HALF, t + 3);
    WAIT_V(6); BAR; MMA(1, 1, At, B1); BAR;
  }
  { LDB(B0, 0, 0); LDA(At, 0, 0); STAGE(SA(1, 1), A, brow + HALF, nt - 1);
    BAR; WAIT_L(0); MMA(0, 0, At, B0); BAR;
    LDB(B1, 0, 1); BAR; WAIT_L(0); MMA(0, 1, At, B1); BAR;
    LDA(At, 0, 1); WAIT_V(4); BAR; WAIT_L(0); MMA(1, 0, At, B0); MMA(1, 1, At, B1); BAR; }
  { LDB(B0, 1, 0); LDA(At, 1, 0); WAIT_V(2); BAR; WAIT_L(0); MMA(0, 0, At, B0); BAR;
    LDB(B1, 1, 1); WAIT_V(0); BAR; WAIT_L(0); MMA(0, 1, At, B1); BAR;
    LDA(At, 1, 1); BAR; WAIT_L(0); MMA(1, 0, At, B0); MMA(1, 1, At, B1); BAR; }
  if (wr == 0) BAR;
#undef SA
#undef SB
#undef STAGE
#undef LDA
#undef LDB
#undef MMA
#undef WAIT_V
#undef WAIT_L
#undef BAR
#undef SCHED
}
}

DI bool unit_of(int L, int nM, int nN, int& pm, int& pn) {
  const int nwg = nM * nN;
  if (L >= nwg) return false;
  int wgid = L;
  { const int q = nwg / 8, r = nwg % 8, xcd = wgid % 8, off = wgid / 8; wgid = (xcd < r ? xcd * (q + 1) : r * (q + 1) + (xcd - r) * q) + off; }
  const int nig = 8 * nN, gid = wgid / nig, fm = gid * 8, gsz = (nM - fm) < 8 ? (nM - fm) : 8;
  pm = fm + ((wgid % nig) % gsz); pn = (wgid % nig) / gsz;
  return true;
}
DI void quad_to_lds_f32(const f32x4 (&acc)[2][2][4][2], int bj, char* smem) {
  const int tid = get_tid(), wid = tid >> 6, lane = tid & 63, wr = wid >> 2, wc = wid & 3, fr = lane & 15, fq = lane >> 4;
#pragma unroll
  for (int ai = 0; ai < 2; ++ai) {
    float* Ct = (float*)(smem + ai * HB_LDS);
#pragma unroll
    for (int m = 0; m < 4; ++m)
#pragma unroll
      for (int n = 0; n < 2; ++n)
        *(f32x4*)(Ct + (wc * 32 + n * 16 + fr) * 132 + wr * 64 + m * 16 + fq * 4) = acc[ai][bj][m][n];
  }
}

DI void gemm_tile(const u16* __restrict__ A, const u16* __restrict__ Bt, int m0, int n0, char* smem, f32x16 (&acc)[2][2], int khalf) {
  constexpr int KD = 1024, NK = KD / 128;
  const int tid = get_tid() & 255, lane = tid & 63, wave = tid >> 6, wm = wave >> 1, wn = wave & 1;
  const int r = lane & 31, h = lane >> 5;
  char* As = smem;
  char* Bs = smem + 18432;
  const int lrow = tid >> 3, kc = tid & 7;
  const u16* ag = A + (size_t)(m0 + lrow) * KD + kc * 8 + khalf * 512;
  const u16* bg = Bt + (size_t)(n0 + lrow) * KD + kc * 8 + khalf * 512;
  u32x4 ra0[4], rb0[4], ra1[4], rb1[4];
  {
#pragma unroll
    for (int j = 0; j < 4; ++j) {
      ra0[j] = *(const u32x4*)(ag + (size_t)j * 32 * KD);
      rb0[j] = *(const u32x4*)(bg + (size_t)j * 32 * KD);
    }
#pragma unroll
    for (int j = 0; j < 4; ++j) {
      ra1[j] = *(const u32x4*)(ag + (size_t)j * 32 * KD + 64);
      rb1[j] = *(const u32x4*)(bg + (size_t)j * 32 * KD + 64);
    }
  }
#pragma unroll
  for (int mi = 0; mi < 2; ++mi)
#pragma unroll
    for (int ni = 0; ni < 2; ++ni)
#pragma unroll
      for (int i = 0; i < 16; ++i) acc[mi][ni][i] = 0.f;
  const char* ap = As + (wm * 64 + r) * 144 + h * 16;
  const char* bp = Bs + (wn * 64 + r) * 144 + h * 16;
  char* aw = As + lrow * 144 + kc * 16;
  char* bw = Bs + lrow * 144 + kc * 16;
#define GEMM_STEP(RA, RB, KT)                                                                   \
  {                                                                                             \
    __syncthreads();                                                                            \
    _Pragma("unroll") for (int j = 0; j < 4; ++j) {  \
      *(u32x4*)(aw + j * 32 * 144) = RA[j];                                                     \
      *(u32x4*)(bw + j * 32 * 144) = RB[j];                                                     \
    }                                                                                           \
    __syncthreads();                                                                            \
    if ((KT) + 2 < NK) {                                                                        \
      _Pragma("unroll") for (int j = 0; j < 4; ++j) {                                           \
        RA[j] = *(const u32x4*)(ag + (size_t)j * 32 * KD + ((KT) + 2) * 64);                    \
        RB[j] = *(const u32x4*)(bg + (size_t)j * 32 * KD + ((KT) + 2) * 64);                    \
      }                                                                                         \
    }                                                                                           \
    __builtin_amdgcn_sched_barrier(0);                                                          \
    _Pragma("unroll") for (int ks = 0; ks < 4; ++ks) {                                          \
      const bf16x8 a0 = *(const bf16x8*)(ap + ks * 32), a1 = *(const bf16x8*)(ap + 32 * 144 + ks * 32); \
      const bf16x8 b0 = *(const bf16x8*)(bp + ks * 32), b1 = *(const bf16x8*)(bp + 32 * 144 + ks * 32); \
      acc[0][0] = MFMA32(a0, b0, acc[0][0]);                                                    \
      acc[0][1] = MFMA32(a0, b1, acc[0][1]);                                                    \
      acc[1][0] = MFMA32(a1, b0, acc[1][0]);                                                    \
      acc[1][1] = MFMA32(a1, b1, acc[1][1]);                                                    \
    }                                                                                           \
  }
#pragma unroll 1
  for (int kt = 0; kt < NK; kt += 2) {
    GEMM_STEP(ra0, rb0, kt)
    GEMM_STEP(ra1, rb1, kt + 1)
  }
#undef GEMM_STEP
}


DI void kadd(f32x16 (&acc)[2][2], char* smem, int hbk, int lt) {
  float* Pf = (float*)(smem + HB_LDS);
  const int lane = lt & 63, wave = lt >> 6;
  __syncthreads();
  if (hbk == 1) {
#pragma unroll
    for (int mi = 0; mi < 2; ++mi)
#pragma unroll
      for (int ni = 0; ni < 2; ++ni)
#pragma unroll
        for (int i = 0; i < 16; ++i) Pf[(wave * 64 + (mi * 2 + ni) * 16 + i) * 64 + lane] = acc[mi][ni][i];
  }
  __syncthreads();
  if (hbk == 0) {
#pragma unroll
    for (int mi = 0; mi < 2; ++mi)
#pragma unroll
      for (int ni = 0; ni < 2; ++ni)
#pragma unroll
        for (int i = 0; i < 16; ++i) acc[mi][ni][i] += Pf[(wave * 64 + (mi * 2 + ni) * 16 + i) * 64 + lane];
  }
}

DI bool leftover_quad(int q, int nM, int nN, int& pm, int& pn, int& ai, int& bj) {
  const int G = (int)gridDim.x, nwg = nM * nN, nfull = nwg / G, nl = nwg - nfull * G;
  if (q >= 4 * nl) return false;
  ai = (q >> 1) & 1; bj = q & 1;
  return unit_of(nfull * G + (q >> 2), nM, nN, pm, pn);
}

DI void b_rowpass(const Params& p, const float* Ct, int m0, int n0, int lt) {
#pragma unroll 2
    for (int it = 0; it < 4; ++it) {
      const int idx = it * 256 + lt;
      const int j = idx & 3, g = (idx >> 2) & 1, row = idx >> 3;
      const int grow = m0 + row;
      const float* cp = Ct + row * 132 + g * 64 + 8 * j;
      f32x4 x1a = *(const f32x4*)cp, x1b = *(const f32x4*)(cp + 4), x2a = *(const f32x4*)(cp + 32), x2b = *(const f32x4*)(cp + 36);
      const int vc = n0 + g * 64 + 8 * j;
      if (n0 < 1024) {
        const int ca = (vc >> 6) * 32 + 8 * j;
        const f32x4 ba0 = *(const f32x4*)(p.b_in + ca), ba1 = *(const f32x4*)(p.b_in + ca + 4);
        const f32x4 bb0 = *(const f32x4*)(p.b_in + 512 + ca), bb1 = *(const f32x4*)(p.b_in + 512 + ca + 4);
        f32x4 u0, u1;
#pragma unroll
        for (int e = 0; e < 4; ++e) {
          u0[e] = (x1a[e] + ba0[e]) / (1.f + __expf(-(x2a[e] + bb0[e])));
          u1[e] = (x1b[e] + ba1[e]) / (1.f + __expf(-(x2b[e] + bb1[e])));
        }
        *(u32x4*)(P_ub + (size_t)grow * 512 + ca) = pack8v(u0, u1);
        float* cs = nullptr;
        if (grow < TP) { const int s = grow & 2047; if (s >= 2018) cs = P_conv_prompt + ((size_t)(grow >> 11) * 30 + (s - 2018)) * 512 + ca; }
        else { const int rs = grow - TP, s = rs & 31; if (s >= 2) cs = P_conv_sample + ((size_t)(rs >> 5) * 30 + (s - 2)) * 512 + ca; }
        if (cs) { *(f32x4*)cs = u0; *(f32x4*)(cs + 4) = u1; }
      } else {
        const f32x4 b1a = *(const f32x4*)(p.b_in + vc), b1b = *(const f32x4*)(p.b_in + vc + 4);
        const f32x4 b2a = *(const f32x4*)(p.b_in + vc + 32), b2b = *(const f32x4*)(p.b_in + vc + 36);
#pragma unroll
        for (int e = 0; e < 4; ++e) { x1a[e] += b1a[e]; x1b[e] += b1b[e]; x2a[e] += b2a[e]; x2b[e] += b2b[e]; }
        if (n0 < 2048) {
          const int pos = grow < TP ? (grow & 2047) : 2048 + ((grow - TP) & 31);
          const f32x4* rp = (const f32x4*)(P_rope + pos * 32 + 8 * j);
          const f32x4 r0 = rp[0], r1 = rp[1], r2 = rp[2], r3 = rp[3];
          f32x4 o1a, o1b, o2a, o2b;
          o1a[0] = x1a[0] * r0[0] - x2a[0] * r0[1]; o2a[0] = x2a[0] * r0[0] + x1a[0] * r0[1];
          o1a[1] = x1a[1] * r0[2] - x2a[1] * r0[3]; o2a[1] = x2a[1] * r0[2] + x1a[1] * r0[3];
          o1a[2] = x1a[2] * r1[0] - x2a[2] * r1[1]; o2a[2] = x2a[2] * r1[0] + x1a[2] * r1[1];
          o1a[3] = x1a[3] * r1[2] - x2a[3] * r1[3]; o2a[3] = x2a[3] * r1[2] + x1a[3] * r1[3];
          o1b[0] = x1b[0] * r2[0] - x2b[0] * r2[1]; o2b[0] = x2b[0] * r2[0] + x1b[0] * r2[1];
          o1b[1] = x1b[1] * r2[2] - x2b[1] * r2[3]; o2b[1] = x2b[1] * r2[2] + x1b[1] * r2[3];
          o1b[2] = x1b[2] * r3[0] - x2b[2] * r3[1]; o2b[2] = x2b[2] * r3[0] + x1b[2] * r3[1];
          o1b[3] = x1b[3] * r3[2] - x2b[3] * r3[3]; o2b[3] = x2b[3] * r3[2] + x1b[3] * r3[3];
          x1a = o1a; x1b = o1b; x2a = o2a; x2b = o2b;
        }
        const bool isq = n0 < 1536, isk = !isq && n0 < 2048;
        const int col = vc - (isq ? 1024 : (isk ? 1536 : 2048));
        u16* db = (isq ? P_qb : (isk ? P_kb : P_vb)) + (size_t)grow * 512 + col;
        *(u32x4*)db = pack8v(x1a, x1b);
        *(u32x4*)(db + 32) = pack8v(x2a, x2b);
        if (!isq) {
          float* fo = (isk ? (grow < TP ? P_k_prompt + (size_t)grow * 512 : P_k_sample + (size_t)(grow - TP) * 512)
                           : (grow < TP ? P_v_prompt + (size_t)grow * 512 : P_v_sample + (size_t)(grow - TP) * 512)) + col;
          *(f32x4*)fo = x1a; *(f32x4*)(fo + 4) = x1b; *(f32x4*)(fo + 32) = x2a; *(f32x4*)(fo + 36) = x2b;
        }
      }
    }
}

DI void phaseB(const Params& p, char* smem) {
  const int nfull = (132 * 10) / (int)gridDim.x;
  for (int i = 0; i < nfull; ++i) {
    int pm, pn;
    if (!unit_of(i * (int)gridDim.x + (int)blockIdx.x, 132, 10, pm, pn)) break;
    f32x4 acc[2][2][4][2];
    __syncthreads();
    g8::gemm256(P_win_t, P_hb, pn * 256, pm * 256, smem, acc);
#pragma unroll
    for (int bj = 0; bj < 2; ++bj) {
      __syncthreads();
      quad_to_lds_f32(acc, bj, smem);
      __syncthreads();
      const int t2 = get_tid(), hbk = t2 >> 8;
      b_rowpass(p, (const float*)(smem + hbk * HB_LDS), pm * 256 + bj * 128, pn * 256 + hbk * 128, t2 & 255);
    }
  }
  for (int q = (int)blockIdx.x;; q += (int)gridDim.x) {
    int pm, pn, ai, bj;
    if (!leftover_quad(q, 132, 10, pm, pn, ai, bj)) break;
    {
      const int t2 = get_tid(), hbk = t2 >> 8, lt = t2 & 255, lane = lt & 63, wave = lt >> 6, wm = wave >> 1, wn = wave & 1, r = lane & 31, h = lane >> 5;
      char* sm = smem + hbk * HB_LDS;
      const int m0 = pm * 256 + ai * 128, n0 = pn * 256 + bj * 128;
      const bool act = hbk == 0;
      f32x16 acc[2][2];
      gemm_tile(P_hb, P_win_t, m0, n0, sm, acc, hbk);
      kadd(acc, smem, hbk, lt);
      __syncthreads();
      float* Ct = (float*)sm;
#pragma unroll
      for (int mi = 0; mi < 2; ++mi)
#pragma unroll
        for (int ni = 0; ni < 2; ++ni)
#pragma unroll
          for (int i = 0; i < 16; ++i) Ct[(wm * 64 + mi * 32 + crow(i, h)) * 132 + wn * 64 + ni * 32 + r] = acc[mi][ni][i];
      __syncthreads();
      if (act) b_rowpass(p, Ct, m0, n0, lt);
    }
  }
}

DI bf16x8 pack_frag(const f32x16& x, int s) {
  u32x4 o;
  if (s == 0)
    asm volatile("v_cvt_pk_bf16_f32 %0, %4, %5\n\tv_cvt_pk_bf16_f32 %1, %6, %7\n\tv_cvt_pk_bf16_f32 %2, %8, %9\n\tv_cvt_pk_bf16_f32 %3, %10, %11\n\ts_nop 1"
                 : "=&v"(o[0]), "=&v"(o[1]), "=&v"(o[2]), "=&v"(o[3])
                 : "v"(x[0]), "v"(x[1]), "v"(x[2]), "v"(x[3]), "v"(x[4]), "v"(x[5]), "v"(x[6]), "v"(x[7]));
  else
    asm volatile("v_cvt_pk_bf16_f32 %0, %4, %5\n\tv_cvt_pk_bf16_f32 %1, %6, %7\n\tv_cvt_pk_bf16_f32 %2, %8, %9\n\tv_cvt_pk_bf16_f32 %3, %10, %11\n\ts_nop 1"
                 : "=&v"(o[0]), "=&v"(o[1]), "=&v"(o[2]), "=&v"(o[3])
                 : "v"(x[8]), "v"(x[9]), "v"(x[10]), "v"(x[11]), "v"(x[12]), "v"(x[13]), "v"(x[14]), "v"(x[15]));
  return __builtin_bit_cast(bf16x8, o);
}

DI void attn_tile_compute(char* smem, int pm, const bf16x8 (&qf)[4], f32x16 (&O)[4], float& m_run, float& l_run, bool mask_hi, int lane) {
  const int r = lane & 31, h = lane >> 5;
  const char* Kp = smem + pm * 9216 + r * 144 + h * 16;
  f32x16 s0, s1;
#pragma unroll
  for (int i = 0; i < 16; ++i) { s0[i] = 0.f; s1[i] = 0.f; }
#pragma unroll
  for (int ks = 0; ks < 4; ++ks) {
    const bf16x8 k0 = *(const bf16x8*)(Kp + ks * 32), k1 = *(const bf16x8*)(Kp + 32 * 144 + ks * 32);
    s0 = MFMA32(k0, qf[ks], s0);
    s1 = MFMA32(k1, qf[ks], s1);
  }
  if (mask_hi) {
#pragma unroll
    for (int i = 0; i < 16; ++i) s1[i] = -INFINITY;
  }
  float mx = s0[0];
#pragma unroll
  for (int i = 1; i < 16; ++i) mx = fmaxf(mx, s0[i]);
#pragma unroll
  for (int i = 0; i < 16; ++i) mx = fmaxf(mx, s1[i]);
  mx = xmax32(mx);
  const float m_new = fmaxf(m_run, mx);
  const float c = 0.125f * 1.4426950408889634f;
  const float alpha = __builtin_amdgcn_exp2f((m_run - m_new) * c);
  const float mc = m_new * c;
  float rs = 0.f;
#pragma unroll
  for (int i = 0; i < 16; ++i) { s0[i] = __builtin_amdgcn_exp2f(s0[i] * c - mc); rs += s0[i]; }
#pragma unroll
  for (int i = 0; i < 16; ++i) { s1[i] = __builtin_amdgcn_exp2f(s1[i] * c - mc); rs += s1[i]; }
  rs = xsum32(rs);
  l_run = l_run * alpha + rs;
  if (__builtin_amdgcn_ballot_w64(m_new != m_run) != 0ull) {
#pragma unroll
    for (int d = 0; d < 4; ++d)
#pragma unroll
      for (int i = 0; i < 16; ++i) O[d][i] *= alpha;
  }
  m_run = m_new;
  bf16x8 pf[4];
  pf[0] = pack_frag(s0, 0); pf[1] = pack_frag(s0, 1); pf[2] = pack_frag(s1, 0); pf[3] = pack_frag(s1, 1);
  const int q4 = (lane & 15) >> 2, p4 = lane & 3, blk = (lane >> 4) & 1;
  const unsigned vbase = (unsigned)(size_t)(smem + 18432) + (4 * h + q4) * 320 + (16 * blk + 4 * p4) * 2;
  s16x4 va[8], vb[8];
#define TR_ISSUE(R, ADDR)                                                                                        \
  asm volatile("ds_read_b64_tr_b16 %0, %8\n\tds_read_b64_tr_b16 %1, %8 offset:2560\n\t"                          \
               "ds_read_b64_tr_b16 %2, %8 offset:64\n\tds_read_b64_tr_b16 %3, %8 offset:2624\n\t"                 \
               "ds_read_b64_tr_b16 %4, %8 offset:128\n\tds_read_b64_tr_b16 %5, %8 offset:2688\n\t"                \
               "ds_read_b64_tr_b16 %6, %8 offset:192\n\tds_read_b64_tr_b16 %7, %8 offset:2752"                    \
               : "=&v"(R[0]), "=&v"(R[1]), "=&v"(R[2]), "=&v"(R[3]), "=&v"(R[4]), "=&v"(R[5]), "=&v"(R[6]), "=&v"(R[7]) \
               : "v"(ADDR) : "memory")
#define TR_WAIT(R, N)                                                                                            \
  asm volatile("s_waitcnt lgkmcnt(" #N ")"                                                                       \
               : "+v"(R[0]), "+v"(R[1]), "+v"(R[2]), "+v"(R[3]), "+v"(R[4]), "+v"(R[5]), "+v"(R[6]), "+v"(R[7]) :: "memory")
#define PV_MFMA(R, KK)                                                                                           \
  O[0] = MFMA32(__builtin_shufflevector(R[0], R[1], 0, 1, 2, 3, 4, 5, 6, 7), pf[KK], O[0]);                      \
  O[1] = MFMA32(__builtin_shufflevector(R[2], R[3], 0, 1, 2, 3, 4, 5, 6, 7), pf[KK], O[1]);                      \
  O[2] = MFMA32(__builtin_shufflevector(R[4], R[5], 0, 1, 2, 3, 4, 5, 6, 7), pf[KK], O[2]);                      \
  O[3] = MFMA32(__builtin_shufflevector(R[6], R[7], 0, 1, 2, 3, 4, 5, 6, 7), pf[KK], O[3]);
  TR_ISSUE(va, vbase);
  TR_ISSUE(vb, vbase + 16 * 320);
  TR_WAIT(va, 8);
  PV_MFMA(va, 0)
  TR_ISSUE(va, vbase + 32 * 320);
  TR_WAIT(vb, 8);
  PV_MFMA(vb, 1)
  TR_ISSUE(vb, vbase + 48 * 320);
  TR_WAIT(va, 8);
  PV_MFMA(va, 2)
  TR_WAIT(vb, 0);
  PV_MFMA(vb, 3)
#undef TR_ISSUE
#undef TR_WAIT
#undef PV_MFMA
}

DI void attn_epilogue(const Params& p, char* smem, int qg, int pm, bool active, f32x16 (&O)[4], float l_run, size_t tok, int hh, int lane) {
  const int r = lane & 31, h = lane >> 5;
  __syncthreads();
  const float inv_l = 1.f / l_run;
  float* X = (float*)smem + qg * 4096;
  if (active && pm == 1) {
#pragma unroll
    for (int d = 0; d < 4; ++d)
#pragma unroll
      for (int i = 0; i < 16; ++i) X[(d * 32 + crow(i, h)) * 32 + r] = O[d][i] * inv_l;
  }
  __syncthreads();
  if (active && pm == 0) {
    const float lam = P_misc[0];
    float ssq = 0.f;
#pragma unroll
    for (int d = 0; d < 4; ++d)
#pragma unroll
      for (int i = 0; i < 16; ++i) {
        const float o = O[d][i] * inv_l - lam * X[(d * 32 + crow(i, h)) * 32 + r];
        O[d][i] = o; ssq += o * o;
      }
    ssq = xsum32(ssq);
    const float rms = rsqrtf(ssq * (1.f / 128.f) + LN_EPS) * (1.f - LAM_INIT);
    u16* dst = P_mix + tok * 1024 + 512 + hh * 128;
#pragma unroll
    for (int d = 0; d < 4; ++d)
#pragma unroll
      for (int g = 0; g < 4; ++g) {
        const int dv = d * 32 + 8 * g + 4 * h;
        const float4 sg = *(const float4*)(p.subln_g + dv);
        uint2 w;
        w.x = pack2(O[d][4 * g + 0] * rms * sg.x, O[d][4 * g + 1] * rms * sg.y);
        w.y = pack2(O[d][4 * g + 2] * rms * sg.z, O[d][4 * g + 3] * rms * sg.w);
        *(uint2*)(dst + dv) = w;
      }
  }
}

DI void attn_prompt_item(const Params& p, int b, int hh, int qp, char* smem) {
  const int tid = get_tid(), lane = tid & 63, wave = tid >> 6, qg = wave >> 1, pm = wave & 1;
  const int r = lane & 31, h = lane >> 5;
  const size_t tok0 = (size_t)b * 2048;
  const size_t tq = tok0 + qp * 128 + qg * 32 + r;
  bf16x8 qf[4];
  {
    const u16* qptr = P_qb + tq * 512 + (hh * 2 + pm) * 64 + h * 8;
#pragma unroll
    for (int ks = 0; ks < 4; ++ks) qf[ks] = *(const bf16x8*)(qptr + ks * 16);
  }
  f32x16 O[4];
#pragma unroll
  for (int d = 0; d < 4; ++d)
#pragma unroll
    for (int i = 0; i < 16; ++i) O[d][i] = 0.f;
  float m_run = -INFINITY, l_run = 0.f;
  const int my_last = qp * 2 + (qg >> 1), nkt = qp * 2 + 2;
  const int lrow = tid >> 5, cc = tid & 31;
  const u16* gsrc;
  int lds_off, lstride;
  if (cc < 16) { gsrc = P_kb + (tok0 + lrow) * 512 + hh * 128 + cc * 8; lds_off = (cc >> 3) * 9216 + lrow * 144 + (cc & 7) * 16; lstride = 144; }
  else { gsrc = P_vb + (tok0 + lrow) * 512 + hh * 128 + (cc - 16) * 8; lds_off = 18432 + lrow * 320 + (cc - 16) * 16; lstride = 320; }
  u32x4 rg[4];
#pragma unroll
  for (int j = 0; j < 4; ++j) rg[j] = *(const u32x4*)(gsrc + (size_t)(16 * j) * 512);
  const u16* gnext = gsrc + (size_t)64 * 512;
  const int my_last_s = __builtin_amdgcn_readfirstlane(my_last);
  for (int kt = 0; kt < nkt; ++kt) {
    __syncthreads();
#pragma unroll
    for (int j = 0; j < 4; ++j) *(u32x4*)(smem + lds_off + 16 * j * lstride) = rg[j];
    __syncthreads();
    if (kt + 1 < nkt) {
#pragma unroll
      for (int j = 0; j < 4; ++j) rg[j] = *(const u32x4*)(gnext + (size_t)(16 * j) * 512);
      gnext += (size_t)64 * 512;
    }
    __builtin_amdgcn_sched_barrier(0);
    if (kt <= my_last_s) attn_tile_compute(smem, pm, qf, O, m_run, l_run, false, lane);
  }
  attn_epilogue(p, smem, qg, pm, true, O, l_run, tq, hh, lane);
}

DI void attn_sample_item(const Params& p, int b, int hh, char* smem) {
  const int tid = get_tid(), lane = tid & 63, wave = tid >> 6, qg = wave >> 1, pm = wave & 1;
  const int r = lane & 31, h = lane >> 5;
  const bool active = (qg == 0);
  const size_t tokq0 = (size_t)TP + (size_t)b * 32;
  const size_t tq = tokq0 + r;
  bf16x8 qf[4];
  {
    const u16* qptr = P_qb + tq * 512 + (hh * 2 + pm) * 64 + h * 8;
#pragma unroll
    for (int ks = 0; ks < 4; ++ks) qf[ks] = *(const bf16x8*)(qptr + ks * 16);
  }
  f32x16 O[4];
#pragma unroll
  for (int d = 0; d < 4; ++d)
#pragma unroll
    for (int i = 0; i < 16; ++i) O[d][i] = 0.f;
  float m_run = -INFINITY, l_run = 0.f;
  const int lrow = tid >> 5, cc = tid & 31;
  const float* fsrc;
  const u16* bsrc;
  int lds_off, lstride;
  if (cc < 16) {
    fsrc = p.cache_k + ((size_t)b * 2048 + lrow) * 512 + hh * 128 + cc * 8;
    bsrc = P_kb + (tokq0 + lrow) * 512 + hh * 128 + cc * 8;
    lds_off = (cc >> 3) * 9216 + lrow * 144 + (cc & 7) * 16; lstride = 144;
  } else {
    fsrc = p.cache_v + ((size_t)b * 2048 + lrow) * 512 + hh * 128 + (cc - 16) * 8;
    bsrc = P_vb + (tokq0 + lrow) * 512 + hh * 128 + (cc - 16) * 8;
    lds_off = 18432 + lrow * 320 + (cc - 16) * 16; lstride = 320;
  }
  f32x4 rf[8];
#pragma unroll
  for (int j = 0; j < 4; ++j) {
    rf[2 * j] = *(const f32x4*)(fsrc + (size_t)(16 * j) * 512);
    rf[2 * j + 1] = *(const f32x4*)(fsrc + (size_t)(16 * j) * 512 + 4);
  }
  for (int kt = 0; kt <= 32; ++kt) {
    __syncthreads();
    if (kt < 32) {
#pragma unroll
      for (int j = 0; j < 4; ++j) *(u32x4*)(smem + lds_off + 16 * j * lstride) = pack8v(rf[2 * j], rf[2 * j + 1]);
    } else {
#pragma unroll
      for (int j = 0; j < 4; ++j) {
        u32x4 v = {0u, 0u, 0u, 0u};
        if (j < 2) v = *(const u32x4*)(bsrc + (size_t)(16 * j) * 512);
        *(u32x4*)(smem + lds_off + 16 * j * lstride) = v;
      }
    }
    __syncthreads();
    if (kt + 1 < 32) {
#pragma unroll
      for (int j = 0; j < 4; ++j) {
        rf[2 * j] = *(const f32x4*)(fsrc + (size_t)((kt + 1) * 64 + 16 * j) * 512);
        rf[2 * j + 1] = *(const f32x4*)(fsrc + (size_t)((kt + 1) * 64 + 16 * j) * 512 + 4);
      }
    }
    __builtin_amdgcn_sched_barrier(0);
    if (active) attn_tile_compute(smem, pm, qf, O, m_run, l_run, kt == 32, lane);
  }
  attn_epilogue(p, smem, qg, pm, active, O, l_run, tq, hh, lane);
}

DI void conv_item(const Params& p, int ci, char* smem) {
  const int tid = get_tid(), lane = tid & 63, wave = tid >> 6;
  const bool sample = ci >= 1024;
  const int b = sample ? ci - 1024 : ci >> 6;
  const int s0 = sample ? 0 : (ci & 63) * 32;
  const size_t tokbase = sample ? (size_t)TP + (size_t)b * 32 : (size_t)b * 2048;
  const float* hist = p.cache_conv + (size_t)b * 30 * 512;
  float* U = (float*)smem;
  float cw[31];
#pragma unroll
  for (int j = 0; j < 31; ++j) cw[j] = p.w_dw[j * 512 + tid];
  const float cbias = p.b_dw[tid];
  {
    u32x4 st[8];
#pragma unroll
    for (int it = 0; it < 8; ++it) {
      const int c = it * 512 + tid;
      const int rr = c >> 6, ch = c & 63;
      const int s = s0 - 30 + rr;
      u32x4 v = {0u, 0u, 0u, 0u};
      if (c < 62 * 64) {
        if (s >= 0) v = *(const u32x4*)(P_ub + (tokbase + s) * 512 + ch * 8);
        else if (sample) {
          const float* hp = hist + (30 + s) * 512 + ch * 8;
          v = pack8v(*(const f32x4*)hp, *(const f32x4*)(hp + 4));
        }
      }
      st[it] = v;
    }
    __syncthreads();
#pragma unroll
    for (int it = 0; it < 8; ++it) {
      const int c = it * 512 + tid;
      if (c < 62 * 64) {
        float* d = U + (c >> 6) * 512 + (c & 63) * 8;
        *(f32x4*)d = f32x4{bf_lo(st[it][0]), bf_hi(st[it][0]), bf_lo(st[it][1]), bf_hi(st[it][1])};
        *(f32x4*)(d + 4) = f32x4{bf_lo(st[it][2]), bf_hi(st[it][2]), bf_lo(st[it][3]), bf_hi(st[it][3])};
      }
    }
  }
  __syncthreads();
  {
    float cacc[32];
#pragma unroll
    for (int i = 0; i < 32; ++i) cacc[i] = cbias;
#pragma unroll
    for (int r = 0; r < 62; ++r) {
      const float u = U[r * 512 + tid];
#pragma unroll
      for (int i = 0; i < 32; ++i)
        if (r - i >= 0 && r - i <= 30) cacc[i] += cw[r - i] * u;
    }
    __syncthreads();
#pragma unroll
    for (int i = 0; i < 32; ++i) U[i * 512 + tid] = cacc[i];
  }
  __syncthreads();
  const int c0 = lane * 8;
  float acc[4][8];
#pragma unroll
  for (int i = 0; i < 4; ++i) {
    const float* yp = U + (wave * 4 + i) * 512 + c0;
    const f32x4 a0 = *(const f32x4*)yp, a1 = *(const f32x4*)(yp + 4);
#pragma unroll
    for (int e = 0; e < 4; ++e) { acc[i][e] = a0[e]; acc[i][4 + e] = a1[e]; }
  }
  float gg[8], gb[8];
  {
    const f32x4 g0 = *(const f32x4*)(p.conv_ln_g + c0), g1 = *(const f32x4*)(p.conv_ln_g + c0 + 4);
    const f32x4 e0 = *(const f32x4*)(p.conv_ln_b + c0), e1 = *(const f32x4*)(p.conv_ln_b + c0 + 4);
#pragma unroll
    for (int e = 0; e < 4; ++e) { gg[e] = g0[e]; gg[4 + e] = g1[e]; gb[e] = e0[e]; gb[4 + e] = e1[e]; }
  }
#pragma unroll
  for (int i = 0; i < 4; ++i) {
    float s = 0.f;
#pragma unroll
    for (int c = 0; c < 8; ++c) s += acc[i][c];
    const float mu = wave_sum(s) * (1.f / 512.f);
    float v = 0.f;
#pragma unroll
    for (int c = 0; c < 8; ++c) { acc[i][c] -= mu; v += acc[i][c] * acc[i][c]; }
    const float rstd = rsqrtf(wave_sum(v) * (1.f / 512.f) + LN_EPS);
    float y[8];
#pragma unroll
    for (int c = 0; c < 8; ++c) {
      const float t = acc[i][c] * rstd * gg[c] + gb[c];
      y[c] = t / (1.f + __expf(-t));
    }
    u32x4 w;
    w[0] = pack2(y[0], y[1]); w[1] = pack2(y[2], y[3]); w[2] = pack2(y[4], y[5]); w[3] = pack2(y[6], y[7]);
    *(u32x4*)(P_mix + (tokbase + s0 + wave * 4 + i) * 1024 + c0) = w;
  }
}

DI void phaseC(const Params& p, char* smem) {
  const int total = 128 + 1024 + 1056;
  int nxt = 0;
  if (get_tid() == 0) nxt = (int)atomicAdd(P_counters, 1u);
  for (;;) {
    __syncthreads();
    if (get_tid() == 0) *(volatile int*)(smem + SMEM_CTRL) = nxt;
    __syncthreads();
    const int item = *(volatile int*)(smem + SMEM_CTRL);
    if (item >= total) break;
    if (get_tid() == 0) nxt = (int)atomicAdd(P_counters, 1u);
    if (item < 128) attn_sample_item(p, item >> 2, item & 3, smem);
    else if (item < 1152) { const int i = item - 128; const int qp = 15 - (i >> 6), bh = i & 63; attn_prompt_item(p, bh >> 2, bh & 3, qp, smem); }
    else conv_item(p, item - 1152, smem);
  }
}

DI void d_rowstore(const Params& p, const float* Ct, int m0, int n0, int lt) {
  const int c8 = (lt & 15) * 8;
  const f32x4 bo0 = *(const f32x4*)(p.b_out + n0 + c8), bo1 = *(const f32x4*)(p.b_out + n0 + c8 + 4);
#pragma unroll
  for (int it = 0; it < 8; ++it) {
    const int row = it * 16 + (lt >> 4);
    f32x4 a = *(const f32x4*)(Ct + row * 132 + c8), b = *(const f32x4*)(Ct + row * 132 + c8 + 4);
#pragma unroll
    for (int e = 0; e < 4; ++e) { a[e] += bo0[e]; b[e] += bo1[e]; }
    *(u32x4*)(P_r + (size_t)(m0 + row) * 1024 + n0 + c8) = pack8v(a, b);
  }
}
DI void phaseD(const Params& p, char* smem) {
  const int nfull = (132 * 4) / (int)gridDim.x;
  for (int i = 0; i < nfull; ++i) {
    int pm, pn;
    if (!unit_of(i * (int)gridDim.x + (int)blockIdx.x, 132, 4, pm, pn)) break;
    f32x4 acc[2][2][4][2];
    __syncthreads();
    g8::gemm256(P_wout_t, P_mix, pn * 256, pm * 256, smem, acc);
#pragma unroll
    for (int bj = 0; bj < 2; ++bj) {
      __syncthreads();
      quad_to_lds_f32(acc, bj, smem);
      __syncthreads();
      const int t2 = get_tid(), hbk = t2 >> 8, lt = t2 & 255;
      d_rowstore(p, (const float*)(smem + hbk * HB_LDS), pm * 256 + bj * 128, pn * 256 + hbk * 128, lt);
    }
  }
  for (int q = (int)blockIdx.x;; q += (int)gridDim.x) {
    int pm, pn, ai, bj;
    if (!leftover_quad(q, 132, 4, pm, pn, ai, bj)) break;
    {
      const int t2 = get_tid(), hbk = t2 >> 8, lt = t2 & 255, lane = lt & 63, wave = lt >> 6, wm = wave >> 1, wn = wave & 1, r = lane & 31, h = lane >> 5;
      char* sm = smem + hbk * HB_LDS;
      const int m0 = pm * 256 + ai * 128, n0 = pn * 256 + bj * 128;
      const bool act = hbk == 0;
      f32x16 acc[2][2];
      gemm_tile(P_mix, P_wout_t, m0, n0, sm, acc, hbk);
      kadd(acc, smem, hbk, lt);
      __syncthreads();
      float* Ct = (float*)sm;
#pragma unroll
      for (int mi = 0; mi < 2; ++mi)
#pragma unroll
        for (int ni = 0; ni < 2; ++ni)
#pragma unroll
          for (int i = 0; i < 16; ++i) Ct[(wm * 64 + mi * 32 + crow(i, h)) * 132 + wn * 64 + ni * 32 + r] = acc[mi][ni][i];
      __syncthreads();
      if (act) d_rowstore(p, Ct, m0, n0, lt);
    }
  }
}

DI void phaseE(const Params& p) {
  const int tid = get_tid(), lane = tid & 63;
  const int gw = (tid >> 6) * gridDim.x + blockIdx.x, nw = gridDim.x * 8;
  for (int tok0 = gw; tok0 < T; tok0 += 2 * nw) {
    float v[2][16];
    int tk[2];
#pragma unroll
    for (int u = 0; u < 2; ++u) {
      const int tok = tok0 + u * nw < T ? tok0 + u * nw : tok0;
      tk[u] = tok;
      const u16* rr = P_r + (size_t)tok * 1024;
      const float* xr = tok < TP ? p.x_prompt + (size_t)tok * 1024 : p.x_sample + (size_t)(tok - TP) * 1024;
      const float* gr = P_mod + mod_row(tok) * 6144 + 2048;
#pragma unroll
      for (int hf = 0; hf < 2; ++hf) {
        const int c = hf * 512 + lane * 8;
        const u32x4 rw = *(const u32x4*)(rr + c);
        f32x4 a, b;
        a[0] = bf_lo(rw[0]); a[1] = bf_hi(rw[0]); a[2] = bf_lo(rw[1]); a[3] = bf_hi(rw[1]);
        b[0] = bf_lo(rw[2]); b[1] = bf_hi(rw[2]); b[2] = bf_lo(rw[3]); b[3] = bf_hi(rw[3]);
        const f32x4 xa = *(const f32x4*)(xr + c), xb = *(const f32x4*)(xr + c + 4);
        const f32x4 ga = *(const f32x4*)(gr + c), gb = *(const f32x4*)(gr + c + 4);
#pragma unroll
        for (int e = 0; e < 4; ++e) { v[u][hf * 8 + e] = ALPHA * xa[e] + ga[e] * a[e]; v[u][hf * 8 + 4 + e] = ALPHA * xb[e] + gb[e] * b[e]; }
      }
    }
#pragma unroll
    for (int u = 0; u < 2; ++u) {
      const int tok = tk[u];
      const float* mr = P_mod + mod_row(tok) * 6144;
      float s = 0.f;
#pragma unroll
      for (int i = 0; i < 16; ++i) s += v[u][i];
      const float mu = wave_sum(s) * (1.f / 1024.f);
      float q = 0.f;
#pragma unroll
      for (int i = 0; i < 16; ++i) { v[u][i] -= mu; q += v[u][i] * v[u][i]; }
      const float rstd = rsqrtf(wave_sum(q) * (1.f / 1024.f) + LN_EPS);
#pragma unroll
      for (int hf = 0; hf < 2; ++hf) {
        const int c = hf * 512 + lane * 8;
        f32x4 y0, y1, h0, h1;
        const f32x4 g0 = *(const f32x4*)(p.ln1_g + c), g1 = *(const f32x4*)(p.ln1_g + c + 4);
        const f32x4 b0 = *(const f32x4*)(p.ln1_b + c), b1 = *(const f32x4*)(p.ln1_b + c + 4);
        const f32x4 sc0 = *(const f32x4*)(mr + 4096 + c), sc1 = *(const f32x4*)(mr + 4096 + c + 4);
        const f32x4 sh0 = *(const f32x4*)(mr + 3072 + c), sh1 = *(const f32x4*)(mr + 3072 + c + 4);
#pragma unroll
        for (int e = 0; e < 4; ++e) {
          y0[e] = v[u][hf * 8 + e] * rstd * g0[e] + b0[e];
          y1[e] = v[u][hf * 8 + 4 + e] * rstd * g1[e] + b1[e];
          h0[e] = y0[e] * (1.f + sc0[e]) + sh0[e];
          h1[e] = y1[e] * (1.f + sc1[e]) + sh1[e];
        }
        u32x4 yw;
        yw[0] = __builtin_bit_cast(u32, h16x2{(_Float16)y0[0], (_Float16)y0[1]}); yw[1] = __builtin_bit_cast(u32, h16x2{(_Float16)y0[2], (_Float16)y0[3]});
        yw[2] = __builtin_bit_cast(u32, h16x2{(_Float16)y1[0], (_Float16)y1[1]}); yw[3] = __builtin_bit_cast(u32, h16x2{(_Float16)y1[2], (_Float16)y1[3]});
        *(u32x4*)(P_y1 + (size_t)tok * 1024 + c) = yw;
        *(u32x4*)(P_h2 + (size_t)tok * 1024 + c) = pack8v(h0, h1);
      }
    }
  }
}

DI u32 make_key(float s, int idx) {
  u32 u = __float_as_uint(s);
  u ^= ((u32)((int)u >> 31)) | 0x80000000u;
  return (u & ~127u) | (u32)idx;
}
DI float key_val(u32 key) {
  const u32 kb = key & ~127u;
  return __uint_as_float(kb ^ ((~(u32)((int)kb >> 31)) | 0x80000000u));
}
#define CE_DESC(a, b) { const u32 _x = max(a, b); const u32 _n = min(a, b); a = _x; b = _n; }
DI void bitonic_merge16(u32 (&v)[16]) {
#pragma unroll
  for (int j = 8; j > 0; j >>= 1)
#pragma unroll
    for (int i = 0; i < 16; ++i) {
      const int l = i ^ j;
      if (l > i) CE_DESC(v[i], v[l]);
    }
}
DI void sort16(u32 (&v)[16]) {
  CE_DESC(v[0], v[13]); CE_DESC(v[1], v[12]); CE_DESC(v[2], v[15]); CE_DESC(v[3], v[14]); CE_DESC(v[4], v[8]); CE_DESC(v[5], v[6]); CE_DESC(v[7], v[11]); CE_DESC(v[9], v[10]);
  CE_DESC(v[0], v[5]); CE_DESC(v[1], v[7]); CE_DESC(v[2], v[9]); CE_DESC(v[3], v[4]); CE_DESC(v[6], v[13]); CE_DESC(v[8], v[14]); CE_DESC(v[10], v[15]); CE_DESC(v[11], v[12]);
  CE_DESC(v[0], v[1]); CE_DESC(v[2], v[3]); CE_DESC(v[4], v[5]); CE_DESC(v[6], v[8]); CE_DESC(v[7], v[9]); CE_DESC(v[10], v[11]); CE_DESC(v[12], v[13]); CE_DESC(v[14], v[15]);
  CE_DESC(v[0], v[2]); CE_DESC(v[1], v[3]); CE_DESC(v[4], v[10]); CE_DESC(v[5], v[11]); CE_DESC(v[6], v[7]); CE_DESC(v[8], v[9]); CE_DESC(v[12], v[14]); CE_DESC(v[13], v[15]);
  CE_DESC(v[1], v[2]); CE_DESC(v[3], v[12]); CE_DESC(v[4], v[6]); CE_DESC(v[5], v[7]); CE_DESC(v[8], v[10]); CE_DESC(v[9], v[11]); CE_DESC(v[13], v[14]);
  CE_DESC(v[1], v[4]); CE_DESC(v[2], v[6]); CE_DESC(v[5], v[8]); CE_DESC(v[7], v[10]); CE_DESC(v[9], v[13]); CE_DESC(v[11], v[14]);
  CE_DESC(v[2], v[4]); CE_DESC(v[3], v[6]); CE_DESC(v[9], v[12]); CE_DESC(v[11], v[13]);
  CE_DESC(v[3], v[5]); CE_DESC(v[6], v[8]); CE_DESC(v[7], v[9]); CE_DESC(v[10], v[12]);
  CE_DESC(v[3], v[4]); CE_DESC(v[5], v[6]); CE_DESC(v[7], v[8]); CE_DESC(v[9], v[10]); CE_DESC(v[11], v[12]);
  CE_DESC(v[6], v[7]); CE_DESC(v[8], v[9]);
}
DI void merge_top16(u32 (&a)[16], const u32 (&b)[16]) {
#pragma unroll
  for (int i = 0; i < 16; ++i) a[i] = max(a[i], b[15 - i]);
  bitonic_merge16(a);
}

DI void f_epilogue(const Params& p, char* sm, int m0, int hp, int lt) {
  const int lane = lt & 63, wave = lt >> 6, wm = wave >> 1, wn = wave & 1;
  const int r = lane & 31, h = lane >> 5;
  u32* PL = (u32*)sm;
  char* Qs = sm + 32768;
  {
    bf16x8 ska[8], skb[8];
    {
      const u16* skp = P_sk + ((size_t)hp * 128 + wm * 64 + r) * 128 + h * 8;
#pragma unroll
      for (int ks = 0; ks < 8; ++ks) { ska[ks] = *(const bf16x8*)(skp + ks * 16); skb[ks] = *(const bf16x8*)(skp + 32 * 128 + ks * 16); }
    }
    __syncthreads();
    f32x16 st[2][2];
#pragma unroll
    for (int a = 0; a < 2; ++a)
#pragma unroll
      for (int b = 0; b < 2; ++b)
#pragma unroll
        for (int i = 0; i < 16; ++i) st[a][b][i] = 0.f;
    {
      const char* qp = Qs + (wn * 64 + r) * 272 + h * 16;
#pragma unroll
      for (int ks = 0; ks < 8; ++ks) {
        const bf16x8 b0 = *(const bf16x8*)(qp + ks * 32), b1 = *(const bf16x8*)(qp + 32 * 272 + ks * 32);
        st[0][0] = MFMA32(ska[ks], b0, st[0][0]);
        st[0][1] = MFMA32(ska[ks], b1, st[0][1]);
        st[1][0] = MFMA32(skb[ks], b0, st[1][0]);
        st[1][1] = MFMA32(skb[ks], b1, st[1][1]);
      }
    }
#pragma unroll
    for (int nt = 0; nt < 2; ++nt) {
      u32 va[16], vb[16];
#pragma unroll
      for (int i = 0; i < 16; ++i) {
        va[i] = make_key(st[0][nt][i], wm * 64 + crow(i, h));
        vb[i] = make_key(st[1][nt][i], wm * 64 + 32 + crow(i, h));
      }
      sort16(va);
      sort16(vb);
      merge_top16(va, vb);
      u32* dst = PL + ((wn * 64 + nt * 32 + r) * 4 + wm * 2 + h) * 16;
#pragma unroll
      for (int q = 0; q < 4; ++q) *(uint4*)(dst + 4 * q) = make_uint4(va[4 * q], va[4 * q + 1], va[4 * q + 2], va[4 * q + 3]);
    }
    __syncthreads();
    if (lt < 128) {
      u32 l0[16], l1[16], l2[16], l3[16];
      const u32* src = PL + lt * 64;
#pragma unroll
      for (int q = 0; q < 4; ++q) {
        const uint4 a = *(const uint4*)(src + 4 * q), b = *(const uint4*)(src + 16 + 4 * q);
        const uint4 c = *(const uint4*)(src + 32 + 4 * q), d = *(const uint4*)(src + 48 + 4 * q);
        l0[4 * q] = a.x; l0[4 * q + 1] = a.y; l0[4 * q + 2] = a.z; l0[4 * q + 3] = a.w;
        l1[4 * q] = b.x; l1[4 * q + 1] = b.y; l1[4 * q + 2] = b.z; l1[4 * q + 3] = b.w;
        l2[4 * q] = c.x; l2[4 * q + 1] = c.y; l2[4 * q + 2] = c.z; l2[4 * q + 3] = c.w;
        l3[4 * q] = d.x; l3[4 * q + 1] = d.y; l3[4 * q + 2] = d.z; l3[4 * q + 3] = d.w;
      }
      merge_top16(l0, l1);
      merge_top16(l2, l3);
      merge_top16(l0, l2);
      u32* dst = P_topk + (size_t)(m0 + lt) * 256 + hp * 16;
#pragma unroll
      for (int q = 0; q < 4; ++q) *(uint4*)(dst + 4 * q) = make_uint4(l0[4 * q], l0[4 * q + 1], l0[4 * q + 2], l0[4 * q + 3]);
    }
  }
}

DI void phaseF(const Params& p, char* smem) {
  const int nfull = (132 * 8) / (int)gridDim.x;
  for (int i = 0; i < nfull; ++i) {
    int pm, pn;
    if (!unit_of(i * (int)gridDim.x + (int)blockIdx.x, 132, 8, pm, pn)) break;
    f32x4 acc[2][2][4][2];
    __syncthreads();
    g8::gemm256(P_wq_t, P_h2, pn * 256, pm * 256, smem, acc);
#pragma unroll
    for (int bj = 0; bj < 2; ++bj) {
      __syncthreads();
      {
        const int tid = get_tid(), wid = tid >> 6, lane = tid & 63, wr = wid >> 2, wc = wid & 3, fr = lane & 15, fq = lane >> 4;
#pragma unroll
        for (int ai = 0; ai < 2; ++ai) {
          char* Qs = smem + ai * HB_LDS + 32768;
#pragma unroll
          for (int m = 0; m < 4; ++m)
#pragma unroll
            for (int n = 0; n < 2; ++n)
              *(u32x2*)(Qs + (wc * 32 + n * 16 + fr) * 272 + (wr * 64 + m * 16 + fq * 4) * 2) =
                  u32x2{pack2(acc[ai][bj][m][n][0], acc[ai][bj][m][n][1]), pack2(acc[ai][bj][m][n][2], acc[ai][bj][m][n][3])};
        }
      }
      const int t2 = get_tid(), hbk = t2 >> 8;
      f_epilogue(p, smem + hbk * HB_LDS, pm * 256 + bj * 128, pn * 2 + hbk, t2 & 255);
    }
  }
  for (int q = (int)blockIdx.x;; q += (int)gridDim.x) {
    int pm, pn, ai, bj;
    if (!leftover_quad(q, 132, 8, pm, pn, ai, bj)) break;
    {
      const int t2 = get_tid(), hbk = t2 >> 8, lt = t2 & 255, lane = lt & 63, wave = lt >> 6, wm = wave >> 1, wn = wave & 1, r = lane & 31, h = lane >> 5;
      char* sm = smem + hbk * HB_LDS;
      const int m0 = pm * 256 + ai * 128, n0 = pn * 256 + bj * 128;
      const bool act = hbk == 0;
      {
        f32x16 acc[2][2];
        gemm_tile(P_h2, P_wq_t, m0, n0, sm, acc, hbk);
      kadd(acc, smem, hbk, lt);
        char* Qs = sm + 32768;
        __syncthreads();
#pragma unroll
        for (int mi = 0; mi < 2; ++mi)
#pragma unroll
          for (int ni = 0; ni < 2; ++ni)
#pragma unroll
            for (int i = 0; i < 16; ++i)
              *(u16*)(Qs + (wm * 64 + mi * 32 + crow(i, h)) * 272 + (wn * 64 + ni * 32 + r) * 2) = (u16)f2bf(acc[mi][ni][i]);
      }
      if (act) f_epilogue(p, sm, m0, pn * 2 + bj, lt);
      else { __syncthreads(); __syncthreads(); }
    }
  }
}

__device__ const unsigned char kStairI[64] = {0, 0, 0, 0, 0, 0, 0, 0, 0, 0, 0, 0, 0, 0, 0, 0, 1, 1, 1, 1, 1, 1, 1, 1, 2, 2, 2, 2, 2, 3, 3, 3,
                                              3, 4, 4, 4, 5, 5, 6, 6, 7, 7, 8, 9, 10, 11, 12, 13, 14, 15, 0, 0, 0, 0, 0, 0, 0, 0, 0, 0, 0, 0, 0, 0};
__device__ const unsigned char kStairJ[64] = {0, 1, 2, 3, 4, 5, 6, 7, 8, 9, 10, 11, 12, 13, 14, 15, 0, 1, 2, 3, 4, 5, 6, 7, 0, 1, 2, 3, 4, 0, 1, 2,
                                              3, 0, 1, 2, 0, 1, 0, 1, 0, 1, 0, 0, 0, 0, 0, 0, 0, 0, 0, 0, 0, 0, 0, 0, 0, 0, 0, 0, 0, 0, 0, 0};

DI void phaseG1(const Params& p, char* smem) {
  const int tid = get_tid(), lane = tid & 63, wave = tid >> 6;
  const int gw = wave * gridDim.x + blockIdx.x, nw = gridDim.x * 8;
  char* wb = smem + wave * 5632;
  LAS u32* wtop = (LAS u32*)wb;
  LAS float* wcand = (LAS float*)(wb + 1024);
  LAS u32* we = (LAS u32*)(wb + 3072);
  LAS float* wg = (LAS float*)(wb + 3584);
  LAS float* wc = (LAS float*)(wb + 4096);
  LAS float* wsu = (LAS float*)(wb + 4608);
  LAS float* wsv = (LAS float*)(wb + 5120);
  const int si = kStairI[lane], sj = kStairJ[lane];
  const bool valid = lane < 50;
  u32x4 tkn = *(const u32x4*)(P_topk + (size_t)(gw < T ? gw : 0) * 256 + lane * 4);
  for (int tok = gw; tok < T; tok += nw) {
    *(LAS u32x4*)(wtop + lane * 4) = tkn;
    {
      const int ntok = tok + nw < T ? tok + nw : tok;
      tkn = *(const u32x4*)(P_topk + (size_t)ntok * 256 + lane * 4);
    }
    wave_lds_sync();
    float cand[8];
    u32 eid[8], ckey[8];
#pragma unroll
    for (int hd = 0; hd < 8; ++hd) {
      const u32 ka = wtop[(2 * hd) * 16 + si], kb = wtop[(2 * hd + 1) * 16 + sj];
      cand[hd] = valid ? key_val(ka) + key_val(kb) : -INFINITY;
      eid[hd] = (ka & 127u) * 128u + (kb & 127u);
      u32 ku = __float_as_uint(cand[hd]);
      ku ^= ((u32)((int)ku >> 31)) | 0x80000000u;
      ckey[hd] = (ku & ~63u) | (u32)(63 - lane);
      wcand[hd * 64 + lane] = __uint_as_float(ckey[hd]);
    }
    wave_lds_sync();
    int rank[8];
    float su_r[8], sv_r[8];
#pragma unroll
    for (int hd = 0; hd < 8; ++hd) { rank[hd] = 0; su_r[hd] = 0.f; sv_r[hd] = 0.f; }
#pragma unroll 1
    for (int j4 = 0; j4 < 13; ++j4) {
#pragma unroll
      for (int hd = 0; hd < 8; ++hd) {
        const u32x4 o = *(const LAS u32x4*)(wcand + hd * 64 + j4 * 4);
        const u32 m = ckey[hd];
        rank[hd] += (o[0] > m) ? 1 : 0;
        rank[hd] += (o[1] > m) ? 1 : 0;
        rank[hd] += (o[2] > m) ? 1 : 0;
        rank[hd] += (o[3] > m) ? 1 : 0;
      }
    }
#pragma unroll
    for (int hd = 0; hd < 8; ++hd) {
      const float mine = cand[hd];
      const bool sel = valid && rank[hd] < 16;
      const float mx = __uint_as_float((u32)__builtin_amdgcn_readfirstlane((int)__float_as_uint(mine)));
      const float ex = sel ? __expf(mine - mx) : 0.f;
      const float sm = wave_sum(ex);
      if (sel) {
        const int slot = hd * 16 + rank[hd];
        we[slot] = eid[hd]; wg[slot] = ex / sm;
        su_r[hd] = P_usc[eid[hd]]; sv_r[hd] = P_vsc[eid[hd]];
      }
    }
    wave_lds_sync();
    const int l5 = lane & 31, hv = lane >> 5;
    h16x2 hfp[16];
    {
      const u16* h2p = P_h2 + (size_t)tok * 1024 + 4 * l5;
#pragma unroll
      for (int j = 0; j < 8; ++j) {
        const uint2 w = *(const uint2*)(h2p + 128 * j);
        hfp[2 * j] = h16x2{(_Float16)bf_lo(w.x), (_Float16)bf_hi(w.x)};
        hfp[2 * j + 1] = h16x2{(_Float16)bf_lo(w.y), (_Float16)bf_hi(w.y)};
      }
    }
#pragma unroll 1
    for (int k0 = 0; k0 < 128; k0 += 32) {
      u32 es[16];
#pragma unroll
      for (int q = 0; q < 8; ++q) {
        const u32x4 e = *(const LAS u32x4*)(we + k0 + 4 * q);
        es[2 * q] = hv ? e[1] : e[0]; es[2 * q + 1] = hv ? e[3] : e[2];
      }
      u32x4 ra[16];
      u32x2 rb[16];
#pragma unroll
      for (int i = 0; i < 16; ++i) {
        const unsigned char* rp = P_utab + (size_t)es[i] * 768;
        ra[i] = *(const u32x4*)(rp + 16 * l5);
        rb[i] = *(const u32x2*)(rp + 512 + 8 * l5);
      }
      if (k0 == 0) {
#pragma unroll
        for (int hd = 0; hd < 8; ++hd)
          if (valid && rank[hd] < 16) { wsu[hd * 16 + rank[hd]] = su_r[hd]; wsv[hd * 16 + rank[hd]] = sv_r[hd]; }
      }
      float d[16];
#pragma unroll
      for (int i = 0; i < 16; ++i) {
        const h16x32 f = __builtin_amdgcn_cvt_scalef32_pk32_f16_fp6(u32x6{ra[i][0], ra[i][1], ra[i][2], ra[i][3], rb[i][0], rb[i][1]}, 1.0f);
        float acc0 = 0.f, acc1 = 0.f;
#pragma unroll
        for (int m = 0; m < 16; m += 2) {
          acc0 = __builtin_amdgcn_fdot2(h16x2{f[2 * m], f[2 * m + 1]}, hfp[m], acc0, false);
          acc1 = __builtin_amdgcn_fdot2(h16x2{f[2 * m + 2], f[2 * m + 3]}, hfp[m + 1], acc1, false);
        }
        d[i] = acc0 + acc1;
        if (i < 15) asm volatile("" : "+v"(ra[i + 1]) : "v"(d[i]));
      }
      float e8[8], e4[4], e2[2], e1s;
      {
        const bool up = (l5 & 16) != 0;
#pragma unroll
        for (int i = 0; i < 8; ++i) {
          const float send = up ? d[i] : d[i + 8], keep = up ? d[i + 8] : d[i];
          e8[i] = keep + __shfl_xor(send, 16);
        }
      }
      {
        const bool up = (l5 & 8) != 0;
#pragma unroll
        for (int i = 0; i < 4; ++i) {
          const float send = up ? e8[i] : e8[i + 4], keep = up ? e8[i + 4] : e8[i];
          e4[i] = keep + __shfl_xor(send, 8);
        }
      }
      {
        const bool up = (l5 & 4) != 0;
#pragma unroll
        for (int i = 0; i < 2; ++i) {
          const float send = up ? e4[i] : e4[i + 2], keep = up ? e4[i + 2] : e4[i];
          e2[i] = keep + __shfl_xor(send, 4);
        }
      }
      {
        const bool up = (l5 & 2) != 0;
        const float send = up ? e2[0] : e2[1], keep = up ? e2[1] : e2[0];
        e1s = keep + dpp_xor2(send);
      }
      e1s += dpp_xor1(e1s);
      if ((l5 & 1) == 0) {
        const int k = k0 + 2 * (l5 >> 1) + hv;
        const float a = e1s * wsu[k];
        wc[k] = 0.5f * a * (1.f + erff(a * 0.70710678118654752f)) * wg[k] * wsv[k];
      }
    }
    wave_lds_sync();
    {
      const u32x2 ev = *(const LAS u32x2*)(we + 2 * lane);
      const f32x2 cv = *(const LAS f32x2*)(wc + 2 * lane);
      const h16x2 ch = h16x2{(_Float16)(cv[0] * 1024.f), (_Float16)(cv[1] * 1024.f)};
      const u32 cw = __builtin_bit_cast(u32, ch);
      *(u32x2*)(P_elist + (size_t)tok * 128 + 2 * lane) = u32x2{ev[0] | (cw << 16), ev[1] | (cw & 0xffff0000u)};
    }
    wave_lds_sync();
  }
}

DI void phaseG2(const Params& p, char* smem) {
  const int tid = get_tid(), lane = tid & 63, wave = tid >> 6;
  const int gw = wave * gridDim.x + blockIdx.x, nw = gridDim.x * 8;
  char* wb = smem + wave * 5632;
  LAS u32* we = (LAS u32*)(wb + 3072);

  const int l5 = lane & 31, hv = lane >> 5;
  const int cb = 512 * hv + 4 * l5;
  f32x4 l2g[4], l2b[4];
#pragma unroll
  for (int j = 0; j < 4; ++j) { l2g[j] = *(const f32x4*)(p.ln2_g + cb + 128 * j); l2b[j] = *(const f32x4*)(p.ln2_b + cb + 128 * j); }
  u32x2 eln = *(const u32x2*)(P_elist + (size_t)(gw < T ? gw : 0) * 128 + 2 * lane);
  for (int tok = gw; tok < T; tok += nw) {
    *(LAS u32x2*)(we + 2 * lane) = eln;
    {
      const int ntok = tok + nw < T ? tok + nw : tok;
      eln = *(const u32x2*)(P_elist + (size_t)ntok * 128 + 2 * lane);
    }
    h16x4 yh[4];
    f32x4 g2v[4];
    {
      const _Float16* y1p = P_y1 + (size_t)tok * 1024 + cb;
      const float* g2p = P_mod + mod_row(tok) * 6144 + 5120 + cb;
#pragma unroll
      for (int j = 0; j < 4; ++j) { yh[j] = *(const h16x4*)(y1p + 128 * j); g2v[j] = *(const f32x4*)(g2p + 128 * j); }
    }
    wave_lds_sync();
    h16x2 ffh[16];
#pragma unroll
    for (int i = 0; i < 16; ++i) ffh[i] = h16x2{(_Float16)0.f, (_Float16)0.f};
#pragma unroll 1
    for (int k0 = 0; k0 < 128; k0 += 32) {
      u32 es[16];
#pragma unroll
      for (int q = 0; q < 8; ++q) {
        const u32x4 e = *(const LAS u32x4*)(we + k0 + 4 * q);
        es[2 * q] = hv ? e[1] : e[0]; es[2 * q + 1] = hv ? e[3] : e[2];
      }
      u32x4 ra[16];
      u32x2 rb[16];
#pragma unroll
      for (int i = 0; i < 16; ++i) {
        const unsigned char* rp = P_vtab + (size_t)(es[i] & 0xffffu) * 768;
        ra[i] = *(const u32x4*)(rp + 16 * l5);
        rb[i] = *(const u32x2*)(rp + 512 + 8 * l5);
      }
#pragma unroll
      for (int i = 0; i < 16; ++i) {
        const h16x32 f = __builtin_amdgcn_cvt_scalef32_pk32_f16_fp6(u32x6{ra[i][0], ra[i][1], ra[i][2], ra[i][3], rb[i][0], rb[i][1]}, 1.0f);
        const u32 ewd = es[i];
        const h16x2 ew = __builtin_bit_cast(h16x2, ewd);
        const h16x2 cc = h16x2{ew[1], ew[1]};
#pragma unroll
        for (int m = 0; m < 16; ++m) ffh[m] = h16x2{f[2 * m], f[2 * m + 1]} * cc + ffh[m];
        if (i < 15) asm volatile("" : "+v"(ra[i + 1]) : "v"(ffh[0]), "v"(ffh[7]), "v"(ffh[15]));
      }
    }
    float fs[16];
#pragma unroll
    for (int i = 0; i < 8; ++i) {
      const auto r = __builtin_amdgcn_permlane32_swap(__builtin_bit_cast(u32, ffh[i]), __builtin_bit_cast(u32, ffh[8 + i]), false, false);
      const u32 w0 = r[0], w1 = r[1];
      const h16x2 mine = __builtin_bit_cast(h16x2, w0), oth = __builtin_bit_cast(h16x2, w1);
      fs[2 * i] = ((float)mine[0] + (float)oth[0]) * (1.f / 1024.f);
      fs[2 * i + 1] = ((float)mine[1] + (float)oth[1]) * (1.f / 1024.f);
    }
    float rv[16];
#pragma unroll
    for (int j = 0; j < 4; ++j) {
      const f32x4 y = f32x4{(float)yh[j][0], (float)yh[j][1], (float)yh[j][2], (float)yh[j][3]}, g = g2v[j];
#pragma unroll
      for (int i = 0; i < 4; ++i) rv[4 * j + i] = ALPHA * y[i] + g[i] * fs[4 * j + i];
    }
    float s = 0.f;
#pragma unroll
    for (int i = 0; i < 16; ++i) s += rv[i];
    const float mu = wave_sum(s) * (1.f / 1024.f);
    float q = 0.f;
#pragma unroll
    for (int i = 0; i < 16; ++i) { rv[i] -= mu; q += rv[i] * rv[i]; }
    const float rstd = rsqrtf(wave_sum(q) * (1.f / 1024.f) + LN_EPS);
    const float poison = P_misc[1] != 0.f ? __builtin_nanf("") : 0.f;
    float* outp = (tok < TP ? P_y_prompt + (size_t)tok * 1024 : P_y_sample + (size_t)(tok - TP) * 1024) + cb;
#pragma unroll
    for (int j = 0; j < 4; ++j) {
      const f32x4 g = l2g[j], b = l2b[j];
      f32x4 o;
#pragma unroll
      for (int i = 0; i < 4; ++i) o[i] = rv[4 * j + i] * rstd * g[i] + b[i] + poison;
      *(f32x4*)(outp + 128 * j) = o;
    }
    wave_lds_sync();
  }
}

typedef const __attribute__((address_space(4))) Params* kparams_t;
DI Params fresh_params(kparams_t pp) {
#if defined(__HIP_DEVICE_COMPILE__)
  asm volatile("" : "+s"(pp));
  return *pp;
#else
  return Params{};
#endif
}

__global__ void __launch_bounds__(512, 2) fwd_megakernel(Params p_arg) {
  cg::grid_group grid = cg::this_grid();
  __shared__ __attribute__((aligned(16))) char smem[SMEM_BYTES];
  kparams_t pp = (kparams_t)__builtin_amdgcn_kernarg_segment_ptr();
  if (threadIdx.x == 0) { *(volatile LAS unsigned*)(smem + SMEM_CTRL + 8) = 0u; *(volatile LAS unsigned*)(smem + SMEM_CTRL + 12) = 0u; }
  __syncthreads();
  const XcdBarrier xb = xcd_barrier_post((unsigned*)(fresh_params(pp).ws + OFF_BAR), (volatile LAS unsigned*)(smem + SMEM_CTRL + 8));
  if (p_arg.out == nullptr) grid.sync();
  phaseA(fresh_params(pp), smem);
  xcd_barrier(xb);
  phaseA2(fresh_params(pp));
  xcd_barrier(xb);
  phaseB(fresh_params(pp), smem);
  xcd_barrier(xb);
  phaseC(fresh_params(pp), smem);
  xcd_barrier(xb);
  phaseD(fresh_params(pp), smem);
  xcd_barrier(xb);
  phaseE(fresh_params(pp));
  xcd_barrier(xb);
  phaseF(fresh_params(pp), smem);
  xcd_barrier(xb);
  phaseG1(fresh_params(pp), smem);
  xcd_barrier(xb);
  phaseG2(fresh_params(pp), smem);
}

extern "C" void kernel_launch(void* const* d_in, const int* in_sizes, int n_in, void* d_out, int out_size,
                              void* d_ws, size_t ws_size, hipStream_t stream) {
  static int grid_blocks = 0;
  if (!grid_blocks) {
    int dev = 0, cus = 0, per_cu = 0;
    (void)hipGetDevice(&dev);
    (void)hipDeviceGetAttribute(&cus, hipDeviceAttributeMultiprocessorCount, dev);
    (void)hipOccupancyMaxActiveBlocksPerMultiprocessor(&per_cu, fwd_megakernel, 512, 0);
    if (per_cu > 1) per_cu = 1;
    grid_blocks = cus * per_cu;
    if (ws_size < WS_NEED) fprintf(stderr, "workspace too small: %zu < %zu\n", ws_size, (size_t)WS_NEED);
  }
  Params p{};
  const float* const* in = (const float* const*)d_in;
  p.x_prompt = in[0]; p.x_sample = in[1]; p.cache_k = in[2]; p.cache_v = in[3]; p.cache_conv = in[4]; p.c_prompt = in[5]; p.c_sample = in[6];
  p.w_ada = in[7]; p.b_ada = in[8]; p.w_in = in[9]; p.b_in = in[10]; p.w_dw = in[11]; p.b_dw = in[12]; p.conv_ln_g = in[13]; p.conv_ln_b = in[14];
  p.lam_q1 = in[15]; p.lam_k1 = in[16]; p.lam_q2 = in[17]; p.lam_k2 = in[18]; p.subln_g = in[19]; p.w_out = in[20]; p.b_out = in[21];
  p.ln1_g = in[22]; p.ln1_b = in[23]; p.w_query = in[24]; p.sub_keys = in[25]; p.u_tab = in[26]; p.v_tab = in[27]; p.ln2_g = in[28]; p.ln2_b = in[29];
  p.out = (float*)d_out;
  p.ws = (char*)d_ws;
  char* ws = (char*)d_ws;
  (void)hipMemsetAsync(ws + OFF_MISC + 256, 0, 4096 - 256 + 16384, stream);
  void* args[] = {&p};
  hipError_t e = hipLaunchCooperativeKernel((void*)fwd_megakernel, dim3(grid_blocks), dim3(512), args, 0, stream);
  if (e != hipSuccess) fprintf(stderr, "cooperative launch failed: %s (grid %d)\n", hipGetErrorString(e), grid_blocks);
}
```

```cpp
#include <hip/hip_runtime.h>
#include <hip/hip_cooperative_groups.h>
#include <cstdio>
#include <cstdint>
namespace cg = cooperative_groups;

typedef unsigned short u16;
typedef unsigned int u32;
using bf16x8 = __attribute__((ext_vector_type(8))) short;
using s16x4 = __attribute__((ext_vector_type(4))) short;
using f32x16 = __attribute__((ext_vector_type(16))) float;
using u32x4 = __attribute__((ext_vector_type(4))) unsigned;
using f32x4 = __attribute__((ext_vector_type(4))) float;
using f32x2 = __attribute__((ext_vector_type(2))) float;
using h16x2 = __attribute__((ext_vector_type(2))) _Float16;
using h16x4 = __attribute__((ext_vector_type(4))) _Float16;
using h16x32 = __attribute__((ext_vector_type(32))) _Float16;
using u32x2 = __attribute__((ext_vector_type(2))) unsigned;
using u32x6 = __attribute__((ext_vector_type(6))) unsigned;
using f32x32 = __attribute__((ext_vector_type(32))) float;
typedef __bf16 bf16x2_t __attribute__((ext_vector_type(2)));
#define DI __device__ __forceinline__
#define LAS __attribute__((address_space(3)))
#define GAS __attribute__((address_space(1)))
#define MFMA32(a, b, c) __builtin_amdgcn_mfma_f32_32x32x16_bf16((a), (b), (c), 0, 0, 0)

constexpr int TP = 32768, TS = 1024, T = TP + TS;
constexpr float LN_EPS = 1e-5f;
constexpr float ALPHA = 1.189207115002721f;
constexpr float LAM_INIT = 0.2f;

constexpr size_t OFF_MOD = 0;
constexpr size_t OFF_ROPE = OFF_MOD + 1179648;
constexpr size_t OFF_MISC = OFF_ROPE + 532480;
constexpr size_t OFF_BAR = OFF_MISC + 4096;
constexpr size_t OFF_WIN = OFF_BAR + 16384;
constexpr size_t OFF_WOUT = OFF_WIN + 5242880;
constexpr size_t OFF_WQ = OFF_WOUT + 2097152;
constexpr size_t OFF_SK = OFF_WQ + 4194304;
constexpr size_t OFF_UTAB = OFF_SK + 524288;
constexpr size_t OFF_VTAB = OFF_UTAB + 16777216;
constexpr size_t OFF_USC = OFF_VTAB + 16777216;
constexpr size_t OFF_VSC = OFF_USC + 65536;
constexpr size_t OFF_X = OFF_VSC + 65536;
constexpr size_t OFF_Y = OFF_X + 69206016;
constexpr size_t OFF_Z = OFF_Y + 138412032;
constexpr size_t OFF_H2 = OFF_Z + 138412032;
constexpr size_t WS_NEED = OFF_H2 + 69206016;

constexpr int HB_LDS = 73728;
constexpr int SMEM_BYTES = 2 * HB_LDS + 64;
constexpr int SMEM_CTRL = 2 * HB_LDS;

struct Params {
  const float *x_prompt, *x_sample, *cache_k, *cache_v, *cache_conv, *c_prompt, *c_sample;
  const float *w_ada, *b_ada, *w_in, *b_in, *w_dw, *b_dw, *conv_ln_g, *conv_ln_b;
  const float *lam_q1, *lam_k1, *lam_q2, *lam_k2, *subln_g, *w_out, *b_out, *ln1_g, *ln1_b;
  const float *w_query, *sub_keys, *u_tab, *v_tab, *ln2_g, *ln2_b;
  float* out;
  char* ws;
};
#define P_y_prompt (p.out)
#define P_y_sample (p.out + 33554432)
#define P_k_prompt (p.out + 34603008)
#define P_v_prompt (p.out + 51380224)
#define P_conv_prompt (p.out + 68157440)
#define P_k_sample (p.out + 68403200)
#define P_v_sample (p.out + 68927488)
#define P_conv_sample (p.out + 69451776)
#define P_mod ((float*)(p.ws + OFF_MOD))
#define P_rope ((float2*)(p.ws + OFF_ROPE))
#define P_misc ((float*)(p.ws + OFF_MISC))
#define P_counters ((u32*)(p.ws + OFF_MISC + 256))
#define P_win_t ((u16*)(p.ws + OFF_WIN))
#define P_wout_t ((u16*)(p.ws + OFF_WOUT))
#define P_wq_t ((u16*)(p.ws + OFF_WQ))
#define P_sk ((u16*)(p.ws + OFF_SK))
#define P_utab ((unsigned char*)(p.ws + OFF_UTAB))
#define P_vtab ((unsigned char*)(p.ws + OFF_VTAB))
#define P_usc ((float*)(p.ws + OFF_USC))
#define P_vsc ((float*)(p.ws + OFF_VSC))
#define P_hb ((u16*)(p.ws + OFF_X))
#define P_mix ((u16*)(p.ws + OFF_X))
#define P_ub ((u16*)(p.ws + OFF_Y))
#define P_qb ((u16*)(p.ws + OFF_Y + 34603008))
#define P_kb ((u16*)(p.ws + OFF_Y + 2 * 34603008))
#define P_vb ((u16*)(p.ws + OFF_Y + 3 * 34603008))
#define P_y1 ((_Float16*)(p.ws + OFF_Y))
#define P_r ((u16*)(p.ws + OFF_Z))
#define P_topk ((u32*)(p.ws + OFF_Z))
#define P_elist ((u32*)(p.ws + OFF_Z + 41943040))
#define P_h2 ((u16*)(p.ws + OFF_H2))

DI u32 f2bf(float x) { u32 u = __float_as_uint(x); u += 0x7fffu + ((u >> 16) & 1u); return u >> 16; }
DI u32 pack2(float lo, float hi) { return f2bf(lo) | (f2bf(hi) << 16); }
DI float bf_lo(u32 w) { return __uint_as_float(w << 16); }
DI float bf_hi(u32 w) { return __uint_as_float(w & 0xffff0000u); }
DI int get_tid() { int t = threadIdx.x; asm volatile("" : "+v"(t)); return t; }
DI int crow(int reg, int h) { return (reg & 3) + 8 * (reg >> 2) + 4 * h; }
DI float dpp_xor1(float v) { return __uint_as_float((u32)__builtin_amdgcn_mov_dpp((int)__float_as_uint(v), 0xB1, 0xF, 0xF, true)); }
DI float dpp_xor2(float v) { return __uint_as_float((u32)__builtin_amdgcn_mov_dpp((int)__float_as_uint(v), 0x4E, 0xF, 0xF, true)); }
DI float dpp_ror8(float v) { return __uint_as_float((u32)__builtin_amdgcn_mov_dpp((int)__float_as_uint(v), 0x128, 0xF, 0xF, true)); }
DI float dpp_ror4(float v) { return __uint_as_float((u32)__builtin_amdgcn_mov_dpp((int)__float_as_uint(v), 0x124, 0xF, 0xF, true)); }
DI float xsum32(float x) { const auto r = __builtin_amdgcn_permlane32_swap(__float_as_uint(x), __float_as_uint(x), false, false); return __uint_as_float(r[0]) + __uint_as_float(r[1]); }
DI float xmax32(float x) { const auto r = __builtin_amdgcn_permlane32_swap(__float_as_uint(x), __float_as_uint(x), false, false); return fmaxf(__uint_as_float(r[0]), __uint_as_float(r[1])); }
DI float xsum16(float x) { const auto r = __builtin_amdgcn_permlane16_swap(__float_as_uint(x), __float_as_uint(x), false, false); return __uint_as_float(r[0]) + __uint_as_float(r[1]); }
DI float xmax16(float x) { const auto r = __builtin_amdgcn_permlane16_swap(__float_as_uint(x), __float_as_uint(x), false, false); return fmaxf(__uint_as_float(r[0]), __uint_as_float(r[1])); }
DI float wave_sum(float v) {
  v = xsum32(v);
  v = xsum16(v);
  v += dpp_ror8(v);
  v += dpp_ror4(v);
  v += dpp_xor2(v);
  v += dpp_xor1(v);
  return v;
}
DI float wave_max(float v) {
  v = xmax32(v);
  v = xmax16(v);
  v = fmaxf(v, dpp_ror8(v));
  v = fmaxf(v, dpp_ror4(v));
  v = fmaxf(v, dpp_xor2(v));
  v = fmaxf(v, dpp_xor1(v));
  return v;
}
DI void wave_lds_sync() { asm volatile("s_waitcnt lgkmcnt(0)" ::: "memory"); }
DI uint4 pack8(const float4& a, const float4& b) {
  uint4 r; r.x = pack2(a.x, a.y); r.y = pack2(a.z, a.w); r.z = pack2(b.x, b.y); r.w = pack2(b.z, b.w); return r;
}
DI u32x4 pack8v(const f32x4& a, const f32x4& b) {
  u32x4 r; r[0] = pack2(a[0], a[1]); r[1] = pack2(a[2], a[3]); r[2] = pack2(b[0], b[1]); r[3] = pack2(b[2], b[3]); return r;
}
DI int mod_row(int tok) { return tok < TP ? (tok >> 11) : 16 + ((tok - TP) >> 5); }
DI float dot2bf(u32 a, u32 b, float acc) {
  return __builtin_amdgcn_fdot2_f32_bf16(__builtin_bit_cast(bf16x2_t, a), __builtin_bit_cast(bf16x2_t, b), acc, false);
}


#define XB_TMO      128
#define XB_XCNT(j)  (256  + 64 * (j))
#define XB_XSUB(j)  (1280 + 64 * (j))
#define XB_XGEN(j)  (2304 + 64 * (j))
#define XB_TOP      3328
#define XB_TOPGEN   3392
#define XCD_BAR_WORDS 3456
#define XB_SPIN_CAP (1u << 18)
DI unsigned xb_ld(unsigned* p)              { return __hip_atomic_load(p, __ATOMIC_RELAXED, __HIP_MEMORY_SCOPE_AGENT); }
DI unsigned xb_add(unsigned* p, unsigned v) { return __hip_atomic_fetch_add(p, v, __ATOMIC_RELAXED, __HIP_MEMORY_SCOPE_AGENT); }
DI unsigned xb_xcc_id() { return (unsigned)__builtin_amdgcn_s_getreg((3 << 11) | 20) & 0xFu; }
#define XB_SPIN(cond, bar) do { unsigned _sp = 0; while (cond) { __builtin_amdgcn_s_sleep(1); \
    if ((++_sp & 255u) == 0u) { if (xb_ld(&(bar)[XB_TMO])) break; if (_sp > XB_SPIN_CAP) { atomicAdd(&(bar)[XB_TMO], 1u); break; } } } } while (0)
struct XcdBarrier { unsigned* bar; unsigned x; volatile LAS unsigned* st; };
DI XcdBarrier xcd_barrier_post(unsigned* bar, volatile LAS unsigned* st) {
  XcdBarrier b; b.bar = bar; b.x = xb_xcc_id(); b.st = st;
  if (threadIdx.x == 0) (void)xb_add(&bar[XB_XCNT(b.x)], 1u);
  return b;
}
DI void xcd_barrier_complete(unsigned* bar, unsigned x, unsigned& nloc, unsigned& nx) {
  const unsigned G = gridDim.x * gridDim.y * gridDim.z;
  unsigned sum, cnt, mine, sp = 0u;
  for (;;) {
    sum = 0u; cnt = 0u; mine = 0u;
#pragma unroll
    for (unsigned j = 0; j < 16; ++j) { const unsigned c = xb_ld(&bar[XB_XCNT(j)]); sum += c; cnt += (c > 0u) ? 1u : 0u; mine = (j == x) ? c : mine; }
    if (sum == G) break;
    __builtin_amdgcn_s_sleep(1);
    if ((++sp & 255u) == 0u) { if (xb_ld(&bar[XB_TMO])) break; if (sp > XB_SPIN_CAP) { atomicAdd(&bar[XB_TMO], 1u); break; } }
  }
  nloc = mine > 0u ? mine : 1u; nx = cnt > 0u ? cnt : 1u;
}
DI void xcd_barrier(const XcdBarrier& b) {
  asm volatile("s_waitcnt vmcnt(0)" ::: "memory");
  __syncthreads();
  if (threadIdx.x == 0) {
    unsigned* bar = b.bar;
    __builtin_amdgcn_s_waitcnt(0);
    unsigned nloc = b.st[0], nx = b.st[1];
    if (nloc == 0u) { xcd_barrier_complete(bar, b.x, nloc, nx); b.st[0] = nloc; b.st[1] = nx; }
    const unsigned old = xb_add(&bar[XB_XSUB(b.x)], 1u);
    const unsigned gen = old / nloc;
    if (old + 1u == (gen + 1u) * nloc) {
      __builtin_amdgcn_fence(__ATOMIC_RELEASE, "agent");
      asm volatile("s_waitcnt vmcnt(0)" ::: "memory");
      const unsigned og = xb_add(&bar[XB_TOP], 1u);
      const unsigned tg = og / nx;
      if (og + 1u == (tg + 1u) * nx) xb_add(&bar[XB_TOPGEN], 1u);
      else XB_SPIN(xb_ld(&bar[XB_TOPGEN]) == tg, bar);
      __builtin_amdgcn_fence(__ATOMIC_ACQUIRE, "agent");
      xb_add(&bar[XB_XGEN(b.x)], 1u);
      asm volatile("s_waitcnt vmcnt(0)" ::: "memory");
    } else {
      XB_SPIN(xb_ld(&bar[XB_XGEN(b.x)]) == gen, bar);
      __builtin_amdgcn_fence(__ATOMIC_ACQUIRE, "agent");
      asm volatile("s_waitcnt vmcnt(0)" ::: "memory");
    }
  }
  __syncthreads();
}

DI void prep_mod(const Params& p, int item, char* smem) {
  float* sc = (float*)smem;
  float* red = (float*)(smem + 24576);
  const int tid = (get_tid() & 255), col = tid & 31, kg = tid >> 5;
  const int n0 = item * 32;
  float acc[48];
#pragma unroll
  for (int b = 0; b < 48; ++b) acc[b] = 0.f;
  for (int kc = 0; kc < 1024; kc += 128) {
    f32x4 cv[6];
#pragma unroll
    for (int j2 = 0; j2 < 6; ++j2) {
      const int b = (tid >> 5) + 8 * j2;
      const float* cp = (b < 16) ? p.c_prompt + b * 1024 : p.c_sample + (b - 16) * 1024;
      cv[j2] = *(const f32x4*)(cp + kc + (tid & 31) * 4);
    }
    float wv[16];
#pragma unroll
    for (int i = 0; i < 16; ++i) wv[i] = p.w_ada[(size_t)(kc + kg * 16 + i) * 6144 + n0 + col];
    __syncthreads();
#pragma unroll
    for (int j2 = 0; j2 < 6; ++j2) {
      const int b = (tid >> 5) + 8 * j2;
#pragma unroll
      for (int e = 0; e < 4; ++e) {
        const float c = cv[j2][e];
        sc[((tid & 31) * 4 + e) * 48 + b] = c / (1.f + __expf(-c));
      }
    }
    __syncthreads();
#pragma unroll
    for (int i = 0; i < 16; ++i) {
      const int kk = kg * 16 + i;
      const float w = wv[i];
      const float4* s4 = (const float4*)(sc + kk * 48);
#pragma unroll
      for (int q = 0; q < 12; ++q) {
        const float4 sv = s4[q];
        acc[4 * q + 0] += sv.x * w; acc[4 * q + 1] += sv.y * w; acc[4 * q + 2] += sv.z * w; acc[4 * q + 3] += sv.w * w;
      }
    }
  }
  __syncthreads();
#pragma unroll
  for (int b = 0; b < 48; ++b) red[(kg * 48 + b) * 32 + col] = acc[b];
  __syncthreads();
  for (int i = tid; i < 1536; i += 256) {
    const int b = i >> 5, c = i & 31;
    float sum = 0.f;
#pragma unroll
    for (int g = 0; g < 8; ++g) sum += red[(g * 48 + b) * 32 + c];
    P_mod[b * 6144 + n0 + c] = sum + p.b_ada[n0 + c];
  }
}

DI void prep_transpose(const float* __restrict__ W, int N, u16* __restrict__ Wt, int tile, bool conv_perm, char* smem) {
  float* ts = (float*)smem;
  const int tid = (get_tid() & 255);
  const int nT = N >> 6;
  const int kt = tile / nT, nt = tile - kt * nT;
  __syncthreads();
#pragma unroll
  for (int j = 0; j < 4; ++j) {
    const int kr = (tid >> 4) + 16 * j, c4 = (tid & 15) * 4;
    const float4 v = *(const float4*)(W + (size_t)(kt * 64 + kr) * N + nt * 64 + c4);
    ts[kr * 65 + c4 + 0] = v.x; ts[kr * 65 + c4 + 1] = v.y; ts[kr * 65 + c4 + 2] = v.z; ts[kr * 65 + c4 + 3] = v.w;
  }
  __syncthreads();
  const int n = tid >> 2, k0 = (tid & 3) * 16;
  u32 w[8];
#pragma unroll
  for (int i = 0; i < 8; ++i) w[i] = pack2(ts[(k0 + 2 * i) * 65 + n], ts[(k0 + 2 * i + 1) * 65 + n]);
  int nn = nt * 64 + n;
  if (conv_perm && nn < 1024) { const int c = nn & 511, isb = nn >> 9; nn = (c >> 5) * 64 + isb * 32 + (c & 31); }
  uint4* dst = (uint4*)(Wt + (size_t)nn * 1024 + kt * 64 + k0);
  dst[0] = make_uint4(w[0], w[1], w[2], w[3]);
  dst[1] = make_uint4(w[4], w[5], w[6], w[7]);
}

DI void prep_convert(const float* __restrict__ src, u16* __restrict__ dst, size_t base) {
  const int tid = (get_tid() & 255);
#pragma unroll
  for (int j = 0; j < 4; ++j) {
    const size_t e = base + (size_t)(j * 256 + tid) * 8;
    const float4 a = *(const float4*)(src + e), b = *(const float4*)(src + e + 4);
    *(uint4*)(dst + e) = pack8(a, b);
  }
}


DI void prep_row_fp6(const float* __restrict__ src, unsigned char* __restrict__ dst, float* __restrict__ scl, int row, int lane) {
  const int l5 = lane & 31;
  const float* rp = src + (size_t)row * 1024;
  f32x4 v[8];
#pragma unroll
  for (int j = 0; j < 8; ++j) v[j] = *(const f32x4*)(rp + 128 * j + 4 * l5);
  float am = 0.f;
#pragma unroll
  for (int j = 0; j < 8; ++j) am = fmaxf(am, fmaxf(fmaxf(fabsf(v[j][0]), fabsf(v[j][1])), fmaxf(fabsf(v[j][2]), fabsf(v[j][3]))));
  am = xmax16(am); am = fmaxf(am, dpp_ror8(am)); am = fmaxf(am, dpp_ror4(am)); am = fmaxf(am, dpp_xor2(am)); am = fmaxf(am, dpp_xor1(am));
  const float sc = am > 0.f ? am * (1.f / 7.f) : 1.f;
  const float inv = 1.f / sc;
  f32x16 lo, hi;
#pragma unroll
  for (int m = 0; m < 16; ++m) { lo[m] = v[m >> 1][2 * (m & 1)] * inv; hi[m] = v[m >> 1][2 * (m & 1) + 1] * inv; }
  const u32x6 q = __builtin_amdgcn_cvt_scalef32_2xpk16_fp6_f32(lo, hi, 1.0f);
  unsigned char* rd = dst + (size_t)row * 768;
  *(u32x4*)(rd + 16 * l5) = u32x4{q[0], q[1], q[2], q[3]};
  *(u32x2*)(rd + 512 + 8 * l5) = u32x2{q[4], q[5]};
  if (l5 == 0) scl[row] = sc;
}

DI void prep_rope(const Params& p, int item) {
  const int idx = item * 256 + (get_tid() & 255);
  if (idx >= 2080 * 32) return;
  const int pos = idx >> 5, d = idx & 31;
  double inv = 1.0;
  for (int i = 0; i < d; ++i) inv *= 0.74989420933245582730;
  const double a = (double)pos * inv;
  const double n = rint(a * 0.63661977236758134308);
  const double r = (a - n * 1.57079632673412561417e+00) - n * 6.07710050650619224932e-11;
  const int q = ((int)n) & 3;
  const double r2 = r * r;
  const double sp = r * (1.0 + r2 * (-1.0 / 6 + r2 * (1.0 / 120 + r2 * (-1.0 / 5040 + r2 * (1.0 / 362880 + r2 * (-1.0 / 39916800 + r2 * (1.0 / 6227020800.0)))))));
  const double cp = 1.0 + r2 * (-0.5 + r2 * (1.0 / 24 + r2 * (-1.0 / 720 + r2 * (1.0 / 40320 + r2 * (-1.0 / 3628800 + r2 * (1.0 / 479001600.0 + r2 * (-1.0 / 87178291200.0)))))));
  double s, c;
  if (q == 0) { s = sp; c = cp; } else if (q == 1) { s = cp; c = -sp; } else if (q == 2) { s = -sp; c = -cp; } else { s = -cp; c = sp; }
  P_rope[idx] = make_float2((float)c, (float)s);
}

DI void phaseA(const Params& p, char* smem) {
  const int hbk = get_tid() >> 8;
  char* sm = smem + hbk * HB_LDS;
  const int total = 1894 + 4096;
  int nxt = 0;
  if (get_tid() == 0) nxt = (int)atomicAdd(P_counters + 32, 1u);
  for (;;) {
    __syncthreads();
    if (get_tid() == 0) *(volatile int*)(smem + SMEM_CTRL) = nxt;
    __syncthreads();
    const int pair = *(volatile int*)(smem + SMEM_CTRL);
    if (pair * 2 >= total) break;
    if (get_tid() == 0) nxt = (int)atomicAdd(P_counters + 32, 1u);
    const int item = pair * 2 + hbk;
    if (item < 192) prep_mod(p, item, sm);
    else if (item < 832) prep_transpose(p.w_in, 2560, P_win_t, item - 192, true, sm);
    else if (item < 1088) prep_transpose(p.w_out, 1024, P_wout_t, item - 832, false, sm);
    else if (item < 1600) prep_transpose(p.w_query, 2048, P_wq_t, item - 1088, false, sm);
    else if (item < 1632) prep_convert(p.sub_keys, P_sk, (size_t)(item - 1600) * 8192);
    else if (item < 1892) prep_rope(p, item - 1632);
    else if (item < 1894) {
      const int l = get_tid() & 255;
      if (item == 1892 && l < 64) {
        const float s1 = wave_sum(p.lam_q1[l] * p.lam_k1[l]);
        const float s2 = wave_sum(p.lam_q2[l] * p.lam_k2[l]);
        if (l == 0) P_misc[0] = expf(s1) - expf(s2) + LAM_INIT;
      }
      if (item == 1892 && l >= 64 && l < 128) {
        const float rep[16] = {0.125f, 0.25f, 0.375f, 0.5f, 0.75f, 1.0f, 1.25f, 1.5f, 1.75f, 2.0f, 2.5f, 3.0f, 3.5f, 4.0f, 5.0f, 7.0f};
        f32x16 lo, hi;
#pragma unroll
        for (int q = 0; q < 16; ++q) { lo[q] = (q & 1) ? -rep[q >> 1] : rep[q >> 1]; hi[q] = (q & 1) ? -rep[8 + (q >> 1)] : rep[8 + (q >> 1)]; }
        const u32x6 qq = __builtin_amdgcn_cvt_scalef32_2xpk16_fp6_f32(lo, hi, 1.0f);
        const f32x32 f = __builtin_amdgcn_cvt_scalef32_pk32_f32_fp6(qq, 1.0f);
        bool ok = true;
#pragma unroll
        for (int q = 0; q < 16; ++q) ok = ok && (f[2 * q] == lo[q]) && (f[2 * q + 1] == hi[q]);
        if (l == 64) P_misc[1] = ok ? 0.f : 1.f;
      }
    } else {
      const int it = item - 1894;
      const int tid = get_tid() & 255, lane = tid & 63, wave = tid >> 6;
      if (it < 2048) prep_row_fp6(p.u_tab, P_utab, P_usc, it * 8 + wave * 2 + (lane >> 5), lane);
      else prep_row_fp6(p.v_tab, P_vtab, P_vsc, (it - 2048) * 8 + wave * 2 + (lane >> 5), lane);
    }
  }
}

DI void phaseA2(const Params& p) {
  const int tid = get_tid(), lane = tid & 63;
  const int gw = (tid >> 6) * gridDim.x + blockIdx.x, nw = gridDim.x * 8;
  for (int tok0 = gw; tok0 < T; tok0 += 2 * nw) {
    f32x4 x[2][4];
    int tk[2];
#pragma unroll
    for (int u = 0; u < 2; ++u) {
      const int tok = tok0 + u * nw < T ? tok0 + u * nw : tok0;
      tk[u] = tok;
      const float* xr = tok < TP ? p.x_prompt + (size_t)tok * 1024 : p.x_sample + (size_t)(tok - TP) * 1024;
#pragma unroll
      for (int hf = 0; hf < 2; ++hf) {
        x[u][2 * hf] = *(const f32x4*)(xr + hf * 512 + lane * 8);
        x[u][2 * hf + 1] = *(const f32x4*)(xr + hf * 512 + lane * 8 + 4);
      }
    }
#pragma unroll
    for (int u = 0; u < 2; ++u) {
      const float* mr = P_mod + mod_row(tk[u]) * 6144;
#pragma unroll
      for (int hf = 0; hf < 2; ++hf) {
        const int c = hf * 512 + lane * 8;
        const f32x4 h0 = *(const f32x4*)(mr + c), h1 = *(const f32x4*)(mr + c + 4);
        const f32x4 s0 = *(const f32x4*)(mr + 1024 + c), s1 = *(const f32x4*)(mr + 1024 + c + 4);
        f32x4 a = x[u][2 * hf], b = x[u][2 * hf + 1];
#pragma unroll
        for (int e = 0; e < 4; ++e) { a[e] = a[e] * (1.f + s0[e]) + h0[e]; b[e] = b[e] * (1.f + s1[e]) + h1[e]; }
        *(u32x4*)(P_hb + (size_t)tk[u] * 1024 + c) = pack8v(a, b);
      }
    }
  }
}

namespace g8 {
constexpr int BK = 64, HALF = 128, HTB = HALF * BK * 2, KD = 1024;
DI int lds_byte(int r, int c) { const int st = (r >> 4) * 2 + (c >> 5), rr = r & 15, cc = c & 31, ob = rr * 64 + cc * 2; return st * 1024 + (ob ^ (((ob >> 9) & 1) << 5)); }
DI void stage_rc(int b, int& R, int& C) { const int st = b / 1024, sb = b % 1024, swz = sb ^ (((sb >> 9) & 1) << 5); R = (st >> 1) * 16 + swz / 64; C = (st & 1) * 32 + (swz % 64) / 2; }
DI void gemm256(const u16* __restrict__ A, const u16* __restrict__ Bt, int brow, int bcol, char* shm, f32x4 (&acc)[2][2][4][2]) {
  const int tid = get_tid();
  const int wid = __builtin_amdgcn_readfirstlane(tid >> 6), lane = tid & 63, wr = wid >> 2, wc = wid & 3, fr = lane & 15, fq = lane >> 4;
#define SA(b, h) (shm + ((b) * 2 + (h)) * HTB)
#define SB(b, h) (shm + (4 + (b) * 2 + (h)) * HTB)
#define STAGE(P, BASE, br, kt) do { const u16* _gb = (BASE) + ((size_t)(br) * KD + (size_t)(kt) * BK); \
    __builtin_amdgcn_global_load_lds((const GAS unsigned*)(_gb + toff0), (LAS unsigned*)((P) + tid * 16), 16, 0, 0); \
    __builtin_amdgcn_global_load_lds((const GAS unsigned*)(_gb + 64 * KD + toff0), (LAS unsigned*)((P) + tid * 16 + 8192), 16, 0, 0); } while (0)
#define LDA(dst, b, h) _Pragma("unroll") for (int m = 0; m < 4; ++m) _Pragma("unroll") for (int k = 0; k < 2; ++k) \
    dst[m][k] = *(const bf16x8*)(SA(b, h) + lds_byte(wr * 64 + m * 16 + fr, k * 32 + fq * 8))
#define LDB(dst, b, h) _Pragma("unroll") for (int n = 0; n < 2; ++n) _Pragma("unroll") for (int k = 0; k < 2; ++k) \
    dst[n][k] = *(const bf16x8*)(SB(b, h) + lds_byte(wc * 32 + n * 16 + fr, k * 32 + fq * 8))
#define MMA(ai, bj, At_, Bt_) do { __builtin_amdgcn_s_setprio(1); \
    _Pragma("unroll") for (int m = 0; m < 4; ++m) _Pragma("unroll") for (int n = 0; n < 2; ++n) _Pragma("unroll") for (int k = 0; k < 2; ++k) \
      acc[ai][bj][m][n] = __builtin_amdgcn_mfma_f32_16x16x32_bf16(At_[m][k], Bt_[n][k], acc[ai][bj][m][n], 0, 0, 0); \
    __builtin_amdgcn_s_setprio(0); } while (0)
#define WAIT_V(n) asm volatile("s_waitcnt vmcnt(" #n ")" ::: "memory")
#define WAIT_L(n) asm volatile("s_waitcnt lgkmcnt(" #n ")" ::: "memory")
#define BAR __builtin_amdgcn_s_barrier()
#define SCHED __builtin_amdgcn_sched_barrier(0)
#pragma unroll
  for (int a = 0; a < 2; ++a)
#pragma unroll
    for (int b = 0; b < 2; ++b)
#pragma unroll
      for (int m = 0; m < 4; ++m)
#pragma unroll
        for (int n = 0; n < 2; ++n) acc[a][b][m][n] = f32x4{0.f, 0.f, 0.f, 0.f};
  bf16x8 At[4][2], B0[2][2], B1[2][2];
  constexpr int nt = KD / BK;
  unsigned toff0;
  { int r_, c_; stage_rc(tid * 16, r_, c_); toff0 = (unsigned)(r_ * KD + c_); }
  STAGE(SB(0, 0), Bt, bcol, 0); STAGE(SA(0, 0), A, brow, 0);
  STAGE(SB(0, 1), Bt, bcol + HALF, 0); STAGE(SA(0, 1), A, brow + HALF, 0);
  if (wr == 1) BAR;
  WAIT_V(4); BAR;
  STAGE(SB(1, 0), Bt, bcol, 1); STAGE(SA(1, 0), A, brow, 1); STAGE(SB(1, 1), Bt, bcol + HALF, 1);
  WAIT_V(6); BAR;
#pragma unroll 1
  for (int t = 0; t < nt - 2; t += 2) {
    LDB(B0, 0, 0); SCHED; LDA(At, 0, 0); STAGE(SA(1, 1), A, brow + HALF, t + 1);
    WAIT_L(8); BAR; WAIT_L(0); MMA(0, 0, At, B0); BAR; SCHED;
    LDB(B1, 0, 1); STAGE(SB(0, 0), Bt, bcol, t + 2);
    BAR; WAIT_L(0); MMA(0, 1, At, B1); BAR;
    LDA(At, 0, 1); STAGE(SA(0, 0), A, brow, t + 2);
    BAR; WAIT_L(0); MMA(1, 0, At, B0); BAR; SCHED;
    STAGE(SB(0, 1), Bt, bcol + HALF, t + 2);
    WAIT_V(6); BAR; MMA(1, 1, At, B1); BAR;
    LDB(B0, 1, 0); SCHED; LDA(At, 1, 0); STAGE(SA(0, 1), A, brow + HALF, t + 2);
    WAIT_L(8); BAR; WAIT_L(0); MMA(0, 0, At, B0); BAR; SCHED;
    LDB(B1, 1, 1); STAGE(SB(1, 0), Bt, bcol, t + 3);
    BAR; WAIT_L(0); MMA(0, 1, At, B1); BAR;
    LDA(At, 1, 1); STAGE(SA(1, 0), A, brow, t + 3);
    BAR; WAIT_L(0); MMA(1, 0, At, B0); BAR; SCHED;
    STAGE(SB(1, 1), Bt, bcol + HALF, t + 3);
    WAIT_V(6); BAR; MMA(1, 1, At, B1); BAR;
  }
  { LDB(B0, 0, 0); LDA(At, 0, 0); STAGE(SA(1, 1), A, brow + HALF, nt - 1);
    BAR; WAIT_L(0); MMA(0, 0, At, B0); BAR;
    LDB(B1, 0, 1); BAR; WAIT_L(0); MMA(0, 1, At, B1); BAR;
    LDA(At, 0, 1); WAIT_V(4); BAR; WAIT_L(0); MMA(1, 0, At, B0); MMA(1, 1, At, B1); BAR; }
  { LDB(B0, 1, 0); LDA(At, 1, 0); WAIT_V(2); BAR; WAIT_L(0); MMA(0, 0, At, B0); BAR;
    LDB(B1, 1, 1); WAIT_V(0); BAR; WAIT_L(0); MMA(0, 1, At, B1); BAR;
    LDA(At, 1, 1); BAR; WAIT_L(0); MMA(1, 0, At, B0); MMA(1, 1, At, B1); BAR; }
  if (wr == 0) BAR;
#undef SA
#undef SB
#undef STAGE
#undef LDA
#undef LDB
#undef MMA
#undef WAIT_V
#undef WAIT_L
#undef BAR
#undef SCHED
}
}

DI bool unit_of(int L, int nM, int nN, int& pm, int& pn) {
  const int nwg = nM * nN;
  if (L >= nwg) return false;
  int wgid = L;
  { const int q = nwg / 8, r = nwg % 8, xcd = wgid % 8, off = wgid / 8; wgid = (xcd < r ? xcd * (q + 1) : r * (q + 1) + (xcd - r) * q) + off; }
  const int nig = 8 * nN, gid = wgid / nig, fm = gid * 8, gsz = (nM - fm) < 8 ? (nM - fm) : 8;
  pm = fm + ((wgid % nig) % gsz); pn = (wgid % nig) / gsz;
  return true;
}
DI void quad_to_lds_f32(const f32x4 (&acc)[2][2][4][2], int bj, char* smem) {
  const int tid = get_tid(), wid = tid >> 6, lane = tid & 63, wr = wid >> 2, wc = wid & 3, fr = lane & 15, fq = lane >> 4;
#pragma unroll
  for (int ai = 0; ai < 2; ++ai) {
    float* Ct = (float*)(smem + ai * HB_LDS);
#pragma unroll
    for (int m = 0; m < 4; ++m)
#pragma unroll
      for (int n = 0; n < 2; ++n)
        *(f32x4*)(Ct + (wc * 32 + n * 16 + fr) * 132 + wr * 64 + m * 16 + fq * 4) = acc[ai][bj][m][n];
  }
}

DI void gemm_tile(const u16* __restrict__ A, const u16* __restrict__ Bt, int m0, int n0, char* smem, f32x16 (&acc)[2][2], int khalf) {
  constexpr int KD = 1024, NK = KD / 128;
  const int tid = get_tid() & 255, lane = tid & 63, wave = tid >> 6, wm = wave >> 1, wn = wave & 1;
  const int r = lane & 31, h = lane >> 5;
  char* As = smem;
  char* Bs = smem + 18432;
  const int lrow = tid >> 3, kc = tid & 7;
  const u16* ag = A + (size_t)(m0 + lrow) * KD + kc * 8 + khalf * 512;
  const u16* bg = Bt + (size_t)(n0 + lrow) * KD + kc * 8 + khalf * 512;
  u32x4 ra0[4], rb0[4], ra1[4], rb1[4];
  {
#pragma unroll
    for (int j = 0; j < 4; ++j) {
      ra0[j] = *(const u32x4*)(ag + (size_t)j * 32 * KD);
      rb0[j] = *(const u32x4*)(bg + (size_t)j * 32 * KD);
    }
#pragma unroll
    for (int j = 0; j < 4; ++j) {
      ra1[j] = *(const u32x4*)(ag + (size_t)j * 32 * KD + 64);
      rb1[j] = *(const u32x4*)(bg + (size_t)j * 32 * KD + 64);
    }
  }
#pragma unroll
  for (int mi = 0; mi < 2; ++mi)
#pragma unroll
    for (int ni = 0; ni < 2; ++ni)
#pragma unroll
      for (int i = 0; i < 16; ++i) acc[mi][ni][i] = 0.f;
  const char* ap = As + (wm * 64 + r) * 144 + h * 16;
  const char* bp = Bs + (wn * 64 + r) * 144 + h * 16;
  char* aw = As + lrow * 144 + kc * 16;
  char* bw = Bs + lrow * 144 + kc * 16;
#define GEMM_STEP(RA, RB, KT)                                                                   \
  {                                                                                             \
    __syncthreads();                                                                            \
    _Pragma("unroll") for (int j = 0; j < 4; ++j) {  \
      *(u32x4*)(aw + j * 32 * 144) = RA[j];                                                     \
      *(u32x4*)(bw + j * 32 * 144) = RB[j];                                                     \
    }                                                                                           \
    __syncthreads();                                                                            \
    if ((KT) + 2 < NK) {                                                                        \
      _Pragma("unroll") for (int j = 0; j < 4; ++j) {                                           \
        RA[j] = *(const u32x4*)(ag + (size_t)j * 32 * KD + ((KT) + 2) * 64);                    \
        RB[j] = *(const u32x4*)(bg + (size_t)j * 32 * KD + ((KT) + 2) * 64);                    \
      }                                                                                         \
    }                                                                                           \
    __builtin_amdgcn_sched_barrier(0);                                                          \
    _Pragma("unroll") for (int ks = 0; ks < 4; ++ks) {                                          \
      const bf16x8 a0 = *(const bf16x8*)(ap + ks * 32), a1 = *(const bf16x8*)(ap + 32 * 144 + ks * 32); \
      const bf16x8 b0 = *(const bf16x8*)(bp + ks * 32), b1 = *(const bf16x8*)(bp + 32 * 144 + ks * 32); \
      acc[0][0] = MFMA32(a0, b0, acc[0][0]);                                                    \
      acc[0][1] = MFMA32(a0, b1, acc[0][1]);                                                    \
      acc[1][0] = MFMA32(a1, b0, acc[1][0]);                                                    \
      acc[1][1] = MFMA32(a1, b1, acc[1][1]);                                                    \
    }                                                                                           \
  }
#pragma unroll 1
  for (int kt = 0; kt < NK; kt += 2) {
    GEMM_STEP(ra0, rb0, kt)
    GEMM_STEP(ra1, rb1, kt + 1)
  }
#undef GEMM_STEP
}


DI void kadd(f32x16 (&acc)[2][2], char* smem, int hbk, int lt) {
  float* Pf = (float*)(smem + HB_LDS);
  const int lane = lt & 63, wave = lt >> 6;
  __syncthreads();
  if (hbk == 1) {
#pragma unroll
    for (int mi = 0; mi < 2; ++mi)
#pragma unroll
      for (int ni = 0; ni < 2; ++ni)
#pragma unroll
        for (int i = 0; i < 16; ++i) Pf[(wave * 64 + (mi * 2 + ni) * 16 + i) * 64 + lane] = acc[mi][ni][i];
  }
  __syncthreads();
  if (hbk == 0) {
#pragma unroll
    for (int mi = 0; mi < 2; ++mi)
#pragma unroll
      for (int ni = 0; ni < 2; ++ni)
#pragma unroll
        for (int i = 0; i < 16; ++i) acc[mi][ni][i] += Pf[(wave * 64 + (mi * 2 + ni) * 16 + i) * 64 + lane];
  }
}

DI bool leftover_quad(int q, int nM, int nN, int& pm, int& pn, int& ai, int& bj) {
  const int G = (int)gridDim.x, nwg = nM * nN, nfull = nwg / G, nl = nwg - nfull * G;
  if (q >= 4 * nl) return false;
  ai = (q >> 1) & 1; bj = q & 1;
  return unit_of(nfull * G + (q >> 2), nM, nN, pm, pn);
}

DI void b_rowpass(const Params& p, const float* Ct, int m0, int n0, int lt) {
#pragma unroll 2
    for (int it = 0; it < 4; ++it) {
      const int idx = it * 256 + lt;
      const int j = idx & 3, g = (idx >> 2) & 1, row = idx >> 3;
      const int grow = m0 + row;
      const float* cp = Ct + row * 132 + g * 64 + 8 * j;
      f32x4 x1a = *(const f32x4*)cp, x1b = *(const f32x4*)(cp + 4), x2a = *(const f32x4*)(cp + 32), x2b = *(const f32x4*)(cp + 36);
      const int vc = n0 + g * 64 + 8 * j;
      if (n0 < 1024) {
        const int ca = (vc >> 6) * 32 + 8 * j;
        const f32x4 ba0 = *(const f32x4*)(p.b_in + ca), ba1 = *(const f32x4*)(p.b_in + ca + 4);
        const f32x4 bb0 = *(const f32x4*)(p.b_in + 512 + ca), bb1 = *(const f32x4*)(p.b_in + 512 + ca + 4);
        f32x4 u0, u1;
#pragma unroll
        for (int e = 0; e < 4; ++e) {
          u0[e] = (x1a[e] + ba0[e]) / (1.f + __expf(-(x2a[e] + bb0[e])));
          u1[e] = (x1b[e] + ba1[e]) / (1.f + __expf(-(x2b[e] + bb1[e])));
        }
        *(u32x4*)(P_ub + (size_t)grow * 512 + ca) = pack8v(u0, u1);
        float* cs = nullptr;
        if (grow < TP) { const int s = grow & 2047; if (s >= 2018) cs = P_conv_prompt + ((size_t)(grow >> 11) * 30 + (s - 2018)) * 512 + ca; }
        else { const int rs = grow - TP, s = rs & 31; if (s >= 2) cs = P_conv_sample + ((size_t)(rs >> 5) * 30 + (s - 2)) * 512 + ca; }
        if (cs) { *(f32x4*)cs = u0; *(f32x4*)(cs + 4) = u1; }
      } else {
        const f32x4 b1a = *(const f32x4*)(p.b_in + vc), b1b = *(const f32x4*)(p.b_in + vc + 4);
        const f32x4 b2a = *(const f32x4*)(p.b_in + vc + 32), b2b = *(const f32x4*)(p.b_in + vc + 36);
#pragma unroll
        for (int e = 0; e < 4; ++e) { x1a[e] += b1a[e]; x1b[e] += b1b[e]; x2a[e] += b2a[e]; x2b[e] += b2b[e]; }
        if (n0 < 2048) {
          const int pos = grow < TP ? (grow & 2047) : 2048 + ((grow - TP) & 31);
          const f32x4* rp = (const f32x4*)(P_rope + pos * 32 + 8 * j);
          const f32x4 r0 = rp[0], r1 = rp[1], r2 = rp[2], r3 = rp[3];
          f32x4 o1a, o1b, o2a, o2b;
          o1a[0] = x1a[0] * r0[0] - x2a[0] * r0[1]; o2a[0] = x2a[0] * r0[0] + x1a[0] * r0[1];
          o1a[1] = x1a[1] * r0[2] - x2a[1] * r0[3]; o2a[1] = x2a[1] * r0[2] + x1a[1] * r0[3];
          o1a[2] = x1a[2] * r1[0] - x2a[2] * r1[1]; o2a[2] = x2a[2] * r1[0] + x1a[2] * r1[1];
          o1a[3] = x1a[3] * r1[2] - x2a[3] * r1[3]; o2a[3] = x2a[3] * r1[2] + x1a[3] * r1[3];
          o1b[0] = x1b[0] * r2[0] - x2b[0] * r2[1]; o2b[0] = x2b[0] * r2[0] + x1b[0] * r2[1];
          o1b[1] = x1b[1] * r2[2] - x2b[1] * r2[3]; o2b[1] = x2b[1] * r2[2] + x1b[1] * r2[3];
          o1b[2] = x1b[2] * r3[0] - x2b[2] * r3[1]; o2b[2] = x2b[2] * r3[0] + x1b[2] * r3[1];
          o1b[3] = x1b[3] * r3[2] - x2b[3] * r3[3]; o2b[3] = x2b[3] * r3[2] + x1b[3] * r3[3];
          x1a = o1a; x1b = o1b; x2a = o2a; x2b = o2b;
        }
        const bool isq = n0 < 1536, isk = !isq && n0 < 2048;
        const int col = vc - (isq ? 1024 : (isk ? 1536 : 2048));
        u16* db = (isq ? P_qb : (isk ? P_kb : P_vb)) + (size_t)grow * 512 + col;
        *(u32x4*)db = pack8v(x1a, x1b);
        *(u32x4*)(db + 32) = pack8v(x2a, x2b);
        if (!isq) {
          float* fo = (isk ? (grow < TP ? P_k_prompt + (size_t)grow * 512 : P_k_sample + (size_t)(grow - TP) * 512)
                           : (grow < TP ? P_v_prompt + (size_t)grow * 512 : P_v_sample + (size_t)(grow - TP) * 512)) + col;
          *(f32x4*)fo = x1a; *(f32x4*)(fo + 4) = x1b; *(f32x4*)(fo + 32) = x2a; *(f32x4*)(fo + 36) = x2b;
        }
      }
    }
}

DI void phaseB(const Params& p, char* smem) {
  const int nfull = (132 * 10) / (int)gridDim.x;
  for (int i = 0; i < nfull; ++i) {
    int pm, pn;
    if (!unit_of(i * (int)gridDim.x + (int)blockIdx.x, 132, 10, pm, pn)) break;
    f32x4 acc[2][2][4][2];
    __syncthreads();
    g8::gemm256(P_win_t, P_hb, pn * 256, pm * 256, smem, acc);
#pragma unroll
    for (int bj = 0; bj < 2; ++bj) {
      __syncthreads();
      quad_to_lds_f32(acc, bj, smem);
      __syncthreads();
      const int t2 = get_tid(), hbk = t2 >> 8;
      b_rowpass(p, (const float*)(smem + hbk * HB_LDS), pm * 256 + bj * 128, pn * 256 + hbk * 128, t2 & 255);
    }
  }
  for (int q = (int)blockIdx.x;; q += (int)gridDim.x) {
    int pm, pn, ai, bj;
    if (!leftover_quad(q, 132, 10, pm, pn, ai, bj)) break;
    {
      const int t2 = get_tid(), hbk = t2 >> 8, lt = t2 & 255, lane = lt & 63, wave = lt >> 6, wm = wave >> 1, wn = wave & 1, r = lane & 31, h = lane >> 5;
      char* sm = smem + hbk * HB_LDS;
      const int m0 = pm * 256 + ai * 128, n0 = pn * 256 + bj * 128;
      const bool act = hbk == 0;
      f32x16 acc[2][2];
      gemm_tile(P_hb, P_win_t, m0, n0, sm, acc, hbk);
      kadd(acc, smem, hbk, lt);
      __syncthreads();
      float* Ct = (float*)sm;
#pragma unroll
      for (int mi = 0; mi < 2; ++mi)
#pragma unroll
        for (int ni = 0; ni < 2; ++ni)
#pragma unroll
          for (int i = 0; i < 16; ++i) Ct[(wm * 64 + mi * 32 + crow(i, h)) * 132 + wn * 64 + ni * 32 + r] = acc[mi][ni][i];
      __syncthreads();
      if (act) b_rowpass(p, Ct, m0, n0, lt);
    }
  }
}

DI bf16x8 pack_frag(const f32x16& x, int s) {
  u32x4 o;
  if (s == 0)
    asm volatile("v_cvt_pk_bf16_f32 %0, %4, %5\n\tv_cvt_pk_bf16_f32 %1, %6, %7\n\tv_cvt_pk_bf16_f32 %2, %8, %9\n\tv_cvt_pk_bf16_f32 %3, %10, %11\n\ts_nop 1"
                 : "=&v"(o[0]), "=&v"(o[1]), "=&v"(o[2]), "=&v"(o[3])
                 : "v"(x[0]), "v"(x[1]), "v"(x[2]), "v"(x[3]), "v"(x[4]), "v"(x[5]), "v"(x[6]), "v"(x[7]));
  else
    asm volatile("v_cvt_pk_bf16_f32 %0, %4, %5\n\tv_cvt_pk_bf16_f32 %1, %6, %7\n\tv_cvt_pk_bf16_f32 %2, %8, %9\n\tv_cvt_pk_bf16_f32 %3, %10, %11\n\ts_nop 1"
                 : "=&v"(o[0]), "=&v"(o[1]), "=&v"(o[2]), "=&v"(o[3])
                 : "v"(x[8]), "v"(x[9]), "v"(x[10]), "v"(x[11]), "v"(x[12]), "v"(x[13]), "v"(x[14]), "v"(x[15]));
  return __builtin_bit_cast(bf16x8, o);
}

DI void attn_tile_compute(char* smem, int pm, const bf16x8 (&qf)[4], f32x16 (&O)[4], float& m_run, float& l_run, bool mask_hi, int lane) {
  const int r = lane & 31, h = lane >> 5;
  const char* Kp = smem + pm * 9216 + r * 144 + h * 16;
  f32x16 s0, s1;
#pragma unroll
  for (int i = 0; i < 16; ++i) { s0[i] = 0.f; s1[i] = 0.f; }
#pragma unroll
  for (int ks = 0; ks < 4; ++ks) {
    const bf16x8 k0 = *(const bf16x8*)(Kp + ks * 32), k1 = *(const bf16x8*)(Kp + 32 * 144 + ks * 32);
    s0 = MFMA32(k0, qf[ks], s0);
    s1 = MFMA32(k1, qf[ks], s1);
  }
  if (mask_hi) {
#pragma unroll
    for (int i = 0; i < 16; ++i) s1[i] = -INFINITY;
  }
  float mx = s0[0];
#pragma unroll
  for (int i = 1; i < 16; ++i) mx = fmaxf(mx, s0[i]);
#pragma unroll
  for (int i = 0; i < 16; ++i) mx = fmaxf(mx, s1[i]);
  mx = xmax32(mx);
  const float m_new = fmaxf(m_run, mx);
  const float c = 0.125f * 1.4426950408889634f;
  const float alpha = __builtin_amdgcn_exp2f((m_run - m_new) * c);
  const float mc = m_new * c;
  float rs = 0.f;
#pragma unroll
  for (int i = 0; i < 16; ++i) { s0[i] = __builtin_amdgcn_exp2f(s0[i] * c - mc); rs += s0[i]; }
#pragma unroll
  for (int i = 0; i < 16; ++i) { s1[i] = __builtin_amdgcn_exp2f(s1[i] * c - mc); rs += s1[i]; }
  rs = xsum32(rs);
  l_run = l_run * alpha + rs;
  if (__builtin_amdgcn_ballot_w64(m_new != m_run) != 0ull) {
#pragma unroll
    for (int d = 0; d < 4; ++d)
#pragma unroll
      for (int i = 0; i < 16; ++i) O[d][i] *= alpha;
  }
  m_run = m_new;
  bf16x8 pf[4];
  pf[0] = pack_frag(s0, 0); pf[1] = pack_frag(s0, 1); pf[2] = pack_frag(s1, 0); pf[3] = pack_frag(s1, 1);
  const int q4 = (lane & 15) >> 2, p4 = lane & 3, blk = (lane >> 4) & 1;
  const unsigned vbase = (unsigned)(size_t)(smem + 18432) + (4 * h + q4) * 320 + (16 * blk + 4 * p4) * 2;
  s16x4 va[8], vb[8];
#define TR_ISSUE(R, ADDR)                                                                                        \
  asm volatile("ds_read_b64_tr_b16 %0, %8\n\tds_read_b64_tr_b16 %1, %8 offset:2560\n\t"                          \
               "ds_read_b64_tr_b16 %2, %8 offset:64\n\tds_read_b64_tr_b16 %3, %8 offset:2624\n\t"                 \
               "ds_read_b64_tr_b16 %4, %8 offset:128\n\tds_read_b64_tr_b16 %5, %8 offset:2688\n\t"                \
               "ds_read_b64_tr_b16 %6, %8 offset:192\n\tds_read_b64_tr_b16 %7, %8 offset:2752"                    \
               : "=&v"(R[0]), "=&v"(R[1]), "=&v"(R[2]), "=&v"(R[3]), "=&v"(R[4]), "=&v"(R[5]), "=&v"(R[6]), "=&v"(R[7]) \
               : "v"(ADDR) : "memory")
#define TR_WAIT(R, N)                                                                                            \
  asm volatile("s_waitcnt lgkmcnt(" #N ")"                                                                       \
               : "+v"(R[0]), "+v"(R[1]), "+v"(R[2]), "+v"(R[3]), "+v"(R[4]), "+v"(R[5]), "+v"(R[6]), "+v"(R[7]) :: "memory")
#define PV_MFMA(R, KK)                                                                                           \
  O[0] = MFMA32(__builtin_shufflevector(R[0], R[1], 0, 1, 2, 3, 4, 5, 6, 7), pf[KK], O[0]);                      \
  O[1] = MFMA32(__builtin_shufflevector(R[2], R[3], 0, 1, 2, 3, 4, 5, 6, 7), pf[KK], O[1]);                      \
  O[2] = MFMA32(__builtin_shufflevector(R[4], R[5], 0, 1, 2, 3, 4, 5, 6, 7), pf[KK], O[2]);                      \
  O[3] = MFMA32(__builtin_shufflevector(R[6], R[7], 0, 1, 2, 3, 4, 5, 6, 7), pf[KK], O[3]);
  TR_ISSUE(va, vbase);
  TR_ISSUE(vb, vbase + 16 * 320);
  TR_WAIT(va, 8);
  PV_MFMA(va, 0)
  TR_ISSUE(va, vbase + 32 * 320);
  TR_WAIT(vb, 8);
  PV_MFMA(vb, 1)
  TR_ISSUE(vb, vbase + 48 * 320);
  TR_WAIT(va, 8);
  PV_MFMA(va, 2)
  TR_WAIT(vb, 0);
  PV_MFMA(vb, 3)
#undef TR_ISSUE
#undef TR_WAIT
#undef PV_MFMA
}

DI void attn_qk(const char* smem, int pm, const bf16x8 (&qf)[4], f32x16& s0, f32x16& s1, int lane) {
  const int r = lane & 31, h = lane >> 5;
  const char* Kp = smem + pm * 9216 + r * 144 + h * 16;
#pragma unroll
  for (int i = 0; i < 16; ++i) { s0[i] = 0.f; s1[i] = 0.f; }
#pragma unroll
  for (int ks = 0; ks < 4; ++ks) {
    const bf16x8 k0 = *(const bf16x8*)(Kp + ks * 32), k1 = *(const bf16x8*)(Kp + 32 * 144 + ks * 32);
    s0 = MFMA32(k0, qf[ks], s0);
    s1 = MFMA32(k1, qf[ks], s1);
  }
}
DI void attn_softmax_pv(char* smem, f32x16& s0, f32x16& s1, f32x16 (&O)[4], float& m_run, float& l_run, int lane) {
  const int h = lane >> 5;
  float mx = s0[0];
#pragma unroll
  for (int i = 1; i < 16; ++i) mx = fmaxf(mx, s0[i]);
#pragma unroll
  for (int i = 0; i < 16; ++i) mx = fmaxf(mx, s1[i]);
  mx = xmax32(mx);
  const float m_new = fmaxf(m_run, mx);
  const float c = 0.125f * 1.4426950408889634f;
  const float alpha = __builtin_amdgcn_exp2f((m_run - m_new) * c);
  const float mc = m_new * c;
  float rs = 0.f;
#pragma unroll
  for (int i = 0; i < 16; ++i) { s0[i] = __builtin_amdgcn_exp2f(s0[i] * c - mc); rs += s0[i]; }
#pragma unroll
  for (int i = 0; i < 16; ++i) { s1[i] = __builtin_amdgcn_exp2f(s1[i] * c - mc); rs += s1[i]; }
  rs = xsum32(rs);
  l_run = l_run * alpha + rs;
  if (__builtin_amdgcn_ballot_w64(m_new != m_run) != 0ull) {
#pragma unroll
    for (int d = 0; d < 4; ++d)
#pragma unroll
      for (int i = 0; i < 16; ++i) O[d][i] *= alpha;
  }
  m_run = m_new;
  bf16x8 pf[4];
  pf[0] = pack_frag(s0, 0); pf[1] = pack_frag(s0, 1); pf[2] = pack_frag(s1, 0); pf[3] = pack_frag(s1, 1);
  const int q4 = (lane & 15) >> 2, p4 = lane & 3, blk = (lane >> 4) & 1;
  const unsigned vbase = (unsigned)(size_t)(smem + 18432) + (4 * h + q4) * 320 + (16 * blk + 4 * p4) * 2;
  s16x4 va[8], vb[8];
#define TR_ISSUE(R, ADDR)                                                                                        \
  asm volatile("ds_read_b64_tr_b16 %0, %8\n\tds_read_b64_tr_b16 %1, %8 offset:2560\n\t"                          \
               "ds_read_b64_tr_b16 %2, %8 offset:64\n\tds_read_b64_tr_b16 %3, %8 offset:2624\n\t"                 \
               "ds_read_b64_tr_b16 %4, %8 offset:128\n\tds_read_b64_tr_b16 %5, %8 offset:2688\n\t"                \
               "ds_read_b64_tr_b16 %6, %8 offset:192\n\tds_read_b64_tr_b16 %7, %8 offset:2752"                    \
               : "=&v"(R[0]), "=&v"(R[1]), "=&v"(R[2]), "=&v"(R[3]), "=&v"(R[4]), "=&v"(R[5]), "=&v"(R[6]), "=&v"(R[7]) \
               : "v"(ADDR) : "memory")
#define TR_WAIT(R, N)                                                                                            \
  asm volatile("s_waitcnt lgkmcnt(" #N ")"                                                                       \
               : "+v"(R[0]), "+v"(R[1]), "+v"(R[2]), "+v"(R[3]), "+v"(R[4]), "+v"(R[5]), "+v"(R[6]), "+v"(R[7]) :: "memory")
#define PV_MFMA(R, KK)                                                                                           \
  O[0] = MFMA32(__builtin_shufflevector(R[0], R[1], 0, 1, 2, 3, 4, 5, 6, 7), pf[KK], O[0]);                      \
  O[1] = MFMA32(__builtin_shufflevector(R[2], R[3], 0, 1, 2, 3, 4, 5, 6, 7), pf[KK], O[1]);                      \
  O[2] = MFMA32(__builtin_shufflevector(R[4], R[5], 0, 1, 2, 3, 4, 5, 6, 7), pf[KK], O[2]);                      \
  O[3] = MFMA32(__builtin_shufflevector(R[6], R[7], 0, 1, 2, 3, 4, 5, 6, 7), pf[KK], O[3]);
  TR_ISSUE(va, vbase);
  TR_ISSUE(vb, vbase + 16 * 320);
  TR_WAIT(va, 8);
  PV_MFMA(va, 0)
  TR_ISSUE(va, vbase + 32 * 320);
  TR_WAIT(vb, 8);
  PV_MFMA(vb, 1)
  TR_ISSUE(vb, vbase + 48 * 320);
  TR_WAIT(va, 8);
  PV_MFMA(va, 2)
  TR_WAIT(vb, 0);
  PV_MFMA(vb, 3)
#undef TR_ISSUE
#undef TR_WAIT
#undef PV_MFMA
}

DI void attn_epilogue(const Params& p, char* smem, int qg, int pm, bool active, f32x16 (&O)[4], float l_run, size_t tok, int hh, int lane) {
  const int r = lane & 31, h = lane >> 5;
  __syncthreads();
  const float inv_l = 1.f / l_run;
  float* X = (float*)smem + qg * 4096;
  if (active && pm == 1) {
#pragma unroll
    for (int d = 0; d < 4; ++d)
#pragma unroll
      for (int i = 0; i < 16; ++i) X[(d * 32 + crow(i, h)) * 32 + r] = O[d][i] * inv_l;
  }
  __syncthreads();
  if (active && pm == 0) {
    const float lam = P_misc[0];
    float ssq = 0.f;
#pragma unroll
    for (int d = 0; d < 4; ++d)
#pragma unroll
      for (int i = 0; i < 16; ++i) {
        const float o = O[d][i] * inv_l - lam * X[(d * 32 + crow(i, h)) * 32 + r];
        O[d][i] = o; ssq += o * o;
      }
    ssq = xsum32(ssq);
    const float rms = rsqrtf(ssq * (1.f / 128.f) + LN_EPS) * (1.f - LAM_INIT);
    u16* dst = P_mix + tok * 1024 + 512 + hh * 128;
#pragma unroll
    for (int d = 0; d < 4; ++d)
#pragma unroll
      for (int g = 0; g < 4; ++g) {
        const int dv = d * 32 + 8 * g + 4 * h;
        const float4 sg = *(const float4*)(p.subln_g + dv);
        uint2 w;
        w.x = pack2(O[d][4 * g + 0] * rms * sg.x, O[d][4 * g + 1] * rms * sg.y);
        w.y = pack2(O[d][4 * g + 2] * rms * sg.z, O[d][4 * g + 3] * rms * sg.w);
        *(uint2*)(dst + dv) = w;
      }
  }
}

DI void attn_prompt_item(const Params& p, int b, int hh, int qp, char* smem) {
  const int tid = get_tid(), lane = tid & 63, wave = tid >> 6, qg = wave >> 1, pm = wave & 1;
  const int r = lane & 31, h = lane >> 5;
  const size_t tok0 = (size_t)b * 2048;
  const size_t tq = tok0 + qp * 128 + qg * 32 + r;
  bf16x8 qf[4];
  {
    const u16* qptr = P_qb + tq * 512 + (hh * 2 + pm) * 64 + h * 8;
#pragma unroll
    for (int ks = 0; ks < 4; ++ks) qf[ks] = *(const bf16x8*)(qptr + ks * 16);
  }
  f32x16 O[4];
#pragma unroll
  for (int d = 0; d < 4; ++d)
#pragma unroll
    for (int i = 0; i < 16; ++i) O[d][i] = 0.f;
  float m_run = -INFINITY, l_run = 0.f;
  const int my_last = qp * 2 + (qg >> 1), nkt = qp * 2 + 2;
  const int lrow = tid >> 5, cc = tid & 31;
  const u16* gsrc;
  int lds_off, lstride;
  if (cc < 16) { gsrc = P_kb + (tok0 + lrow) * 512 + hh * 128 + cc * 8; lds_off = (cc >> 3) * 9216 + lrow * 144 + (cc & 7) * 16; lstride = 144; }
  else { gsrc = P_vb + (tok0 + lrow) * 512 + hh * 128 + (cc - 16) * 8; lds_off = 18432 + lrow * 320 + (cc - 16) * 16; lstride = 320; }
  constexpr int IMG = 38912;
  const int my_last_s = __builtin_amdgcn_readfirstlane(my_last);
  u32x4 rg[4];
  {
    u32x4 r0[4];
#pragma unroll
    for (int j = 0; j < 4; ++j) { r0[j] = *(const u32x4*)(gsrc + (size_t)(16 * j) * 512); rg[j] = *(const u32x4*)(gsrc + (size_t)(64 + 16 * j) * 512); }
    __syncthreads();
#pragma unroll
    for (int j = 0; j < 4; ++j) { *(u32x4*)(smem + lds_off + 16 * j * lstride) = r0[j]; *(u32x4*)(smem + IMG + lds_off + 16 * j * lstride) = rg[j]; }
  }
  const u16* gnext = gsrc + (size_t)128 * 512;
  if (nkt > 2) {
#pragma unroll
    for (int j = 0; j < 4; ++j) rg[j] = *(const u32x4*)(gnext + (size_t)(16 * j) * 512);
    gnext += (size_t)64 * 512;
  }
  __syncthreads();
  f32x16 sa0, sa1, sb0, sb1;
  attn_qk(smem, pm, qf, sa0, sa1, lane);
  int o_cur = 0, o_nxt = IMG, o_fre = 2 * IMG;
#define ATTN_STEP(KT, SC0, SC1, SN0, SN1)                                                                        \
  {                                                                                                             \
    if ((KT) > 0) __syncthreads();        \
    if ((KT) + 2 < nkt) {                                                                                       \
      _Pragma("unroll") for (int j = 0; j < 4; ++j) *(u32x4*)(smem + o_fre + lds_off + 16 * j * lstride) = rg[j]; \
      if ((KT) + 3 < nkt) {                                                                                     \
        _Pragma("unroll") for (int j = 0; j < 4; ++j) rg[j] = *(const u32x4*)(gnext + (size_t)(16 * j) * 512);   \
        gnext += (size_t)64 * 512;                                                                              \
      }                                                                                                         \
    }                                                                                                           \
    if ((KT) + 1 < nkt && (KT) + 1 <= my_last_s) attn_qk(smem + o_nxt, pm, qf, SN0, SN1, lane);                 \
    __builtin_amdgcn_sched_barrier(0);                                                                          \
    if ((KT) <= my_last_s) attn_softmax_pv(smem + o_cur, SC0, SC1, O, m_run, l_run, lane);                      \
    { const int t_ = o_cur; o_cur = o_nxt; o_nxt = o_fre; o_fre = t_; }                                         \
  }
  for (int kt = 0; kt < nkt; kt += 2) {
    ATTN_STEP(kt, sa0, sa1, sb0, sb1)
    ATTN_STEP(kt + 1, sb0, sb1, sa0, sa1)
  }
#undef ATTN_STEP
  attn_epilogue(p, smem, qg, pm, true, O, l_run, tq, hh, lane);
}

DI void attn_sample_item(const Params& p, int b, int hh, char* smem) {
  const int tid = get_tid(), lane = tid & 63, wave = tid >> 6, qg = wave >> 1, pm = wave & 1;
  const int r = lane & 31, h = lane >> 5;
  const bool active = (qg == 0);
  const size_t tokq0 = (size_t)TP + (size_t)b * 32;
  const size_t tq = tokq0 + r;
  bf16x8 qf[4];
  {
    const u16* qptr = P_qb + tq * 512 + (hh * 2 + pm) * 64 + h * 8;
#pragma unroll
    for (int ks = 0; ks < 4; ++ks) qf[ks] = *(const bf16x8*)(qptr + ks * 16);
  }
  f32x16 O[4];
#pragma unroll
  for (int d = 0; d < 4; ++d)
#pragma unroll
    for (int i = 0; i < 16; ++i) O[d][i] = 0.f;
  float m_run = -INFINITY, l_run = 0.f;
  const int lrow = tid >> 5, cc = tid & 31;
  const float* fsrc;
  const u16* bsrc;
  int lds_off, lstride;
  if (cc < 16) {
    fsrc = p.cache_k + ((size_t)b * 2048 + lrow) * 512 + hh * 128 + cc * 8;
    bsrc = P_kb + (tokq0 + lrow) * 512 + hh * 128 + cc * 8;
    lds_off = (cc >> 3) * 9216 + lrow * 144 + (cc & 7) * 16; lstride = 144;
  } else {
    fsrc = p.cache_v + ((size_t)b * 2048 + lrow) * 512 + hh * 128 + (cc - 16) * 8;
    bsrc = P_vb + (tokq0 + lrow) * 512 + hh * 128 + (cc - 16) * 8;
    lds_off = 18432 + lrow * 320 + (cc - 16) * 16; lstride = 320;
  }
  f32x4 rf[8];
#pragma unroll
  for (int j = 0; j < 4; ++j) {
    rf[2 * j] = *(const f32x4*)(fsrc + (size_t)(16 * j) * 512);
    rf[2 * j + 1] = *(const f32x4*)(fsrc + (size_t)(16 * j) * 512 + 4);
  }
  for (int kt = 0; kt <= 32; ++kt) {
    __syncthreads();
    if (kt < 32) {
#pragma unroll
      for (int j = 0; j < 4; ++j) *(u32x4*)(smem + lds_off + 16 * j * lstride) = pack8v(rf[2 * j], rf[2 * j + 1]);
    } else {
#pragma unroll
      for (int j = 0; j < 4; ++j) {
        u32x4 v = {0u, 0u, 0u, 0u};
        if (j < 2) v = *(const u32x4*)(bsrc + (size_t)(16 * j) * 512);
        *(u32x4*)(smem + lds_off + 16 * j * lstride) = v;
      }
    }
    __syncthreads();
    if (kt + 1 < 32) {
#pragma unroll
      for (int j = 0; j < 4; ++j) {
        rf[2 * j] = *(const f32x4*)(fsrc + (size_t)((kt + 1) * 64 + 16 * j) * 512);
        rf[2 * j + 1] = *(const f32x4*)(fsrc + (size_t)((kt + 1) * 64 + 16 * j) * 512 + 4);
      }
    }
    __builtin_amdgcn_sched_barrier(0);
    if (active) attn_tile_compute(smem, pm, qf, O, m_run, l_run, kt == 32, lane);
  }
  attn_epilogue(p, smem, qg, pm, active, O, l_run, tq, hh, lane);
}

DI void conv_item(const Params& p, int ci, char* smem) {
  const int tid = get_tid(), lane = tid & 63, wave = tid >> 6;
  const bool sample = ci >= 1024;
  const int b = sample ? ci - 1024 : ci >> 6;
  const int s0 = sample ? 0 : (ci & 63) * 32;
  const size_t tokbase = sample ? (size_t)TP + (size_t)b * 32 : (size_t)b * 2048;
  const float* hist = p.cache_conv + (size_t)b * 30 * 512;
  float* U = (float*)smem;
  float cw[31];
#pragma unroll
  for (int j = 0; j < 31; ++j) cw[j] = p.w_dw[j * 512 + tid];
  const float cbias = p.b_dw[tid];
  {
    u32x4 st[8];
#pragma unroll
    for (int it = 0; it < 8; ++it) {
      const int c = it * 512 + tid;
      const int rr = c >> 6, ch = c & 63;
      const int s = s0 - 30 + rr;
      u32x4 v = {0u, 0u, 0u, 0u};
      if (c < 62 * 64) {
        if (s >= 0) v = *(const u32x4*)(P_ub + (tokbase + s) * 512 + ch * 8);
        else if (sample) {
          const float* hp = hist + (30 + s) * 512 + ch * 8;
          v = pack8v(*(const f32x4*)hp, *(const f32x4*)(hp + 4));
        }
      }
      st[it] = v;
    }
    __syncthreads();
#pragma unroll
    for (int it = 0; it < 8; ++it) {
      const int c = it * 512 + tid;
      if (c < 62 * 64) {
        float* d = U + (c >> 6) * 512 + (c & 63) * 8;
        *(f32x4*)d = f32x4{bf_lo(st[it][0]), bf_hi(st[it][0]), bf_lo(st[it][1]), bf_hi(st[it][1])};
        *(f32x4*)(d + 4) = f32x4{bf_lo(st[it][2]), bf_hi(st[it][2]), bf_lo(st[it][3]), bf_hi(st[it][3])};
      }
    }
  }
  __syncthreads();
  {
    float cacc[32];
#pragma unroll
    for (int i = 0; i < 32; ++i) cacc[i] = cbias;
#pragma unroll
    for (int r = 0; r < 62; ++r) {
      const float u = U[r * 512 + tid];
#pragma unroll
      for (int i = 0; i < 32; ++i)
        if (r - i >= 0 && r - i <= 30) cacc[i] += cw[r - i] * u;
    }
    __syncthreads();
#pragma unroll
    for (int i = 0; i < 32; ++i) U[i * 512 + tid] = cacc[i];
  }
  __syncthreads();
  const int c0 = lane * 8;
  float acc[4][8];
#pragma unroll
  for (int i = 0; i < 4; ++i) {
    const float* yp = U + (wave * 4 + i) * 512 + c0;
    const f32x4 a0 = *(const f32x4*)yp, a1 = *(const f32x4*)(yp + 4);
#pragma unroll
    for (int e = 0; e < 4; ++e) { acc[i][e] = a0[e]; acc[i][4 + e] = a1[e]; }
  }
  float gg[8], gb[8];
  {
    const f32x4 g0 = *(const f32x4*)(p.conv_ln_g + c0), g1 = *(const f32x4*)(p.conv_ln_g + c0 + 4);
    const f32x4 e0 = *(const f32x4*)(p.conv_ln_b + c0), e1 = *(const f32x4*)(p.conv_ln_b + c0 + 4);
#pragma unroll
    for (int e = 0; e < 4; ++e) { gg[e] = g0[e]; gg[4 + e] = g1[e]; gb[e] = e0[e]; gb[4 + e] = e1[e]; }
  }
#pragma unroll
  for (int i = 0; i < 4; ++i) {
    float s = 0.f;
#pragma unroll
    for (int c = 0; c < 8; ++c) s += acc[i][c];
    const float mu = wave_sum(s) * (1.f / 512.f);
    float v = 0.f;
#pragma unroll
    for (int c = 0; c < 8; ++c) { acc[i][c] -= mu; v += acc[i][c] * acc[i][c]; }
    const float rstd = rsqrtf(wave_sum(v) * (1.f / 512.f) + LN_EPS);
    float y[8];
#pragma unroll
    for (int c = 0; c < 8; ++c) {
      const float t = acc[i][c] * rstd * gg[c] + gb[c];
      y[c] = t / (1.f + __expf(-t));
    }
    u32x4 w;
    w[0] = pack2(y[0], y[1]); w[1] = pack2(y[2], y[3]); w[2] = pack2(y[4], y[5]); w[3] = pack2(y[6], y[7]);
    *(u32x4*)(P_mix + (tokbase + s0 + wave * 4 + i) * 1024 + c0) = w;
  }
}

DI void phaseC(const Params& p, char* smem) {
  const int total = 128 + 1024 + 1056;
  int nxt = 0;
  if (get_tid() == 0) nxt = (int)atomicAdd(P_counters, 1u);
  for (;;) {
    __syncthreads();
    if (get_tid() == 0) *(volatile int*)(smem + SMEM_CTRL) = nxt;
    __syncthreads();
    const int item = *(volatile int*)(smem + SMEM_CTRL);
    if (item >= total) break;
    if (get_tid() == 0) nxt = (int)atomicAdd(P_counters, 1u);
    if (item < 128) attn_sample_item(p, item >> 2, item & 3, smem);
    else if (item < 1152) { const int i = item - 128; const int qp = 15 - (i >> 6), bh = i & 63; attn_prompt_item(p, bh >> 2, bh & 3, qp, smem); }
    else conv_item(p, item - 1152, smem);
  }
}

DI void d_rowstore(const Params& p, const float* Ct, int m0, int n0, int lt) {
  const int c8 = (lt & 15) * 8;
  const f32x4 bo0 = *(const f32x4*)(p.b_out + n0 + c8), bo1 = *(const f32x4*)(p.b_out + n0 + c8 + 4);
#pragma unroll
  for (int it = 0; it < 8; ++it) {
    const int row = it * 16 + (lt >> 4);
    f32x4 a = *(const f32x4*)(Ct + row * 132 + c8), b = *(const f32x4*)(Ct + row * 132 + c8 + 4);
#pragma unroll
    for (int e = 0; e < 4; ++e) { a[e] += bo0[e]; b[e] += bo1[e]; }
    *(u32x4*)(P_r + (size_t)(m0 + row) * 1024 + n0 + c8) = pack8v(a, b);
  }
}
DI void phaseD(const Params& p, char* smem) {
  const int nfull = (132 * 4) / (int)gridDim.x;
  for (int i = 0; i < nfull; ++i) {
    int pm, pn;
    if (!unit_of(i * (int)gridDim.x + (int)blockIdx.x, 132, 4, pm, pn)) break;
    f32x4 acc[2][2][4][2];
    __syncthreads();
    g8::gemm256(P_wout_t, P_mix, pn * 256, pm * 256, smem, acc);
#pragma unroll
    for (int bj = 0; bj < 2; ++bj) {
      __syncthreads();
      quad_to_lds_f32(acc, bj, smem);
      __syncthreads();
      const int t2 = get_tid(), hbk = t2 >> 8, lt = t2 & 255;
      d_rowstore(p, (const float*)(smem + hbk * HB_LDS), pm * 256 + bj * 128, pn * 256 + hbk * 128, lt);
    }
  }
  for (int q = (int)blockIdx.x;; q += (int)gridDim.x) {
    int pm, pn, ai, bj;
    if (!leftover_quad(q, 132, 4, pm, pn, ai, bj)) break;
    {
      const int t2 = get_tid(), hbk = t2 >> 8, lt = t2 & 255, lane = lt & 63, wave = lt >> 6, wm = wave >> 1, wn = wave & 1, r = lane & 31, h = lane >> 5;
      char* sm = smem + hbk * HB_LDS;
      const int m0 = pm * 256 + ai * 128, n0 = pn * 256 + bj * 128;
      const bool act = hbk == 0;
      f32x16 acc[2][2];
      gemm_tile(P_mix, P_wout_t, m0, n0, sm, acc, hbk);
      kadd(acc, smem, hbk, lt);
      __syncthreads();
      float* Ct = (float*)sm;
#pragma unroll
      for (int mi = 0; mi < 2; ++mi)
#pragma unroll
        for (int ni = 0; ni < 2; ++ni)
#pragma unroll
          for (int i = 0; i < 16; ++i) Ct[(wm * 64 + mi * 32 + crow(i, h)) * 132 + wn * 64 + ni * 32 + r] = acc[mi][ni][i];
      __syncthreads();
      if (act) d_rowstore(p, Ct, m0, n0, lt);
    }
  }
}

DI void phaseE(const Params& p) {
  const int tid = get_tid(), lane = tid & 63;
  const int gw = (tid >> 6) * gridDim.x + blockIdx.x, nw = gridDim.x * 8;
  for (int tok0 = gw; tok0 < T; tok0 += 2 * nw) {
    float v[2][16];
    int tk[2];
#pragma unroll
    for (int u = 0; u < 2; ++u) {
      const int tok = tok0 + u * nw < T ? tok0 + u * nw : tok0;
      tk[u] = tok;
      const u16* rr = P_r + (size_t)tok * 1024;
      const float* xr = tok < TP ? p.x_prompt + (size_t)tok * 1024 : p.x_sample + (size_t)(tok - TP) * 1024;
      const float* gr = P_mod + mod_row(tok) * 6144 + 2048;
#pragma unroll
      for (int hf = 0; hf < 2; ++hf) {
        const int c = hf * 512 + lane * 8;
        const u32x4 rw = *(const u32x4*)(rr + c);
        f32x4 a, b;
        a[0] = bf_lo(rw[0]); a[1] = bf_hi(rw[0]); a[2] = bf_lo(rw[1]); a[3] = bf_hi(rw[1]);
        b[0] = bf_lo(rw[2]); b[1] = bf_hi(rw[2]); b[2] = bf_lo(rw[3]); b[3] = bf_hi(rw[3]);
        const f32x4 xa = *(const f32x4*)(xr + c), xb = *(const f32x4*)(xr + c + 4);
        const f32x4 ga = *(const f32x4*)(gr + c), gb = *(const f32x4*)(gr + c + 4);
#pragma unroll
        for (int e = 0; e < 4; ++e) { v[u][hf * 8 + e] = ALPHA * xa[e] + ga[e] * a[e]; v[u][hf * 8 + 4 + e] = ALPHA * xb[e] + gb[e] * b[e]; }
      }
    }
#pragma unroll
    for (int u = 0; u < 2; ++u) {
      const int tok = tk[u];
      const float* mr = P_mod + mod_row(tok) * 6144;
      float s = 0.f;
#pragma unroll
      for (int i = 0; i < 16; ++i) s += v[u][i];
      const float mu = wave_sum(s) * (1.f / 1024.f);
      float q = 0.f;
#pragma unroll
      for (int i = 0; i < 16; ++i) { v[u][i] -= mu; q += v[u][i] * v[u][i]; }
      const float rstd = rsqrtf(wave_sum(q) * (1.f / 1024.f) + LN_EPS);
#pragma unroll
      for (int hf = 0; hf < 2; ++hf) {
        const int c = hf * 512 + lane * 8;
        f32x4 y0, y1, h0, h1;
        const f32x4 g0 = *(const f32x4*)(p.ln1_g + c), g1 = *(const f32x4*)(p.ln1_g + c + 4);
        const f32x4 b0 = *(const f32x4*)(p.ln1_b + c), b1 = *(const f32x4*)(p.ln1_b + c + 4);
        const f32x4 sc0 = *(const f32x4*)(mr + 4096 + c), sc1 = *(const f32x4*)(mr + 4096 + c + 4);
        const f32x4 sh0 = *(const f32x4*)(mr + 3072 + c), sh1 = *(const f32x4*)(mr + 3072 + c + 4);
#pragma unroll
        for (int e = 0; e < 4; ++e) {
          y0[e] = v[u][hf * 8 + e] * rstd * g0[e] + b0[e];
          y1[e] = v[u][hf * 8 + 4 + e] * rstd * g1[e] + b1[e];
          h0[e] = y0[e] * (1.f + sc0[e]) + sh0[e];
          h1[e] = y1[e] * (1.f + sc1[e]) + sh1[e];
        }
        u32x4 yw;
        yw[0] = __builtin_bit_cast(u32, h16x2{(_Float16)y0[0], (_Float16)y0[1]}); yw[1] = __builtin_bit_cast(u32, h16x2{(_Float16)y0[2], (_Float16)y0[3]});
        yw[2] = __builtin_bit_cast(u32, h16x2{(_Float16)y1[0], (_Float16)y1[1]}); yw[3] = __builtin_bit_cast(u32, h16x2{(_Float16)y1[2], (_Float16)y1[3]});
        *(u32x4*)(P_y1 + (size_t)tok * 1024 + c) = yw;
        *(u32x4*)(P_h2 + (size_t)tok * 1024 + c) = pack8v(h0, h1);
      }
    }
  }
}

DI u32 make_key(float s, int idx) {
  u32 u = __float_as_uint(s);
  u ^= ((u32)((int)u >> 31)) | 0x80000000u;
  return (u & ~127u) | (u32)idx;
}
DI float key_val(u32 key) {
  const u32 kb = key & ~127u;
  return __uint_as_float(kb ^ ((~(u32)((int)kb >> 31)) | 0x80000000u));
}
#define CE_DESC(a, b) { const u32 _x = max(a, b); const u32 _n = min(a, b); a = _x; b = _n; }
DI void bitonic_merge16(u32 (&v)[16]) {
#pragma unroll
  for (int j = 8; j > 0; j >>= 1)
#pragma unroll
    for (int i = 0; i < 16; ++i) {
      const int l = i ^ j;
      if (l > i) CE_DESC(v[i], v[l]);
    }
}
DI void sort16(u32 (&v)[16]) {
  CE_DESC(v[0], v[13]); CE_DESC(v[1], v[12]); CE_DESC(v[2], v[15]); CE_DESC(v[3], v[14]); CE_DESC(v[4], v[8]); CE_DESC(v[5], v[6]); CE_DESC(v[7], v[11]); CE_DESC(v[9], v[10]);
  CE_DESC(v[0], v[5]); CE_DESC(v[1], v[7]); CE_DESC(v[2], v[9]); CE_DESC(v[3], v[4]); CE_DESC(v[6], v[13]); CE_DESC(v[8], v[14]); CE_DESC(v[10], v[15]); CE_DESC(v[11], v[12]);
  CE_DESC(v[0], v[1]); CE_DESC(v[2], v[3]); CE_DESC(v[4], v[5]); CE_DESC(v[6], v[8]); CE_DESC(v[7], v[9]); CE_DESC(v[10], v[11]); CE_DESC(v[12], v[13]); CE_DESC(v[14], v[15]);
  CE_DESC(v[0], v[2]); CE_DESC(v[1], v[3]); CE_DESC(v[4], v[10]); CE_DESC(v[5], v[11]); CE_DESC(v[6], v[7]); CE_DESC(v[8], v[9]); CE_DESC(v[12], v[14]); CE_DESC(v[13], v[15]);
  CE_DESC(v[1], v[2]); CE_DESC(v[3], v[12]); CE_DESC(v[4], v[6]); CE_DESC(v[5], v[7]); CE_DESC(v[8], v[10]); CE_DESC(v[9], v[11]); CE_DESC(v[13], v[14]);
  CE_DESC(v[1], v[4]); CE_DESC(v[2], v[6]); CE_DESC(v[5], v[8]); CE_DESC(v[7], v[10]); CE_DESC(v[9], v[13]); CE_DESC(v[11], v[14]);
  CE_DESC(v[2], v[4]); CE_DESC(v[3], v[6]); CE_DESC(v[9], v[12]); CE_DESC(v[11], v[13]);
  CE_DESC(v[3], v[5]); CE_DESC(v[6], v[8]); CE_DESC(v[7], v[9]); CE_DESC(v[10], v[12]);
  CE_DESC(v[3], v[4]); CE_DESC(v[5], v[6]); CE_DESC(v[7], v[8]); CE_DESC(v[9], v[10]); CE_DESC(v[11], v[12]);
  CE_DESC(v[6], v[7]); CE_DESC(v[8], v[9]);
}
DI void merge_top16(u32 (&a)[16], const u32 (&b)[16]) {
#pragma unroll
  for (int i = 0; i < 16; ++i) a[i] = max(a[i], b[15 - i]);
  bitonic_merge16(a);
}

DI void f_epilogue(const Params& p, char* sm, int m0, int hp, int lt) {
  const int lane = lt & 63, wave = lt >> 6, wm = wave >> 1, wn = wave & 1;
  const int r = lane & 31, h = lane >> 5;
  u32* PL = (u32*)sm;
  char* Qs = sm + 32768;
  {
    bf16x8 ska[8], skb[8];
    {
      const u16* skp = P_sk + ((size_t)hp * 128 + wm * 64 + r) * 128 + h * 8;
#pragma unroll
      for (int ks = 0; ks < 8; ++ks) { ska[ks] = *(const bf16x8*)(skp + ks * 16); skb[ks] = *(const bf16x8*)(skp + 32 * 128 + ks * 16); }
    }
    __syncthreads();
    f32x16 st[2][2];
#pragma unroll
    for (int a = 0; a < 2; ++a)
#pragma unroll
      for (int b = 0; b < 2; ++b)
#pragma unroll
        for (int i = 0; i < 16; ++i) st[a][b][i] = 0.f;
    {
      const char* qp = Qs + (wn * 64 + r) * 272 + h * 16;
#pragma unroll
      for (int ks = 0; ks < 8; ++ks) {
        const bf16x8 b0 = *(const bf16x8*)(qp + ks * 32), b1 = *(const bf16x8*)(qp + 32 * 272 + ks * 32);
        st[0][0] = MFMA32(ska[ks], b0, st[0][0]);
        st[0][1] = MFMA32(ska[ks], b1, st[0][1]);
        st[1][0] = MFMA32(skb[ks], b0, st[1][0]);
        st[1][1] = MFMA32(skb[ks], b1, st[1][1]);
      }
    }
#pragma unroll
    for (int nt = 0; nt < 2; ++nt) {
      u32 va[16], vb[16];
#pragma unroll
      for (int i = 0; i < 16; ++i) {
        va[i] = make_key(st[0][nt][i], wm * 64 + crow(i, h));
        vb[i] = make_key(st[1][nt][i], wm * 64 + 32 + crow(i, h));
      }
      sort16(va);
      sort16(vb);
      merge_top16(va, vb);
      u32* dst = PL + ((wn * 64 + nt * 32 + r) * 4 + wm * 2 + h) * 16;
#pragma unroll
      for (int q = 0; q < 4; ++q) *(uint4*)(dst + 4 * q) = make_uint4(va[4 * q], va[4 * q + 1], va[4 * q + 2], va[4 * q + 3]);
    }
    __syncthreads();
    if (lt < 128) {
      u32 l0[16], l1[16], l2[16], l3[16];
      const u32* src = PL + lt * 64;
#pragma unroll
      for (int q = 0; q < 4; ++q) {
        const uint4 a = *(const uint4*)(src + 4 * q), b = *(const uint4*)(src + 16 + 4 * q);
        const uint4 c = *(const uint4*)(src + 32 + 4 * q), d = *(const uint4*)(src + 48 + 4 * q);
        l0[4 * q] = a.x; l0[4 * q + 1] = a.y; l0[4 * q + 2] = a.z; l0[4 * q + 3] = a.w;
        l1[4 * q] = b.x; l1[4 * q + 1] = b.y; l1[4 * q + 2] = b.z; l1[4 * q + 3] = b.w;
        l2[4 * q] = c.x; l2[4 * q + 1] = c.y; l2[4 * q + 2] = c.z; l2[4 * q + 3] = c.w;
        l3[4 * q] = d.x; l3[4 * q + 1] = d.y; l3[4 * q + 2] = d.z; l3[4 * q + 3] = d.w;
      }
      merge_top16(l0, l1);
      merge_top16(l2, l3);
      merge_top16(l0, l2);
      u32* dst = P_topk + (size_t)(m0 + lt) * 256 + hp * 16;
#pragma unroll
      for (int q = 0; q < 4; ++q) *(uint4*)(dst + 4 * q) = make_uint4(l0[4 * q], l0[4 * q + 1], l0[4 * q + 2], l0[4 * q + 3]);
    }
  }
}

DI void phaseF(const Params& p, char* smem) {
  const int nfull = (132 * 8) / (int)gridDim.x;
  for (int i = 0; i < nfull; ++i) {
    int pm, pn;
    if (!unit_of(i * (int)gridDim.x + (int)blockIdx.x, 132, 8, pm, pn)) break;
    f32x4 acc[2][2][4][2];
    __syncthreads();
    g8::gemm256(P_wq_t, P_h2, pn * 256, pm * 256, smem, acc);
#pragma unroll
    for (int bj = 0; bj < 2; ++bj) {
      __syncthreads();
      {
        const int tid = get_tid(), wid = tid >> 6, lane = tid & 63, wr = wid >> 2, wc = wid & 3, fr = lane & 15, fq = lane >> 4;
#pragma unroll
        for (int ai = 0; ai < 2; ++ai) {
          char* Qs = smem + ai * HB_LDS + 32768;
#pragma unroll
          for (int m = 0; m < 4; ++m)
#pragma unroll
            for (int n = 0; n < 2; ++n)
              *(u32x2*)(Qs + (wc * 32 + n * 16 + fr) * 272 + (wr * 64 + m * 16 + fq * 4) * 2) =
                  u32x2{pack2(acc[ai][bj][m][n][0], acc[ai][bj][m][n][1]), pack2(acc[ai][bj][m][n][2], acc[ai][bj][m][n][3])};
        }
      }
      const int t2 = get_tid(), hbk = t2 >> 8;
      f_epilogue(p, smem + hbk * HB_LDS, pm * 256 + bj * 128, pn * 2 + hbk, t2 & 255);
    }
  }
  for (int q = (int)blockIdx.x;; q += (int)gridDim.x) {
    int pm, pn, ai, bj;
    if (!leftover_quad(q, 132, 8, pm, pn, ai, bj)) break;
    {
      const int t2 = get_tid(), hbk = t2 >> 8, lt = t2 & 255, lane = lt & 63, wave = lt >> 6, wm = wave >> 1, wn = wave & 1, r = lane & 31, h = lane >> 5;
      char* sm = smem + hbk * HB_LDS;
      const int m0 = pm * 256 + ai * 128, n0 = pn * 256 + bj * 128;
      const bool act = hbk == 0;
      {
        f32x16 acc[2][2];
        gemm_tile(P_h2, P_wq_t, m0, n0, sm, acc, hbk);
      kadd(acc, smem, hbk, lt);
        char* Qs = sm + 32768;
        __syncthreads();
#pragma unroll
        for (int mi = 0; mi < 2; ++mi)
#pragma unroll
          for (int ni = 0; ni < 2; ++ni)
#pragma unroll
            for (int i = 0; i < 16; ++i)
              *(u16*)(Qs + (wm * 64 + mi * 32 + crow(i, h)) * 272 + (wn * 64 + ni * 32 + r) * 2) = (u16)f2bf(acc[mi][ni][i]);
      }
      if (act) f_epilogue(p, sm, m0, pn * 2 + bj, lt);
      else { __syncthreads(); __syncthreads(); }
    }
  }
}

__device__ const unsigned char kStairI[64] = {0, 0, 0, 0, 0, 0, 0, 0, 0, 0, 0, 0, 0, 0, 0, 0, 1, 1, 1, 1, 1, 1, 1, 1, 2, 2, 2, 2, 2, 3, 3, 3,
                                              3, 4, 4, 4, 5, 5, 6, 6, 7, 7, 8, 9, 10, 11, 12, 13, 14, 15, 0, 0, 0, 0, 0, 0, 0, 0, 0, 0, 0, 0, 0, 0};
__device__ const unsigned char kStairJ[64] = {0, 1, 2, 3, 4, 5, 6, 7, 8, 9, 10, 11, 12, 13, 14, 15, 0, 1, 2, 3, 4, 5, 6, 7, 0, 1, 2, 3, 4, 0, 1, 2,
                                              3, 0, 1, 2, 0, 1, 0, 1, 0, 1, 0, 0, 0, 0, 0, 0, 0, 0, 0, 0, 0, 0, 0, 0, 0, 0, 0, 0, 0, 0, 0, 0};

DI void phaseG1(const Params& p, char* smem) {
  const int tid = get_tid(), lane = tid & 63, wave = tid >> 6;
  const int gw = wave * gridDim.x + blockIdx.x, nw = gridDim.x * 8;
  char* wb = smem + wave * 5632;
  LAS u32* wtop = (LAS u32*)wb;
  LAS float* wcand = (LAS float*)(wb + 1024);
  LAS u32* we = (LAS u32*)(wb + 3072);
  LAS float* wg = (LAS float*)(wb + 3584);
  LAS float* wc = (LAS float*)(wb + 4096);
  LAS float* wsu = (LAS float*)(wb + 4608);
  LAS float* wsv = (LAS float*)(wb + 5120);
  const int si = kStairI[lane], sj = kStairJ[lane];
  const bool valid = lane < 50;
  u32x4 tkn = *(const u32x4*)(P_topk + (size_t)(gw < T ? gw : 0) * 256 + lane * 4);
  for (int tok = gw; tok < T; tok += nw) {
    *(LAS u32x4*)(wtop + lane * 4) = tkn;
    {
      const int ntok = tok + nw < T ? tok + nw : tok;
      tkn = *(const u32x4*)(P_topk + (size_t)ntok * 256 + lane * 4);
    }
    wave_lds_sync();
    float cand[8];
    u32 eid[8], ckey[8];
#pragma unroll
    for (int hd = 0; hd < 8; ++hd) {
      const u32 ka = wtop[(2 * hd) * 16 + si], kb = wtop[(2 * hd + 1) * 16 + sj];
      cand[hd] = valid ? key_val(ka) + key_val(kb) : -INFINITY;
      eid[hd] = (ka & 127u) * 128u + (kb & 127u);
      u32 ku = __float_as_uint(cand[hd]);
      ku ^= ((u32)((int)ku >> 31)) | 0x80000000u;
      ckey[hd] = (ku & ~63u) | (u32)(63 - lane);
      wcand[hd * 64 + lane] = __uint_as_float(ckey[hd]);
    }
    wave_lds_sync();
    int rank[8];
    float su_r[8], sv_r[8];
#pragma unroll
    for (int hd = 0; hd < 8; ++hd) { rank[hd] = 0; su_r[hd] = 0.f; sv_r[hd] = 0.f; }
#pragma unroll 1
    for (int j4 = 0; j4 < 13; ++j4) {
#pragma unroll
      for (int hd = 0; hd < 8; ++hd) {
        const u32x4 o = *(const LAS u32x4*)(wcand + hd * 64 + j4 * 4);
        const u32 m = ckey[hd];
        rank[hd] += (o[0] > m) ? 1 : 0;
        rank[hd] += (o[1] > m) ? 1 : 0;
        rank[hd] += (o[2] > m) ? 1 : 0;
        rank[hd] += (o[3] > m) ? 1 : 0;
      }
    }
#pragma unroll
    for (int hd = 0; hd < 8; ++hd) {
      const float mine = cand[hd];
      const bool sel = valid && rank[hd] < 16;
      const float mx = __uint_as_float((u32)__builtin_amdgcn_readfirstlane((int)__float_as_uint(mine)));
      const float ex = sel ? __expf(mine - mx) : 0.f;
      const float sm = wave_sum(ex);
      if (sel) {
        const int slot = hd * 16 + rank[hd];
        we[slot] = eid[hd]; wg[slot] = ex / sm;
        su_r[hd] = P_usc[eid[hd]]; sv_r[hd] = P_vsc[eid[hd]];
      }
    }
    wave_lds_sync();
    const int l5 = lane & 31, hv = lane >> 5;
    h16x2 hfp[16];
    {
      const u16* h2p = P_h2 + (size_t)tok * 1024 + 4 * l5;
#pragma unroll
      for (int j = 0; j < 8; ++j) {
        const uint2 w = *(const uint2*)(h2p + 128 * j);
        hfp[2 * j] = h16x2{(_Float16)bf_lo(w.x), (_Float16)bf_hi(w.x)};
        hfp[2 * j + 1] = h16x2{(_Float16)bf_lo(w.y), (_Float16)bf_hi(w.y)};
      }
    }
#pragma unroll 1
    for (int k0 = 0; k0 < 128; k0 += 32) {
      u32 es[16];
#pragma unroll
      for (int q = 0; q < 8; ++q) {
        const u32x4 e = *(const LAS u32x4*)(we + k0 + 4 * q);
        es[2 * q] = hv ? e[1] : e[0]; es[2 * q + 1] = hv ? e[3] : e[2];
      }
      u32x4 ra[16];
      u32x2 rb[16];
#pragma unroll
      for (int i = 0; i < 16; ++i) {
        const unsigned char* rp = P_utab + (size_t)es[i] * 768;
        ra[i] = *(const u32x4*)(rp + 16 * l5);
        rb[i] = *(const u32x2*)(rp + 512 + 8 * l5);
      }
      if (k0 == 0) {
#pragma unroll
        for (int hd = 0; hd < 8; ++hd)
          if (valid && rank[hd] < 16) { wsu[hd * 16 + rank[hd]] = su_r[hd]; wsv[hd * 16 + rank[hd]] = sv_r[hd]; }
      }
      float d[16];
#pragma unroll
      for (int i = 0; i < 16; ++i) {
        const h16x32 f = __builtin_amdgcn_cvt_scalef32_pk32_f16_fp6(u32x6{ra[i][0], ra[i][1], ra[i][2], ra[i][3], rb[i][0], rb[i][1]}, 1.0f);
        float acc0 = 0.f, acc1 = 0.f;
#pragma unroll
        for (int m = 0; m < 16; m += 2) {
          acc0 = __builtin_amdgcn_fdot2(h16x2{f[2 * m], f[2 * m + 1]}, hfp[m], acc0, false);
          acc1 = __builtin_amdgcn_fdot2(h16x2{f[2 * m + 2], f[2 * m + 3]}, hfp[m + 1], acc1, false);
        }
        d[i] = acc0 + acc1;
        if (i < 15) asm volatile("" : "+v"(ra[i + 1]) : "v"(d[i]));
      }
      float e8[8], e4[4], e2[2], e1s;
      {
        const bool up = (l5 & 16) != 0;
#pragma unroll
        for (int i = 0; i < 8; ++i) {
          const float send = up ? d[i] : d[i + 8], keep = up ? d[i + 8] : d[i];
          e8[i] = keep + __shfl_xor(send, 16);
        }
      }
      {
        const bool up = (l5 & 8) != 0;
#pragma unroll
        for (int i = 0; i < 4; ++i) {
          const float send = up ? e8[i] : e8[i + 4], keep = up ? e8[i + 4] : e8[i];
          e4[i] = keep + __shfl_xor(send, 8);
        }
      }
      {
        const bool up = (l5 & 4) != 0;
#pragma unroll
        for (int i = 0; i < 2; ++i) {
          const float send = up ? e4[i] : e4[i + 2], keep = up ? e4[i + 2] : e4[i];
          e2[i] = keep + __shfl_xor(send, 4);
        }
      }
      {
        const bool up = (l5 & 2) != 0;
        const float send = up ? e2[0] : e2[1], keep = up ? e2[1] : e2[0];
        e1s = keep + dpp_xor2(send);
      }
      e1s += dpp_xor1(e1s);
      if ((l5 & 1) == 0) {
        const int k = k0 + 2 * (l5 >> 1) + hv;
        const float a = e1s * wsu[k];
        wc[k] = 0.5f * a * (1.f + erff(a * 0.70710678118654752f)) * wg[k] * wsv[k];
      }
    }
    wave_lds_sync();
    {
      const u32x2 ev = *(const LAS u32x2*)(we + 2 * lane);
      const f32x2 cv = *(const LAS f32x2*)(wc + 2 * lane);
      const h16x2 ch = h16x2{(_Float16)(cv[0] * 1024.f), (_Float16)(cv[1] * 1024.f)};
      const u32 cw = __builtin_bit_cast(u32, ch);
      *(u32x2*)(P_elist + (size_t)tok * 128 + 2 * lane) = u32x2{ev[0] | (cw << 16), ev[1] | (cw & 0xffff0000u)};
    }
    wave_lds_sync();
  }
}

DI void phaseG2(const Params& p, char* smem) {
  const int tid = get_tid(), lane = tid & 63, wave = tid >> 6;
  const int gw = wave * gridDim.x + blockIdx.x, nw = gridDim.x * 8;
  char* wb = smem + wave * 5632;
  LAS u32* we = (LAS u32*)(wb + 3072);

  const int l5 = lane & 31, hv = lane >> 5;
  const int cb = 512 * hv + 4 * l5;
  f32x4 l2g[4], l2b[4];
#pragma unroll
  for (int j = 0; j < 4; ++j) { l2g[j] = *(const f32x4*)(p.ln2_g + cb + 128 * j); l2b[j] = *(const f32x4*)(p.ln2_b + cb + 128 * j); }
  u32x2 eln = *(const u32x2*)(P_elist + (size_t)(gw < T ? gw : 0) * 128 + 2 * lane);
  for (int tok = gw; tok < T; tok += nw) {
    *(LAS u32x2*)(we + 2 * lane) = eln;
    {
      const int ntok = tok + nw < T ? tok + nw : tok;
      eln = *(const u32x2*)(P_elist + (size_t)ntok * 128 + 2 * lane);
    }
    h16x4 yh[4];
    f32x4 g2v[4];
    {
      const _Float16* y1p = P_y1 + (size_t)tok * 1024 + cb;
      const float* g2p = P_mod + mod_row(tok) * 6144 + 5120 + cb;
#pragma unroll
      for (int j = 0; j < 4; ++j) { yh[j] = *(const h16x4*)(y1p + 128 * j); g2v[j] = *(const f32x4*)(g2p + 128 * j); }
    }
    wave_lds_sync();
    h16x2 ffh[16];
#pragma unroll
    for (int i = 0; i < 16; ++i) ffh[i] = h16x2{(_Float16)0.f, (_Float16)0.f};
#pragma unroll 1
    for (int k0 = 0; k0 < 128; k0 += 32) {
      u32 es[16];
#pragma unroll
      for (int q = 0; q < 8; ++q) {
        const u32x4 e = *(const LAS u32x4*)(we + k0 + 4 * q);
        es[2 * q] = hv ? e[1] : e[0]; es[2 * q + 1] = hv ? e[3] : e[2];
      }
      u32x4 ra[16];
      u32x2 rb[16];
#pragma unroll
      for (int i = 0; i < 16; ++i) {
        const unsigned char* rp = P_vtab + (size_t)(es[i] & 0xffffu) * 768;
        ra[i] = *(const u32x4*)(rp + 16 * l5);
        rb[i] = *(const u32x2*)(rp + 512 + 8 * l5);
      }
#pragma unroll
      for (int i = 0; i < 16; ++i) {
        const h16x32 f = __builtin_amdgcn_cvt_scalef32_pk32_f16_fp6(u32x6{ra[i][0], ra[i][1], ra[i][2], ra[i][3], rb[i][0], rb[i][1]}, 1.0f);
        const u32 ewd = es[i];
        const h16x2 ew = __builtin_bit_cast(h16x2, ewd);
        const h16x2 cc = h16x2{ew[1], ew[1]};
#pragma unroll
        for (int m = 0; m < 16; ++m) ffh[m] = h16x2{f[2 * m], f[2 * m + 1]} * cc + ffh[m];
        if (i < 15) asm volatile("" : "+v"(ra[i + 1]) : "v"(ffh[0]), "v"(ffh[7]), "v"(ffh[15]));
      }
    }
    float fs[16];
#pragma unroll
    for (int i = 0; i < 8; ++i) {
      const auto r = __builtin_amdgcn_permlane32_swap(__builtin_bit_cast(u32, ffh[i]), __builtin_bit_cast(u32, ffh[8 + i]), false, false);
      const u32 w0 = r[0], w1 = r[1];
      const h16x2 mine = __builtin_bit_cast(h16x2, w0), oth = __builtin_bit_cast(h16x2, w1);
      fs[2 * i] = ((float)mine[0] + (float)oth[0]) * (1.f / 1024.f);
      fs[2 * i + 1] = ((float)mine[1] + (float)oth[1]) * (1.f / 1024.f);
    }
    float rv[16];
#pragma unroll
    for (int j = 0; j < 4; ++j) {
      const f32x4 y = f32x4{(float)yh[j][0], (float)yh[j][1], (float)yh[j][2], (float)yh[j][3]}, g = g2v[j];
#pragma unroll
      for (int i = 0; i < 4; ++i) rv[4 * j + i] = ALPHA * y[i] + g[i] * fs[4 * j + i];
    }
    float s = 0.f;
#pragma unroll
    for (int i = 0; i < 16; ++i) s += rv[i];
    const float mu = wave_sum(s) * (1.f / 1024.f);
    float q = 0.f;
#pragma unroll
    for (int i = 0; i < 16; ++i) { rv[i] -= mu; q += rv[i] * rv[i]; }
    const float rstd = rsqrtf(wave_sum(q) * (1.f / 1024.f) + LN_EPS);
    const float poison = P_misc[1] != 0.f ? __builtin_nanf("") : 0.f;
    float* outp = (tok < TP ? P_y_prompt + (size_t)tok * 1024 : P_y_sample + (size_t)(tok - TP) * 1024) + cb;
#pragma unroll
    for (int j = 0; j < 4; ++j) {
      const f32x4 g = l2g[j], b = l2b[j];
      f32x4 o;
#pragma unroll
      for (int i = 0; i < 4; ++i) o[i] = rv[4 * j + i] * rstd * g[i] + b[i] + poison;
      *(f32x4*)(outp + 128 * j) = o;
    }
    wave_lds_sync();
  }
}

typedef const __attribute__((address_space(4))) Params* kparams_t;
DI Params fresh_params(kparams_t pp) {
#if defined(__HIP_DEVICE_COMPILE__)
  asm volatile("" : "+s"(pp));
  return *pp;
#else
  return Params{};
#endif
}

__global__ void __launch_bounds__(512, 2) fwd_megakernel(Params p_arg) {
  cg::grid_group grid = cg::this_grid();
  __shared__ __attribute__((aligned(16))) char smem[SMEM_BYTES];
  kparams_t pp = (kparams_t)__builtin_amdgcn_kernarg_segment_ptr();
  if (threadIdx.x == 0) { *(volatile LAS unsigned*)(smem + SMEM_CTRL + 8) = 0u; *(volatile LAS unsigned*)(smem + SMEM_CTRL + 12) = 0u; }
  __syncthreads();
  const XcdBarrier xb = xcd_barrier_post((unsigned*)(fresh_params(pp).ws + OFF_BAR), (volatile LAS unsigned*)(smem + SMEM_CTRL + 8));
  if (p_arg.out == nullptr) grid.sync();
  phaseA(fresh_params(pp), smem);
  xcd_barrier(xb);
  phaseA2(fresh_params(pp));
  xcd_barrier(xb);
  phaseB(fresh_params(pp), smem);
  xcd_barrier(xb);
  phaseC(fresh_params(pp), smem);
  xcd_barrier(xb);
  phaseD(fresh_params(pp), smem);
  xcd_barrier(xb);
  phaseE(fresh_params(pp));
  xcd_barrier(xb);
  phaseF(fresh_params(pp), smem);
  xcd_barrier(xb);
  phaseG1(fresh_params(pp), smem);
  xcd_barrier(xb);
  phaseG2(fresh_params(pp), smem);
}

extern "C" void kernel_launch(void* const* d_in, const int* in_sizes, int n_in, void* d_out, int out_size,
                              void* d_ws, size_t ws_size, hipStream_t stream) {
  static int grid_blocks = 0;
  if (!grid_blocks) {
    int dev = 0, cus = 0, per_cu = 0;
    (void)hipGetDevice(&dev);
    (void)hipDeviceGetAttribute(&cus, hipDeviceAttributeMultiprocessorCount, dev);
    (void)hipOccupancyMaxActiveBlocksPerMultiprocessor(&per_cu, fwd_megakernel, 512, 0);
    if (per_cu > 1) per_cu = 1;
    grid_blocks = cus * per_cu;
    if (ws_size < WS_NEED) fprintf(stderr, "workspace too small: %zu < %zu\n", ws_size, (size_t)WS_NEED);
  }
  Params p{};
  const float* const* in = (const float* const*)d_in;
  p.x_prompt = in[0]; p.x_sample = in[1]; p.cache_k = in[2]; p.cache_v = in[3]; p.cache_conv = in[4]; p.c_prompt = in[5]; p.c_sample = in[6];
  p.w_ada = in[7]; p.b_ada = in[8]; p.w_in = in[9]; p.b_in = in[10]; p.w_dw = in[11]; p.b_dw = in[12]; p.conv_ln_g = in[13]; p.conv_ln_b = in[14];
  p.lam_q1 = in[15]; p.lam_k1 = in[16]; p.lam_q2 = in[17]; p.lam_k2 = in[18]; p.subln_g = in[19]; p.w_out = in[20]; p.b_out = in[21];
  p.ln1_g = in[22]; p.ln1_b = in[23]; p.w_query = in[24]; p.sub_keys = in[25]; p.u_tab = in[26]; p.v_tab = in[27]; p.ln2_g = in[28]; p.ln2_b = in[29];
  p.out = (float*)d_out;
  p.ws = (char*)d_ws;
  char* ws = (char*)d_ws;
  (void)hipMemsetAsync(ws + OFF_MISC + 256, 0, 4096 - 256 + 16384, stream);
  void* args[] = {&p};
  hipError_t e = hipLaunchCooperativeKernel((void*)fwd_megakernel, dim3(grid_blocks), dim3(512), args, 0, stream);
  if (e != hipSuccess) fprintf(stderr, "cooperative launch failed: %s (grid %d)\n", hipGetErrorString(e), grid_blocks);
}
```
